# Optimizing an MI355X kernel written in HIP

```python
import math
import jax, jax.numpy as jnp
from jax import lax
import numpy as np

D_MODEL = 2048
BATCH = 4
SEQ = 2048
DEPTH = 1

D_MIX = D_MODEL
DA_QK = 64
DA_V = 2 * DA_QK
DA_HEADS = D_MODEL // 256
DA_WIDTH = DA_HEADS * DA_V
ML_QK = 128
ML_V = 256
ML_HEADS = D_MODEL // 512
ML_WIDTH = ML_HEADS * ML_V
CONV_W = 4
ML_CHUNK = 64
GATE_CAP = 15.0
Q_BLOCK = 128
ROPE_THETA = 10000.0
PEER_HEADS = 8
PEER_NKEYS = 128
PEER_EXPERTS = PEER_NKEYS * PEER_NKEYS
PEER_QDIM = 256
PEER_TOPK = 16
PEER_TOK_BLOCK = 128
EPS = 1e-6

PROJ_SIZES = [2 * DA_HEADS * DA_QK, 2 * DA_HEADS * DA_QK, DA_WIDTH,
              ML_HEADS * ML_QK, ML_HEADS * ML_QK, ML_WIDTH, ML_WIDTH,
              ML_HEADS, ML_HEADS]
PROJ_DIM = sum(PROJ_SIZES)
PROJ_SPLITS = [int(s) for s in np.cumsum(PROJ_SIZES)[:-1]]

kernel_name = 'hymba_diffattn_mlstm_peer_adaln'


def rms_norm(x, g):
    xf = x.astype(jnp.float32)
    y = xf * lax.rsqrt(jnp.mean(xf * xf, axis=-1, keepdims=True) + EPS)
    return (y * g.astype(jnp.float32)).astype(x.dtype)


def modulate(h, shift, scale):
    return h * (1 + scale[:, None, :]) + shift[:, None, :]


def rope(x, pos):
    d = x.shape[-1]
    half = d // 2
    inv = ROPE_THETA ** (-jnp.arange(half, dtype=jnp.float32) / half)
    ang = pos.astype(jnp.float32)[:, None] * inv[None, :]
    cos = jnp.cos(ang)[None, :, None, :]
    sin = jnp.sin(ang)[None, :, None, :]
    xf = x.astype(jnp.float32)
    x1, x2 = xf[..., :half], xf[..., half:]
    return jnp.concatenate([x1 * cos - x2 * sin, x2 * cos + x1 * sin], axis=-1).astype(x.dtype)


def causal_dwconv(x, w, b):
    C = x.shape[-1]
    y = lax.conv_general_dilated(x, w[:, None, :].astype(x.dtype), window_strides=(1,),
                                 padding=[(CONV_W - 1, 0)],
                                 dimension_numbers=('NWC', 'WIO', 'NWC'),
                                 feature_group_count=C)
    return y + b


def differential_attention(q, k, v, lam):
    B, S = q.shape[0], q.shape[1]
    nqb = S // Q_BLOCK
    qb = q.reshape(B, nqb, Q_BLOCK, 2 * DA_HEADS, DA_QK).transpose(1, 0, 2, 3, 4)
    starts = jnp.arange(nqb) * Q_BLOCK
    kpos = jnp.arange(S)
    scale = DA_QK ** -0.5

    def one_block(args):
        q_blk, start = args
        s = jnp.einsum('bqhd,bkhd->bhqk', q_blk, k).astype(jnp.float32) * scale
        qpos = start + jnp.arange(Q_BLOCK)
        s = jnp.where(kpos[None, :] <= qpos[:, None], s, -jnp.inf)
        p = jax.nn.softmax(s, axis=-1).reshape(B, DA_HEADS, 2, Q_BLOCK, S)
        a = p[:, :, 0] - lam * p[:, :, 1]
        return jnp.einsum('bhqk,bkhe->bqhe', a.astype(v.dtype), v)

    o = lax.map(one_block, (qb, starts))
    return o.transpose(1, 0, 2, 3, 4).reshape(B, S, DA_HEADS, DA_V)


def mlstm_chunkwise(q, k, v, li, lf):
    B, S, H, dk = q.shape
    dv = v.shape[-1]
    nc = S // ML_CHUNK
    L = ML_CHUNK

    def to_chunks4(t):
        return t.reshape(B, nc, L, H, t.shape[-1]).transpose(1, 0, 3, 2, 4)

    def to_chunks3(t):
        return t.reshape(B, nc, L, H).transpose(1, 0, 3, 2)

    tri = jnp.tril(jnp.ones((L, L), dtype=bool))

    def body(carry, xs):
        C, n, m = carry
        qc, kc, vc, lic, lfc = xs
        b = jnp.cumsum(lfc, axis=-1)
        D = jnp.where(tri, b[..., :, None] - b[..., None, :] + lic[..., None, :], -jnp.inf)
        inter = b + m[..., None]
        m_j = jnp.maximum(inter, jnp.max(D, axis=-1))
        w_intra = jnp.exp(D - m_j[..., None])
        w_inter = jnp.exp(inter - m_j)
        qk = jnp.einsum('bhjd,bhsd->bhjs', qc, kc) * w_intra
        num = w_inter[..., None] * jnp.einsum('bhjd,bhde->bhje', qc, C) + \
            jnp.einsum('bhjs,bhse->bhje', qk, vc)
        den = w_inter * jnp.einsum('bhjd,bhd->bhj', qc, n) + jnp.sum(qk, axis=-1)
        h = num / jnp.maximum(jnp.abs(den), jnp.exp(-m_j))[..., None]
        bL = b[..., -1]
        logw = bL[..., None] - b + lic
        m_new = jnp.maximum(bL + m, jnp.max(logw, axis=-1))
        decay = jnp.exp(bL + m - m_new)
        ws = jnp.exp(logw - m_new[..., None])
        C_new = decay[..., None, None] * C + jnp.einsum('bhs,bhsd,bhse->bhde', ws, kc, vc)
        n_new = decay[..., None] * n + jnp.einsum('bhs,bhsd->bhd', ws, kc)
        return (C_new, n_new, m_new), h

    init = (jnp.zeros((B, H, dk, dv), jnp.float32),
            jnp.zeros((B, H, dk), jnp.float32),
            jnp.zeros((B, H), jnp.float32))
    xs = (to_chunks4(q), to_chunks4(k), to_chunks4(v), to_chunks3(li), to_chunks3(lf))
    _, hs = lax.scan(body, init, xs)
    return hs.transpose(1, 0, 3, 2, 4).reshape(B, S, H, dv)


def softcap(x):
    return GATE_CAP * jnp.tanh(x / GATE_CAP)


def peer(h, w_pq, sub_keys, peer_u, peer_v):
    B, S, D = h.shape
    T = B * S
    ht = h.reshape(T, D)
    q = (ht @ w_pq).reshape(T, PEER_HEADS, 2, PEER_QDIM // 2)
    s = jnp.einsum('thcd,hcnd->thcn', q, sub_keys).astype(jnp.float32)
    s_top, i_top = lax.top_k(s, PEER_TOPK)
    cand = (s_top[:, :, 0, :, None] + s_top[:, :, 1, None, :]).reshape(T, PEER_HEADS, PEER_TOPK * PEER_TOPK)
    cand_idx = (i_top[:, :, 0, :, None] * PEER_NKEYS + i_top[:, :, 1, None, :]).reshape(T, PEER_HEADS, PEER_TOPK * PEER_TOPK)
    sc, pos = lax.top_k(cand, PEER_TOPK)
    idx = jnp.take_along_axis(cand_idx, pos, axis=-1)
    g = jax.nn.softmax(sc, axis=-1)
    nb = T // PEER_TOK_BLOCK

    def one_block(args):
        h_b, idx_b, g_b = args
        u_sel = jnp.take(peer_u, idx_b, axis=0)
        a = jax.nn.gelu(jnp.einsum('td,thkd->thk', h_b, u_sel).astype(jnp.float32), approximate=False)
        w = (g_b * a).astype(h.dtype)
        v_sel = jnp.take(peer_v, idx_b, axis=0)
        return jnp.einsum('thk,thkd->td', w, v_sel)

    y = lax.map(one_block, (ht.reshape(nb, PEER_TOK_BLOCK, D),
                            idx.reshape(nb, PEER_TOK_BLOCK, PEER_HEADS, PEER_TOPK),
                            g.reshape(nb, PEER_TOK_BLOCK, PEER_HEADS, PEER_TOPK)))
    return y.reshape(B, S, D)


def setup_inputs(seed: int = 0) -> dict:
    key = jax.random.key(seed)
    ks = jax.random.split(key, 26)
    f32 = jnp.float32
    D = D_MODEL
    nrm = lambda k, shp, s: jax.random.normal(k, shp, f32) * s
    return {
        'x': nrm(ks[0], (BATCH, SEQ, D), 1.0),
        'c': nrm(ks[1], (BATCH, D), 1.0),
        'w_ada': nrm(ks[2], (DEPTH, D, 6 * D), 0.5 * D ** -0.5),
        'b_ada': nrm(ks[3], (DEPTH, 6 * D), 0.02),
        'g_mix': 1.0 + nrm(ks[4], (DEPTH, D), 0.02),
        'w_in': nrm(ks[5], (DEPTH, D, PROJ_DIM), D ** -0.5),
        'conv_w': nrm(ks[6], (DEPTH, CONV_W, 2 * ML_HEADS * ML_QK), CONV_W ** -0.5),
        'conv_b': nrm(ks[7], (DEPTH, 2 * ML_HEADS * ML_QK), 0.02),
        'b_igate': -3.0 + nrm(ks[8], (DEPTH, ML_HEADS), 0.1),
        'b_fgate': jnp.broadcast_to(jnp.linspace(3.0, 6.0, ML_HEADS, dtype=f32), (DEPTH, ML_HEADS)) + nrm(ks[9], (DEPTH, ML_HEADS), 0.1),
        'lambda_q1': nrm(ks[10], (DEPTH, DA_QK), 0.1),
        'lambda_k1': nrm(ks[11], (DEPTH, DA_QK), 0.1),
        'lambda_q2': nrm(ks[12], (DEPTH, DA_QK), 0.1),
        'lambda_k2': nrm(ks[13], (DEPTH, DA_QK), 0.1),
        'da_norm': 1.0 + nrm(ks[14], (DEPTH, DA_V), 0.02),
        'ml_norm': 1.0 + nrm(ks[15], (DEPTH, ML_V), 0.02),
        'w_out': nrm(ks[16], (DEPTH, D_MIX, D), D_MIX ** -0.5),
        'g_ffn': 1.0 + nrm(ks[17], (DEPTH, D), 0.02),
        'w_pq': nrm(ks[18], (DEPTH, D, PEER_HEADS * PEER_QDIM), D ** -0.5),
        'sub_keys': nrm(ks[19], (DEPTH, PEER_HEADS, 2, PEER_NKEYS, PEER_QDIM // 2), (PEER_QDIM // 2) ** -0.5),
        'peer_u': nrm(ks[20], (DEPTH, PEER_EXPERTS, D), D ** -0.5),
        'peer_v': nrm(ks[21], (DEPTH, PEER_EXPERTS, D), PEER_HEADS ** -0.5),
        'w_ada_final': nrm(ks[22], (D, 2 * D), 0.5 * D ** -0.5),
        'b_ada_final': nrm(ks[23], (2 * D,), 0.02),
        'g_final': 1.0 + nrm(ks[24], (D,), 0.02),
    }


def reference(x, c, w_ada, b_ada, g_mix, w_in, conv_w, conv_b, b_igate, b_fgate,
              lambda_q1, lambda_k1, lambda_q2, lambda_k2, da_norm, ml_norm, w_out,
              g_ffn, w_pq, sub_keys, peer_u, peer_v, w_ada_final, b_ada_final, g_final):
    B, S, D = x.shape
    pos = jnp.arange(S)
    cs = jax.nn.silu(c.astype(jnp.float32)).astype(x.dtype)
    for l in range(DEPTH):
        mod = (cs @ w_ada[l] + b_ada[l]).reshape(B, 6, D)
        sh_m, sc_m, gt_m, sh_f, sc_f, gt_f = [mod[:, i] for i in range(6)]

        h = modulate(rms_norm(x, g_mix[l]), sh_m, sc_m)
        p = jnp.einsum('bsd,dp->bsp', h, w_in[l])
        da_q, da_k, da_v, ml_q, ml_k, ml_v, ml_o, ml_i, ml_f = jnp.split(p, PROJ_SPLITS, axis=-1)

        lam_init = 0.8 - 0.6 * math.exp(-0.3 * l)
        lam = (jnp.exp(jnp.sum(lambda_q1[l].astype(jnp.float32) * lambda_k1[l].astype(jnp.float32)))
               - jnp.exp(jnp.sum(lambda_q2[l].astype(jnp.float32) * lambda_k2[l].astype(jnp.float32)))
               + lam_init)
        qa = rope(da_q.reshape(B, S, 2 * DA_HEADS, DA_QK), pos)
        ka = rope(da_k.reshape(B, S, 2 * DA_HEADS, DA_QK), pos)
        va = da_v.reshape(B, S, DA_HEADS, DA_V)
        oa = differential_attention(qa, ka, va, lam)
        oa = (rms_norm(oa, da_norm[l]) * (1.0 - lam_init)).reshape(B, S, DA_WIDTH)

        qk_m = jax.nn.silu(causal_dwconv(jnp.concatenate([ml_q, ml_k], axis=-1), conv_w[l], conv_b[l]))
        qm, km = jnp.split(qk_m, 2, axis=-1)
        qm = qm.reshape(B, S, ML_HEADS, ML_QK).astype(jnp.float32)
        km = km.reshape(B, S, ML_HEADS, ML_QK).astype(jnp.float32) * (ML_QK ** -0.5)
        vm = ml_v.reshape(B, S, ML_HEADS, ML_V).astype(jnp.float32)
        li = softcap((ml_i + b_igate[l]).astype(jnp.float32))
        lf = jax.nn.log_sigmoid(softcap((ml_f + b_fgate[l]).astype(jnp.float32)))
        hm = mlstm_chunkwise(qm, km, vm, li, lf).astype(x.dtype)
        om = rms_norm(hm, ml_norm[l]).reshape(B, S, ML_WIDTH) * jax.nn.sigmoid(ml_o)

        mixed = jnp.einsum('bsm,md->bsd', jnp.concatenate([oa, om], axis=-1), w_out[l])
        x = x + gt_m[:, None, :] * mixed

        h2 = modulate(rms_norm(x, g_ffn[l]), sh_f, sc_f)
        x = x + gt_f[:, None, :] * peer(h2, w_pq[l], sub_keys[l], peer_u[l], peer_v[l])

    mod_o = (cs @ w_ada_final + b_ada_final).reshape(B, 2, D)
    return modulate(rms_norm(x, g_final), mod_o[:, 0], mod_o[:, 1])
```

```cpp
#include <hip/hip_runtime.h>
#include <hip/hip_cooperative_groups.h>
#include <cstdio>
#include <cstdint>
namespace cg = cooperative_groups;
#define DI __device__ __forceinline__
namespace pg8 {
#define PG8_LAS __attribute__((address_space(3)))
typedef unsigned short bf16_t;
typedef short bf16x8 __attribute__((ext_vector_type(8)));
typedef float f32x4 __attribute__((ext_vector_type(4)));
typedef unsigned u32x4 __attribute__((ext_vector_type(4)));
constexpr int BM = 256, BK = 64, HALF = 128, HTB = HALF * BK * 2  , STAGE_BYTES = 8 * HTB, NXCD = 8, WGM = 8;

__host__ __device__ __forceinline__ int lds_byte(int r, int c) { const int st = (r >> 4) * 2 + (c >> 5), rr = r & 15, cc = c & 31, ob = rr * 64 + cc * 2; return st * 1024 + (ob ^ (((ob >> 9) & 1) << 5)); }
__host__ __device__ __forceinline__ void stage_rc(int b, int& R, int& C) { const int st = b / 1024, sb = b % 1024, swz = sb ^ (((sb >> 9) & 1) << 5); R = (st >> 1) * 16 + swz / 64; C = (st & 1) * 32 + (swz % 64) / 2; }
__host__ __device__ __forceinline__ int perm32(int rho) { const int n = rho >> 4, i = rho & 15; return 8 * (i >> 2) + 4 * n + (i & 3); }

struct Unit { int pm, pn; };
struct Gemm { const bf16_t* A; const bf16_t* Bt; int M, N, K; };

struct StaticOrder {
    int nM, nN, nwg, G, c;
    __host__ __device__ void init(int M, int N, int G_, int c_) { nM = M / BM; nN = N / BM; nwg = nM * nN; G = G_; c = c_; }
    __host__ __device__ bool next(int i, Unit& u) const {
        const long L = (long)i * G + c; if (L >= nwg) return false;
        int wgid = (int)L; { const int q = nwg / NXCD, r = nwg % NXCD, xcd = wgid % NXCD, off = wgid / NXCD; wgid = (xcd < r ? xcd * (q + 1) : r * (q + 1) + (xcd - r) * q) + off; }
        const int nig = WGM * nN, gid = wgid / nig, fm = gid * WGM, gsz = (nM - fm) < WGM ? (nM - fm) : WGM;
        u.pm = fm + ((wgid % nig) % gsz); u.pn = (wgid % nig) / gsz; return true;
    }
    __device__ __forceinline__ void a_ready(const Unit&) const {}
    __device__ __forceinline__ void done(const Unit&) const {}
};
template <class Epi, class Sched, bool STAMP = false>
__device__ __forceinline__ void gemm_phase(PG8_LAS unsigned char* lds, const Gemm g, const Sched& S, const Epi& E, unsigned long long* stamps) {
    const int tid = threadIdx.x, wid = __builtin_amdgcn_readfirstlane(tid >> 6), lane = tid & 63, wr = wid >> 2, wc = wid & 3, fr = lane & 15, fq = lane >> 4;
    const int K = g.K, nt = K / BK;
    int ts_lo = 0, ts_hi = 0, nts = 0; const unsigned long long rt_entry = STAMP ? (unsigned long long)wall_clock64() : 0ull;
#define PG8_STAMP() do { if (STAMP && wid == 0 && nts < 64) { const unsigned long long _c = (unsigned long long)clock64(); \
        ts_lo = (lane == nts) ? (int)(unsigned)_c : ts_lo; ts_hi = (lane == nts) ? (int)(unsigned)(_c >> 32) : ts_hi; ++nts; } } while (0)
    PG8_STAMP();
    unsigned voffA[2], voffB[2];
#pragma unroll
    for (int i = 0; i < 2; ++i) { int R, C; stage_rc(tid * 16 + i * 8192, R, C); const int Rb = Epi::PERM ? ((R & ~31) + perm32(R & 31)) : R;
        voffA[i] = (unsigned)(R * K + C) * 2u; voffB[i] = (unsigned)(Rb * K + C) * 2u; }
    const size_t kstep = (size_t)(BK * 2);
    const size_t hstep = (size_t)HALF * K * 2;
    const size_t tstep = 2 * hstep;
    const unsigned ldsw = (unsigned)wid * 1024u;
    const int aoff = lds_byte(wr * 64 + fr, fq * 8), boff = lds_byte(wc * 32 + fr, fq * 8);
#define PG8_SA(b, h) (((b) * 2 + (h)) * HTB)
#define PG8_SB(b, h) ((4 + (b) * 2 + (h)) * HTB)
#define PG8_STAGE(bufoff, gbase, voff) do { _Pragma("unroll") for (int _i = 0; _i < 2; ++_i) \
        __builtin_amdgcn_global_load_lds((const unsigned*)((const char*)(gbase) + (voff)[_i]), (PG8_LAS unsigned*)(lds + (bufoff) + ldsw + _i * 8192), 16, 0, 0); } while (0)
#define PG8_LDA(dst, b, h) do { _Pragma("unroll") for (int m = 0; m < 4; ++m) _Pragma("unroll") for (int k = 0; k < 2; ++k) dst[m][k] = *(const PG8_LAS bf16x8*)(lds + PG8_SA(b, h) + aoff + m * 2048 + k * 1024); } while (0)
#define PG8_LDB(dst, b, h) do { _Pragma("unroll") for (int n = 0; n < 2; ++n) _Pragma("unroll") for (int k = 0; k < 2; ++k) dst[n][k] = *(const PG8_LAS bf16x8*)(lds + PG8_SB(b, h) + boff + n * 2048 + k * 1024); } while (0)
#define PG8_MMA(ai, bj, At, Bt) do { __builtin_amdgcn_s_setprio(1); _Pragma("unroll") for (int m = 0; m < 4; ++m) _Pragma("unroll") for (int n = 0; n < 2; ++n) _Pragma("unroll") for (int k = 0; k < 2; ++k) \
        acc[ai][bj][m][n] = __builtin_amdgcn_mfma_f32_16x16x32_bf16(Bt[n][k], At[m][k], acc[ai][bj][m][n], 0, 0, 0); __builtin_amdgcn_s_setprio(0); } while (0)
#define PG8_WAIT_V(n) asm volatile("s_waitcnt vmcnt(" #n ")" ::: "memory")
#define PG8_WAIT_L(n) asm volatile("s_waitcnt lgkmcnt(" #n ")" ::: "memory")
#define PG8_BAR __builtin_amdgcn_s_barrier()
#define PG8_SCHED __builtin_amdgcn_sched_barrier(0)
    Unit cur, nxt; int ui = 0;
    if (!S.next(0, cur)) return;
    f32x4 acc[2][2][4][2];
#pragma unroll
    for (int a = 0; a < 2; ++a)
#pragma unroll
        for (int b = 0; b < 2; ++b)
#pragma unroll
            for (int m = 0; m < 4; ++m)
#pragma unroll
                for (int n = 0; n < 2; ++n) acc[a][b][m][n] = (f32x4){0.f, 0.f, 0.f, 0.f};
    bf16x8 At[4][2], B0[2][2], B1[2][2];
    const char* cA = (const char*)g.A + (size_t)cur.pm * tstep; const char* cB = (const char*)g.Bt + (size_t)cur.pn * tstep;
    S.a_ready(cur);
    PG8_STAGE(PG8_SB(0, 0), cB, voffB); PG8_STAGE(PG8_SA(0, 0), cA, voffA); PG8_STAGE(PG8_SB(0, 1), cB + hstep, voffB); PG8_STAGE(PG8_SA(0, 1), cA + hstep, voffA);
    if (wr == 1) PG8_BAR;
    PG8_WAIT_V(4); PG8_BAR;
    PG8_STAGE(PG8_SB(1, 0), cB + kstep, voffB); PG8_STAGE(PG8_SA(1, 0), cA + kstep, voffA); PG8_STAGE(PG8_SB(1, 1), cB + hstep + kstep, voffB);
    PG8_WAIT_V(6); PG8_BAR;
    PG8_STAMP();
    for (;;) {
        const bool has_next = S.next(ui + 1, nxt);
        const char* nA = has_next ? (const char*)g.A + (size_t)nxt.pm * tstep : cA; const char* nB = has_next ? (const char*)g.Bt + (size_t)nxt.pn * tstep : cB;
        for (int t = 0; t < nt; t += 2) {
            const bool last = (t == nt - 2);
            const char* a1 = cA + (size_t)(t + 1) * kstep;
            const char* a2 = last ? nA : cA + (size_t)(t + 2) * kstep; const char* b2 = last ? nB : cB + (size_t)(t + 2) * kstep;
            const char* a3 = a2 + kstep; const char* b3 = b2 + kstep;
            if (last && has_next) S.a_ready(nxt);
            PG8_LDB(B0, 0, 0); PG8_SCHED; PG8_LDA(At, 0, 0); PG8_STAGE(PG8_SA(1, 1), a1 + hstep, voffA);
            PG8_WAIT_L(8); PG8_BAR; PG8_WAIT_L(0); PG8_MMA(0, 0, At, B0); PG8_BAR; PG8_SCHED;
            PG8_LDB(B1, 0, 1); PG8_STAGE(PG8_SB(0, 0), b2, voffB);
            PG8_BAR; PG8_WAIT_L(0); PG8_MMA(0, 1, At, B1); PG8_BAR;
            PG8_LDA(At, 0, 1); PG8_STAGE(PG8_SA(0, 0), a2, voffA);
            PG8_BAR; PG8_WAIT_L(0); PG8_MMA(1, 0, At, B0); PG8_BAR; PG8_SCHED;
            PG8_STAGE(PG8_SB(0, 1), b2 + hstep, voffB);
            PG8_WAIT_V(6); PG8_BAR; PG8_MMA(1, 1, At, B1); PG8_BAR;
            PG8_LDB(B0, 1, 0); PG8_SCHED; PG8_LDA(At, 1, 0); PG8_STAGE(PG8_SA(0, 1), a2 + hstep, voffA);
            PG8_WAIT_L(8); PG8_BAR; PG8_WAIT_L(0); PG8_MMA(0, 0, At, B0); PG8_BAR; PG8_SCHED;
            PG8_LDB(B1, 1, 1); PG8_STAGE(PG8_SB(1, 0), b3, voffB);
            PG8_BAR; PG8_WAIT_L(0); PG8_MMA(0, 1, At, B1); PG8_BAR;
            PG8_LDA(At, 1, 1); PG8_STAGE(PG8_SA(1, 0), a3, voffA);
            PG8_BAR; PG8_WAIT_L(0); PG8_MMA(1, 0, At, B0); PG8_BAR; PG8_SCHED;
            PG8_STAGE(PG8_SB(1, 1), b3 + hstep, voffB);
            PG8_WAIT_V(6); PG8_BAR; PG8_MMA(1, 1, At, B1); PG8_BAR;
        }
        PG8_STAMP();
        if constexpr (!Epi::AFTER_DRAIN) { E(acc, cur, wr, wc, fr, fq); S.done(cur); }
        PG8_STAMP();
        if (!has_next) break;
#pragma unroll
        for (int a = 0; a < 2; ++a)
#pragma unroll
            for (int b = 0; b < 2; ++b)
#pragma unroll
                for (int m = 0; m < 4; ++m)
#pragma unroll
                    for (int n = 0; n < 2; ++n) acc[a][b][m][n] = (f32x4){0.f, 0.f, 0.f, 0.f};
        cur = nxt; cA = nA; cB = nB; ++ui;
    }
    PG8_WAIT_V(0);
    if (wr == 0) PG8_BAR;
    PG8_BAR;
    if constexpr (Epi::AFTER_DRAIN) { E.fused(acc, cur, wr, wc, fr, fq, lds, wid, lane); S.done(cur); }
    PG8_STAMP();
    if (STAMP && wid == 0) { stamps[lane] = lane < nts ? (((unsigned long long)(unsigned)ts_hi << 32) | (unsigned)ts_lo) : 0ull;
        if (lane == 62) stamps[62] = rt_entry; if (lane == 63) stamps[63] = (unsigned long long)wall_clock64(); }
#undef PG8_STAMP
#undef PG8_SA
#undef PG8_SB
#undef PG8_STAGE
#undef PG8_LDA
#undef PG8_LDB
#undef PG8_MMA
#undef PG8_WAIT_V
#undef PG8_WAIT_L
#undef PG8_BAR
#undef PG8_SCHED
}
}
using pg8::bf16_t; using pg8::bf16x8; using pg8::f32x4; using pg8::u32x4;
typedef short s16x4 __attribute__((ext_vector_type(4)));
typedef float f32x16 __attribute__((ext_vector_type(16)));
typedef float f32x2 __attribute__((ext_vector_type(2)));
typedef unsigned u32x2 __attribute__((ext_vector_type(2)));
typedef __bf16 bfv2 __attribute__((ext_vector_type(2)));

constexpr int T_ = 8192, D_ = 2048;
constexpr size_t OFF_CTL = 0;
constexpr size_t OFF_MOD = 4096;
constexpr size_t OFF_ROPE = OFF_MOD + 262144;
constexpr size_t OFF_WG = OFF_ROPE + 524288;
constexpr size_t OFF_GATES = OFF_WG + 65536;
constexpr size_t OFF_IDX = OFF_GATES + 262144;
constexpr size_t OFF_GW = OFF_IDX + 4194304;
constexpr size_t OFF_NST = OFF_GW + 4194304;
constexpr size_t OFF_DEC = OFF_NST + 262144;
constexpr size_t OFF_WINT = OFF_DEC + 4096;
constexpr size_t OFF_WOUTT = OFF_WINT + 25165824;
constexpr size_t OFF_WPQT = OFF_WOUTT + 8388608;
constexpr size_t OFF_PU = OFF_WPQT + 8388608;
constexpr size_t OFF_PV = OFF_PU + 67108864;
constexpr size_t OFF_HB = OFF_PV + 67108864;
constexpr size_t OFF_PB = OFF_HB + 33554432;
constexpr size_t OFF_X1 = OFF_PB;
constexpr size_t OFF_QP = OFF_PB + 67108864;
constexpr size_t OFF_MIX = OFF_PB + 100663296;
constexpr size_t OFF_CST = OFF_MIX + 33554432;
constexpr size_t WS_TOTAL = OFF_CST + 67108864;
constexpr int LDS_BYTES = 147456;

struct Params {
  const float *x, *c, *w_ada, *b_ada, *g_mix, *w_in, *conv_w, *conv_b, *b_igate, *b_fgate,
              *lq1, *lk1, *lq2, *lk2, *da_norm, *ml_norm, *w_out, *g_ffn, *w_pq, *sub_keys,
              *peer_u, *peer_v, *w_ada_final, *b_ada_final, *g_final;
  float* out;
  unsigned char* ws;
};

DI unsigned pk2(float lo, float hi) { f32x2 v = {lo, hi}; bfv2 r = __builtin_convertvector(v, bfv2); return __builtin_bit_cast(unsigned, r); }
DI float bflo(unsigned u) { return __uint_as_float(u << 16); }
DI float bfhi(unsigned u) { return __uint_as_float(u & 0xffff0000u); }
DI float bf2f(bf16_t b) { return __uint_as_float(((unsigned)b) << 16); }
DI float wave_sum(float v) {
#pragma unroll
  for (int o = 1; o < 64; o <<= 1) v += __shfl_xor(v, o);
  return v;
}
DI f32x16 mfma32(bf16x8 a, bf16x8 b, f32x16 c) { return __builtin_amdgcn_mfma_f32_32x32x16_bf16(a, b, c, 0, 0, 0); }
DI int crow(int i, int h) { return (i & 3) + 8 * (i >> 2) + 4 * h; }
template <int S> DI bf16x8 pack8(const f32x16& x) {
  u32x4 p; p[0] = pk2(x[8 * S], x[8 * S + 1]); p[1] = pk2(x[8 * S + 2], x[8 * S + 3]); p[2] = pk2(x[8 * S + 4], x[8 * S + 5]); p[3] = pk2(x[8 * S + 6], x[8 * S + 7]);
  return __builtin_bit_cast(bf16x8, p);
}
DI bf16x8 cat4(s16x4 lo, s16x4 hi) { return __builtin_shufflevector(lo, hi, 0, 1, 2, 3, 4, 5, 6, 7); }
DI f32x16 zero16() { f32x16 z; for (int i = 0; i < 16; ++i) z[i] = 0.f; return z; }
#define LDS_WAIT() asm volatile("s_waitcnt lgkmcnt(0)" ::: "memory")
DI int newpos_in(int o) { if (o >= 2048) return o; const int hd = o >> 6, j = o & 63; return hd * 64 + (j < 32 ? 2 * j : 2 * (j - 32) + 1); }
DI void transpose_item(const float* W, int ldw, int nblk, bf16_t* WT, int K, float* scr, int item, int lane, bool perm) {
  const int kb = item / nblk, nb = item % nblk, k0 = 64 * kb, n0 = 32 * nb;
#pragma unroll 8
  for (int i = 0; i < 32; ++i) { const int kk = 2 * i + (lane >> 5); scr[kk * 33 + (lane & 31)] = W[(size_t)(k0 + kk) * ldw + n0 + (lane & 31)]; }
  LDS_WAIT();
  const int c = lane & 7;
#pragma unroll
  for (int j = 0; j < 4; ++j) { const int n = (lane >> 3) + 8 * j; const float* s = scr + (8 * c) * 33 + n;
    u32x4 o; o[0] = pk2(s[0 * 33], s[1 * 33]); o[1] = pk2(s[2 * 33], s[3 * 33]); o[2] = pk2(s[4 * 33], s[5 * 33]); o[3] = pk2(s[6 * 33], s[7 * 33]);
    const int orow = perm ? newpos_in(n0 + n) : (n0 + n);
    *(u32x4*)(WT + (size_t)orow * K + k0 + 8 * c) = o; }
  LDS_WAIT();
}
DI void phase0(const Params& p, unsigned char* lds, int bid, int nblk, int tid) {
  const int lane = tid & 63, wave = tid >> 6;
  float* MOD = (float*)(p.ws + OFF_MOD);
  float* cs = (float*)lds;
  float* red = (float*)(lds + 32768);
  for (int item = bid; item < 256; item += nblk) {
    const int col0 = item * 64;
    __syncthreads();
    for (int i = tid; i < 8192; i += 512) { const float v = p.c[i]; cs[i] = v / (1.f + expf(-v)); }
    __syncthreads();
    const int cg = tid & 15, dg = tid >> 4;
    const int col = col0 + cg * 4;
    const float* W; int ldw, wc; const float* bb;
    if (col < 12288) { W = p.w_ada; ldw = 12288; wc = col; bb = p.b_ada + col0; } else { W = p.w_ada_final; ldw = 4096; wc = col - 12288; bb = p.b_ada_final + (col0 - 12288); }
    f32x4 acc[4];
#pragma unroll
    for (int b = 0; b < 4; ++b) acc[b] = (f32x4){0.f, 0.f, 0.f, 0.f};
#pragma unroll 8
    for (int i = 0; i < 64; ++i) {
      const int d = dg * 64 + i;
      const f32x4 w = *(const f32x4*)(W + (size_t)d * ldw + wc);
#pragma unroll
      for (int b = 0; b < 4; ++b) acc[b] += cs[b * 2048 + d] * w;
    }
#pragma unroll
    for (int b = 0; b < 4; ++b) *(f32x4*)(red + (dg * 4 + b) * 64 + cg * 4) = acc[b];
    __syncthreads();
    if (tid < 256) { const int b = tid >> 6, cc = tid & 63; float sm = bb[cc];
      for (int g = 0; g < 32; ++g) sm += red[(g * 4 + b) * 64 + cc];
      MOD[b * 16384 + col0 + cc] = sm; }
  }
  __syncthreads();
  float* scr = (float*)(lds + 65536 + wave * 8448);
  const int gw = bid * 8 + wave, NGW = nblk * 8;
  constexpr int I_IN = 32 * 192, I_O = 32 * 64;
  bf16_t* WINT = (bf16_t*)(p.ws + OFF_WINT); bf16_t* WOUTT = (bf16_t*)(p.ws + OFF_WOUTT); bf16_t* WPQT = (bf16_t*)(p.ws + OFF_WPQT);
  for (int it = gw; it < I_IN + 2 * I_O; it += NGW) {
    if (it < I_IN) transpose_item(p.w_in, 6152, 192, WINT, 2048, scr, it, lane, true);
    else if (it < I_IN + I_O) transpose_item(p.w_out, 2048, 64, WOUTT, 2048, scr, it - I_IN, lane, false);
    else transpose_item(p.w_pq, 2048, 64, WPQT, 2048, scr, it - I_IN - I_O, lane, false);
  }
  {
    bf16_t* PU = (bf16_t*)(p.ws + OFF_PU); bf16_t* PV = (bf16_t*)(p.ws + OFF_PV);
    const size_t nchunk = (size_t)2 * 16384 * 2048 / 8;
    for (size_t ch = (size_t)bid * 512 + tid; ch < nchunk; ch += (size_t)nblk * 512) {
      const size_t off = ch * 8; const float* src; bf16_t* dst;
      if (off < 33554432ull) { src = p.peer_u + off; dst = PU + off; } else { src = p.peer_v + (off - 33554432ull); dst = PV + (off - 33554432ull); }
      const f32x4 a = ((const f32x4*)src)[0], b = ((const f32x4*)src)[1];
      u32x4 o; o[0] = pk2(a[0], a[1]); o[1] = pk2(a[2], a[3]); o[2] = pk2(b[0], b[1]); o[3] = pk2(b[2], b[3]);
      *(u32x4*)dst = o;
    }
  }
  {
    float* RC = (float*)(p.ws + OFF_ROPE); float* RS = RC + 65536;
    for (int i = bid * 512 + tid; i < 65536; i += nblk * 512) { const int pos = i >> 5, k = i & 31; const float inv = powf(10000.f, -(float)k / 32.f); const float ang = (float)pos * inv; RC[i] = cosf(ang); RS[i] = sinf(ang); }
    float* WG = (float*)(p.ws + OFF_WG);
    for (int i = bid * 512 + tid; i < 16384; i += nblk * 512) { const int j = i >> 11, k = i & 2047; WG[i] = p.w_in[(size_t)k * 6152 + 6144 + j]; }
  }
}
template <bool GATES> DI void phase_norm(const Params& p, const float* src, const float* gvec, int sh_idx, int sc_idx, int bid, int nblk, int tid) {
  const int lane = tid & 63, wave = tid >> 6;
  const float* MOD = (const float*)(p.ws + OFF_MOD);
  bf16_t* HB = (bf16_t*)(p.ws + OFF_HB);
  const float* WG = (const float*)(p.ws + OFF_WG);
  float* GT = (float*)(p.ws + OFF_GATES);
  for (int t = bid * 8 + wave; t < T_; t += nblk * 8) {
    const int b = t >> 11;
    const float* xr = src + (size_t)t * 2048;
    f32x4 v[8];
    float ss = 0.f;
#pragma unroll
    for (int r = 0; r < 4; ++r) {
      v[2 * r] = *(const f32x4*)(xr + r * 512 + lane * 8); v[2 * r + 1] = *(const f32x4*)(xr + r * 512 + lane * 8 + 4);
#pragma unroll
      for (int q = 0; q < 2; ++q) ss += v[2 * r + q][0] * v[2 * r + q][0] + v[2 * r + q][1] * v[2 * r + q][1] + v[2 * r + q][2] * v[2 * r + q][2] + v[2 * r + q][3] * v[2 * r + q][3];
    }
    ss = wave_sum(ss);
    const float rstd = 1.0f / sqrtf(ss * (1.f / 2048.f) + 1e-6f);
    const float* sh = MOD + b * 16384 + sh_idx * 2048; const float* sc = MOD + b * 16384 + sc_idx * 2048;
#pragma unroll
    for (int r = 0; r < 4; ++r) {
#pragma unroll
      for (int q = 0; q < 2; ++q) {
        const int e = r * 512 + lane * 8 + q * 4;
        const f32x4 g4 = *(const f32x4*)(gvec + e), sc4 = *(const f32x4*)(sc + e), sh4 = *(const f32x4*)(sh + e);
        v[2 * r + q] = v[2 * r + q] * rstd * g4 * (1.f + sc4) + sh4;
      }
      u32x4 o; o[0] = pk2(v[2 * r][0], v[2 * r][1]); o[1] = pk2(v[2 * r][2], v[2 * r][3]); o[2] = pk2(v[2 * r + 1][0], v[2 * r + 1][1]); o[3] = pk2(v[2 * r + 1][2], v[2 * r + 1][3]);
      *(u32x4*)(HB + (size_t)t * 2048 + r * 512 + lane * 8) = o;
    }
    if (GATES) {
      float mine = 0.f;
#pragma unroll 1
      for (int j = 0; j < 8; ++j) {
        float d = 0.f;
#pragma unroll
        for (int r = 0; r < 4; ++r)
#pragma unroll
          for (int q = 0; q < 2; ++q) { const f32x4 w = *(const f32x4*)(WG + j * 2048 + r * 512 + lane * 8 + q * 4); const f32x4 a = v[2 * r + q]; d += a[0] * w[0] + a[1] * w[1] + a[2] * w[2] + a[3] * w[3]; }
        d = wave_sum(d);
        if (lane == j) mine = d;
      }
      if (lane < 8) GT[t * 8 + lane] = mine;
    }
  }
}
struct EpiProj {
  static constexpr bool PERM = false, AFTER_DRAIN = false;
  bf16_t* PB; const float* RC; const float* RS;
  DI void operator()(const f32x4 (&acc)[2][2][4][2], const pg8::Unit& u, int wr, int wc, int fr, int fq) const {
    const int row0 = u.pm * 256 + wr * 64 + fr, col0 = u.pn * 256 + wc * 32 + 4 * fq;
    const bool rope = u.pn < 8; const float qs = u.pn < 4 ? 0.125f : 1.0f;
#pragma unroll
    for (int ai = 0; ai < 2; ++ai)
#pragma unroll
      for (int m = 0; m < 4; ++m) {
        const int row = row0 + ai * 128 + m * 16; const int pos = row & 2047;
#pragma unroll
        for (int bj = 0; bj < 2; ++bj)
#pragma unroll
          for (int n = 0; n < 2; ++n) {
            const int col = col0 + bj * 128 + n * 16;
            f32x4 v = acc[ai][bj][m][n];
            if (rope) {
              const int i = (col & 63) >> 1;
              const f32x2 cc = *(const f32x2*)(RC + pos * 32 + i), sn = *(const f32x2*)(RS + pos * 32 + i);
              const float a0 = v[0] * cc[0] - v[1] * sn[0], a1 = v[1] * cc[0] + v[0] * sn[0];
              const float a2 = v[2] * cc[1] - v[3] * sn[1], a3 = v[3] * cc[1] + v[2] * sn[1];
              v[0] = a0 * qs; v[1] = a1 * qs; v[2] = a2 * qs; v[3] = a3 * qs;
            }
            u32x2 o; o[0] = pk2(v[0], v[1]); o[1] = pk2(v[2], v[3]);
            *(u32x2*)(PB + (size_t)row * 6144 + col) = o;
          }
      }
  }
};
struct EpiRes {
  static constexpr bool PERM = false, AFTER_DRAIN = false;
  float* X1; const float* x; const float* MOD;
  DI void operator()(const f32x4 (&acc)[2][2][4][2], const pg8::Unit& u, int wr, int wc, int fr, int fq) const {
    const int row0 = u.pm * 256 + wr * 64 + fr, col0 = u.pn * 256 + wc * 32 + 4 * fq;
    const int b = (u.pm * 256) >> 11;
    f32x4 gt[2][2];
#pragma unroll
    for (int bj = 0; bj < 2; ++bj)
#pragma unroll
      for (int n = 0; n < 2; ++n) gt[bj][n] = *(const f32x4*)(MOD + b * 16384 + 2 * 2048 + col0 + bj * 128 + n * 16);
#pragma unroll
    for (int ai = 0; ai < 2; ++ai)
#pragma unroll
      for (int m = 0; m < 4; ++m) {
        const size_t ro = (size_t)(row0 + ai * 128 + m * 16) * 2048;
#pragma unroll
        for (int bj = 0; bj < 2; ++bj)
#pragma unroll
          for (int n = 0; n < 2; ++n) { const int col = col0 + bj * 128 + n * 16; *(f32x4*)(X1 + ro + col) = *(const f32x4*)(x + ro + col) + gt[bj][n] * acc[ai][bj][m][n]; }
      }
  }
};
struct EpiBf {
  static constexpr bool PERM = false, AFTER_DRAIN = false;
  bf16_t* O;
  DI void operator()(const f32x4 (&acc)[2][2][4][2], const pg8::Unit& u, int wr, int wc, int fr, int fq) const {
    const int row0 = u.pm * 256 + wr * 64 + fr, col0 = u.pn * 256 + wc * 32 + 4 * fq;
#pragma unroll
    for (int ai = 0; ai < 2; ++ai)
#pragma unroll
      for (int m = 0; m < 4; ++m) {
        const size_t ro = (size_t)(row0 + ai * 128 + m * 16) * 2048;
#pragma unroll
        for (int bj = 0; bj < 2; ++bj)
#pragma unroll
          for (int n = 0; n < 2; ++n) { const f32x4 v = acc[ai][bj][m][n]; u32x2 o; o[0] = pk2(v[0], v[1]); o[1] = pk2(v[2], v[3]); *(u32x2*)(O + ro + col0 + bj * 128 + n * 16) = o; }
      }
  }
};
DI bf16_t f2bf1(float x) { return (bf16_t)(pk2(x, 0.f) & 0xffffu); }
DI void phase_attn(const Params& p, unsigned char* lds, int bid, int nblk, int tid_in) {
  const bf16_t* PB = (const bf16_t*)(p.ws + OFF_PB); bf16_t* MIX = (bf16_t*)(p.ws + OFF_MIX);
  bf16_t* Ks = (bf16_t*)lds;
  bf16_t* VT = (bf16_t*)(lds + 17408);
  float* XE = (float*)(lds + 36864);
  float d1 = 0.f, d2 = 0.f;
  for (int i = 0; i < 64; ++i) { d1 += p.lq1[i] * p.lk1[i]; d2 += p.lq2[i] * p.lk2[i]; }
  const float lam = expf(d1) - expf(d2) + 0.2f;
  for (int u = bid; u < 256; u += nblk) {
    const int bh = u >> 3, pi = u & 7, b = bh >> 3, hd = bh & 7;
    for (int half = 0; half < 2; ++half) {
      int tid = tid_in; asm volatile("" : "+v"(tid));
      const int lane = tid & 63, wave = tid >> 6, r = lane & 31, h = lane >> 5;
      const int map = wave & 1, qs = wave >> 1;
      const int qb = half ? 15 - pi : pi;
      const int qg = qb * 128 + qs * 32 + r;
      const size_t tq = (size_t)b * 2048 + qg;
      bf16x8 bq[4];
#pragma unroll
      for (int s = 0; s < 4; ++s) bq[s] = *(const bf16x8*)(PB + tq * 6144 + (2 * hd + map) * 64 + 16 * s + 8 * h);
      f32x16 o[4];
#pragma unroll
      for (int et = 0; et < 4; ++et) o[et] = zero16();
      float m_run = -INFINITY, l_run = 0.f;
      const int nkt = 2 * qb + 2;
      u32x4 kreg[2], vreg[2];
#pragma unroll
      for (int i = 0; i < 2; ++i) { const int q = tid + 512 * i, row = q >> 4, c16 = q & 15; const bf16_t* src = PB + ((size_t)b * 2048 + row) * 6144 + hd * 128 + c16 * 8;
        kreg[i] = *(const u32x4*)(src + 1024); vreg[i] = *(const u32x4*)(src + 2048); }
      for (int kt = 0; kt < nkt; ++kt) {
        __syncthreads();
#pragma unroll
        for (int i = 0; i < 2; ++i) { const int q = tid + 512 * i, row = q >> 4, c16 = q & 15;
          *(u32x4*)(Ks + row * 136 + c16 * 8) = kreg[i];
#pragma unroll
          for (int j = 0; j < 4; ++j) { VT[(c16 * 8 + 2 * j) * 72 + row] = (bf16_t)(vreg[i][j] & 0xffffu); VT[(c16 * 8 + 2 * j + 1) * 72 + row] = (bf16_t)(vreg[i][j] >> 16); } }
        __syncthreads();
        if (kt + 1 < nkt) {
#pragma unroll
          for (int i = 0; i < 2; ++i) { const int q = tid + 512 * i, row = q >> 4, c16 = q & 15; const bf16_t* src = PB + ((size_t)b * 2048 + (kt + 1) * 64 + row) * 6144 + hd * 128 + c16 * 8;
            kreg[i] = *(const u32x4*)(src + 1024); vreg[i] = *(const u32x4*)(src + 2048); }
        }
        f32x16 st[2];
#pragma unroll
        for (int kk = 0; kk < 2; ++kk) { st[kk] = zero16();
#pragma unroll
          for (int s = 0; s < 4; ++s) { const bf16x8 a = *(const bf16x8*)(Ks + (kk * 32 + r) * 136 + map * 64 + 16 * s + 8 * h); st[kk] = mfma32(a, bq[s], st[kk]); } }
        const bool diag = (kt >= 2 * qb);
        float mx = -INFINITY;
#pragma unroll
        for (int kk = 0; kk < 2; ++kk)
#pragma unroll
          for (int i = 0; i < 16; ++i) { if (diag) { const int kg = kt * 64 + kk * 32 + crow(i, h); if (kg > qg) st[kk][i] = -INFINITY; } mx = fmaxf(mx, st[kk][i]); }
        mx = fmaxf(mx, __shfl_xor(mx, 32));
        const float m_new = fmaxf(m_run, mx);
        const float corr = __expf(m_run - m_new);
        l_run *= corr;
#pragma unroll
        for (int et = 0; et < 4; ++et) o[et] *= corr;
        float ps = 0.f;
#pragma unroll
        for (int kk = 0; kk < 2; ++kk)
#pragma unroll
          for (int i = 0; i < 16; ++i) { const float pv = __expf(st[kk][i] - m_new); st[kk][i] = pv; ps += pv; }
        l_run += ps; m_run = m_new;
#pragma unroll
        for (int kk = 0; kk < 2; ++kk) {
          const bf16x8 pf0 = pack8<0>(st[kk]), pf1 = pack8<1>(st[kk]);
#pragma unroll
          for (int et = 0; et < 4; ++et) {
            const bf16_t* vrow = VT + (et * 32 + r) * 72 + kk * 32 + 4 * h;
            const bf16x8 a0 = cat4(*(const s16x4*)(vrow), *(const s16x4*)(vrow + 8)), a1 = cat4(*(const s16x4*)(vrow + 16), *(const s16x4*)(vrow + 24));
            o[et] = mfma32(a0, pf0, o[et]); o[et] = mfma32(a1, pf1, o[et]);
          }
        }
      }
      const float inv = 1.0f / (l_run + __shfl_xor(l_run, 32));
      __syncthreads();
      if (map == 1) {
#pragma unroll
        for (int et = 0; et < 4; ++et)
#pragma unroll
          for (int i = 0; i < 16; ++i) XE[(qs * 128 + et * 32 + crow(i, h)) * 32 + r] = lam * o[et][i] * inv;
      }
      __syncthreads();
      if (map == 0) {
        float ss = 0.f;
#pragma unroll
        for (int et = 0; et < 4; ++et)
#pragma unroll
          for (int i = 0; i < 16; ++i) { const float v = o[et][i] * inv - XE[(qs * 128 + et * 32 + crow(i, h)) * 32 + r]; o[et][i] = v; ss += v * v; }
        ss += __shfl_xor(ss, 32);
        const float rstd = 0.8f / sqrtf(ss * (1.f / 128.f) + 1e-6f);
#pragma unroll
        for (int et = 0; et < 4; ++et)
#pragma unroll
          for (int g = 0; g < 4; ++g) { const int e0 = et * 32 + 8 * g + 4 * h; const f32x4 dn = *(const f32x4*)(p.da_norm + e0);
            u32x2 ov; ov[0] = pk2(o[et][4 * g] * rstd * dn[0], o[et][4 * g + 1] * rstd * dn[1]); ov[1] = pk2(o[et][4 * g + 2] * rstd * dn[2], o[et][4 * g + 3] * rstd * dn[3]);
            *(u32x2*)(MIX + tq * 2048 + hd * 128 + e0) = ov; }
      }
    }
  }
}
DI void conv8(const Params& p, const bf16_t* PB, int b, int spos, int pbcol, int cch, float (&out)[8]) {
  const f32x4 b0 = *(const f32x4*)(p.conv_b + cch), b1 = *(const f32x4*)(p.conv_b + cch + 4);
#pragma unroll
  for (int j = 0; j < 4; ++j) { out[j] = b0[j]; out[4 + j] = b1[j]; }
#pragma unroll
  for (int kw = 0; kw < 4; ++kw) {
    const int sp = spos - 3 + kw;
    if (sp >= 0) {
      const u32x4 xv = *(const u32x4*)(PB + ((size_t)b * 2048 + sp) * 6144 + pbcol);
      const f32x4 w0 = *(const f32x4*)(p.conv_w + kw * 1024 + cch), w1 = *(const f32x4*)(p.conv_w + kw * 1024 + cch + 4);
      out[0] += w0[0] * bflo(xv[0]); out[1] += w0[1] * bfhi(xv[0]); out[2] += w0[2] * bflo(xv[1]); out[3] += w0[3] * bfhi(xv[1]);
      out[4] += w1[0] * bflo(xv[2]); out[5] += w1[1] * bfhi(xv[2]); out[6] += w1[2] * bflo(xv[3]); out[7] += w1[3] * bfhi(xv[3]);
    }
  }
#pragma unroll
  for (int j = 0; j < 8; ++j) out[j] = out[j] / (1.f + __expf(-out[j]));
}
DI void gates64(const Params& p, int t0, int hh, int lane, float& li, float& bc) {
  const float* GT = (const float*)(p.ws + OFF_GATES);
  const float gi = GT[(t0 + lane) * 8 + hh] + p.b_igate[hh], gf = GT[(t0 + lane) * 8 + 4 + hh] + p.b_fgate[hh];
  li = 15.f * tanhf(gi * (1.f / 15.f));
  const float z = 15.f * tanhf(gf * (1.f / 15.f));
  const float lf = fminf(z, 0.f) - log1pf(expf(-fabsf(z)));
  bc = lf;
#pragma unroll
  for (int o = 1; o < 64; o <<= 1) { const float n = __shfl_up(bc, o); if (lane >= o) bc += n; }
}
DI void stage_vt256(const bf16_t* PB, bf16_t* VT, int t0, int hh, int tid) {
#pragma unroll
  for (int i = 0; i < 4; ++i) { const int q = tid + 512 * i, s = q >> 5, c32 = q & 31;
    const u32x4 v = *(const u32x4*)(PB + (size_t)(t0 + s) * 6144 + 4096 + hh * 256 + c32 * 8);
#pragma unroll
    for (int j = 0; j < 4; ++j) { VT[(c32 * 8 + 2 * j) * 72 + s] = (bf16_t)(v[j] & 0xffffu); VT[(c32 * 8 + 2 * j + 1) * 72 + s] = (bf16_t)(v[j] >> 16); } }
}
DI void phase_mlA(const Params& p, unsigned char* lds, int bid, int nblk, int tid_in) {
  const bf16_t* PB = (const bf16_t*)(p.ws + OFF_PB);
  float* CST = (float*)(p.ws + OFF_CST); float* NST = (float*)(p.ws + OFF_NST); float* DEC = (float*)(p.ws + OFF_DEC);
  bf16_t* KwT = (bf16_t*)lds;
  bf16_t* VT = (bf16_t*)(lds + 18432);
  float* wsv = (float*)(lds + 55296);
  for (int u = bid; u < 512; u += nblk) {
    int tid = tid_in; asm volatile("" : "+v"(tid));
    const int lane = tid & 63, wave = tid >> 6, r = lane & 31, h = lane >> 5;
    const int bh = u >> 5, c = u & 31, b = bh >> 2, hh = bh & 3;
    const int t0 = b * 2048 + c * 64;
    __syncthreads();
    if (wave == 0) {
      float li, bc; gates64(p, t0, hh, lane, li, bc);
      const float bL = __shfl(bc, 63);
      wsv[lane] = expf(bL - bc + li);
      if (lane == 0) DEC[u] = expf(bL);
    }
    __syncthreads();
#pragma unroll
    for (int i = 0; i < 2; ++i) { const int q = tid + 512 * i, s = q >> 4, c8 = q & 15; float o8[8];
      conv8(p, PB, b, c * 64 + s, 3584 + hh * 128 + c8 * 8, 512 + hh * 128 + c8 * 8, o8);
      const float w = wsv[s] * 0.08838834764831845f;
#pragma unroll
      for (int j = 0; j < 8; ++j) KwT[(c8 * 8 + j) * 72 + s] = f2bf1(o8[j] * w); }
    stage_vt256(PB, VT, t0, hh, tid);
    __syncthreads();
    f32x16 acc[4];
#pragma unroll
    for (int d = 0; d < 4; ++d) acc[d] = zero16();
#pragma unroll
    for (int ks = 0; ks < 4; ++ks) { const bf16x8 a = *(const bf16x8*)(VT + (wave * 32 + r) * 72 + 16 * ks + 8 * h);
#pragma unroll
      for (int d = 0; d < 4; ++d) { const bf16x8 bb = *(const bf16x8*)(KwT + (d * 32 + r) * 72 + 16 * ks + 8 * h); acc[d] = mfma32(a, bb, acc[d]); } }
    float* C = CST + (size_t)u * 32768;
#pragma unroll
    for (int d = 0; d < 4; ++d)
#pragma unroll
      for (int i = 0; i < 16; ++i) C[(wave * 32 + crow(i, h)) * 128 + d * 32 + r] = acc[d][i];
    if (tid < 128) { float s = 0.f; for (int ss = 0; ss < 64; ++ss) s += bf2f(KwT[tid * 72 + ss]); NST[u * 128 + tid] = s; }
  }
}
DI void phase_scan(const Params& p, int bid, int nblk, int tid) {
  float* CST = (float*)(p.ws + OFF_CST); float* NST = (float*)(p.ws + OFF_NST); const float* DEC = (const float*)(p.ws + OFF_DEC);
  for (int e = bid * 512 + tid; e < 16 * 32768 + 16 * 128; e += nblk * 512) {
    float* base; int bh; size_t stride;
    if (e < 524288) { bh = e >> 15; base = CST + (size_t)bh * 32 * 32768 + (e & 32767); stride = 32768; }
    else { const int e2 = e - 524288; bh = e2 >> 7; base = NST + (size_t)bh * 32 * 128 + (e2 & 127); stride = 128; }
    float v[32];
#pragma unroll
    for (int c = 0; c < 32; ++c) v[c] = base[c * stride];
    float carry = 0.f;
#pragma unroll
    for (int c = 0; c < 32; ++c) { const float d = DEC[bh * 32 + c]; base[c * stride] = carry; carry = d * carry + v[c]; }
  }
}
DI void phase_mlC(const Params& p, unsigned char* lds, int bid, int nblk, int tid_in) {
  const bf16_t* PB = (const bf16_t*)(p.ws + OFF_PB); bf16_t* MIX = (bf16_t*)(p.ws + OFF_MIX);
  const float* CST = (const float*)(p.ws + OFF_CST); const float* NST = (const float*)(p.ws + OFF_NST);
  bf16_t* Qs = (bf16_t*)lds;
  bf16_t* Ks = (bf16_t*)(lds + 17408);
  bf16_t* VT = (bf16_t*)(lds + 34816);
  bf16_t* CT = (bf16_t*)(lds + 71680);
  float* bvec = (float*)(lds + 141312);
  float* liv = bvec + 64; float* nvec = liv + 64; float* qn = nvec + 128;
  float* Hout = (float*)lds;
  for (int u = bid; u < 512; u += nblk) {
    int tid = tid_in; asm volatile("" : "+v"(tid));
    const int lane = tid & 63, wave = tid >> 6, r = lane & 31, h = lane >> 5;
    const int bh = u >> 5, c = u & 31, b = bh >> 2, hh = bh & 3;
    const int t0 = b * 2048 + c * 64;
    __syncthreads();
    if (wave == 0) { float li, bc; gates64(p, t0, hh, lane, li, bc); bvec[lane] = bc; liv[lane] = li; }
    if (tid >= 64 && tid < 192) nvec[tid - 64] = NST[u * 128 + tid - 64];
#pragma unroll 1
    for (int i = 0; i < 2; ++i) { const int q = tid + 512 * i, s = q >> 4, c8 = q & 15; float o8[8];
      conv8(p, PB, b, c * 64 + s, 3072 + hh * 128 + c8 * 8, hh * 128 + c8 * 8, o8);
      u32x4 ov; ov[0] = pk2(o8[0], o8[1]); ov[1] = pk2(o8[2], o8[3]); ov[2] = pk2(o8[4], o8[5]); ov[3] = pk2(o8[6], o8[7]);
      *(u32x4*)(Qs + s * 136 + c8 * 8) = ov;
      conv8(p, PB, b, c * 64 + s, 3584 + hh * 128 + c8 * 8, 512 + hh * 128 + c8 * 8, o8);
      const float w = 0.08838834764831845f;
      ov[0] = pk2(o8[0] * w, o8[1] * w); ov[1] = pk2(o8[2] * w, o8[3] * w); ov[2] = pk2(o8[4] * w, o8[5] * w); ov[3] = pk2(o8[6] * w, o8[7] * w);
      *(u32x4*)(Ks + s * 136 + c8 * 8) = ov; }
    stage_vt256(PB, VT, t0, hh, tid);
#pragma unroll 2
    for (int i = 0; i < 8; ++i) { const int q = tid + 512 * i, dv = q >> 4, c8 = q & 15; const float* src = CST + (size_t)u * 32768 + dv * 128 + c8 * 8;
      const f32x4 a = *(const f32x4*)src, bb = *(const f32x4*)(src + 4);
      u32x4 ov; ov[0] = pk2(a[0], a[1]); ov[1] = pk2(a[2], a[3]); ov[2] = pk2(bb[0], bb[1]); ov[3] = pk2(bb[2], bb[3]);
      *(u32x4*)(CT + dv * 136 + c8 * 8) = ov; }
    __syncthreads();
    { const int j = tid >> 3, seg = tid & 7; float s = 0.f;
#pragma unroll
      for (int d = 0; d < 16; ++d) s += bf2f(Qs[j * 136 + seg * 16 + d]) * nvec[seg * 16 + d];
      s += __shfl_xor(s, 1); s += __shfl_xor(s, 2); s += __shfl_xor(s, 4);
      if (seg == 0) qn[j] = s; }
    __syncthreads();
    f32x16 hv[2];
#pragma unroll
    for (int jt = 0; jt < 2; ++jt) {
      f32x16 st[2]; st[0] = zero16(); st[1] = zero16();
#pragma unroll 2
      for (int ks = 0; ks < 8; ++ks) { const bf16x8 bqf = *(const bf16x8*)(Qs + (jt * 32 + r) * 136 + 16 * ks + 8 * h);
#pragma unroll
        for (int s2 = 0; s2 < 2; ++s2) { const bf16x8 a = *(const bf16x8*)(Ks + (s2 * 32 + r) * 136 + 16 * ks + 8 * h); st[s2] = mfma32(a, bqf, st[s2]); } }
      const int jj = jt * 32 + r; const float bj = bvec[jj]; float rs = 0.f;
#pragma unroll
      for (int s2 = 0; s2 < 2; ++s2)
#pragma unroll
        for (int i = 0; i < 16; ++i) { const int s = s2 * 32 + crow(i, h); const float w = (s <= jj) ? __expf(bj - bvec[s] + liv[s]) : 0.f; const float v = st[s2][i] * w; st[s2][i] = v; rs += v; }
      rs += __shfl_xor(rs, 32);
      const float den = __expf(bj) * qn[jj] + rs;
      const float dinv = 1.0f / fmaxf(fabsf(den), 1.0f);
      f32x16 z = zero16();
#pragma unroll
      for (int s2 = 0; s2 < 2; ++s2) { const bf16x8 pf0 = pack8<0>(st[s2]), pf1 = pack8<1>(st[s2]);
        const bf16_t* vrow = VT + (wave * 32 + r) * 72 + s2 * 32 + 4 * h;
        const bf16x8 b0 = cat4(*(const s16x4*)(vrow), *(const s16x4*)(vrow + 8)), b1 = cat4(*(const s16x4*)(vrow + 16), *(const s16x4*)(vrow + 24));
        z = mfma32(pf0, b0, z); z = mfma32(pf1, b1, z); }
      f32x16 z2 = zero16();
#pragma unroll 2
      for (int ks = 0; ks < 8; ++ks) { const bf16x8 a = *(const bf16x8*)(Qs + (jt * 32 + r) * 136 + 16 * ks + 8 * h); const bf16x8 bb = *(const bf16x8*)(CT + (wave * 32 + r) * 136 + 16 * ks + 8 * h); z2 = mfma32(a, bb, z2); }
#pragma unroll
      for (int i = 0; i < 16; ++i) { const int jr = jt * 32 + crow(i, h); const float eb = __expf(bvec[jr]); const float di = __shfl(dinv, crow(i, h)); hv[jt][i] = (eb * z2[i] + z[i]) * di; }
    }
    __syncthreads();
#pragma unroll
    for (int jt = 0; jt < 2; ++jt)
#pragma unroll
      for (int i = 0; i < 16; ++i) Hout[(jt * 32 + crow(i, h)) * 256 + wave * 32 + r] = hv[jt][i];
    __syncthreads();
    { const int j = tid >> 3, seg = tid & 7; const size_t t = (size_t)t0 + j; float vals[32]; float ss = 0.f;
#pragma unroll
      for (int d = 0; d < 32; ++d) { vals[d] = Hout[j * 256 + seg * 32 + d]; ss += vals[d] * vals[d]; }
      ss += __shfl_xor(ss, 1); ss += __shfl_xor(ss, 2); ss += __shfl_xor(ss, 4);
      const float rstd = 1.0f / sqrtf(ss * (1.f / 256.f) + 1e-6f);
#pragma unroll
      for (int d8 = 0; d8 < 4; ++d8) {
        const int dv = seg * 32 + d8 * 8;
        const u32x4 og = *(const u32x4*)(PB + t * 6144 + 5120 + hh * 256 + dv);
        const f32x4 n0 = *(const f32x4*)(p.ml_norm + dv), n1 = *(const f32x4*)(p.ml_norm + dv + 4);
        float ov[8];
#pragma unroll
        for (int k = 0; k < 4; ++k) { const float g0 = bflo(og[k]), g1 = bfhi(og[k]);
          const float nn0 = (2 * k < 4) ? n0[(2 * k) & 3] : n1[(2 * k) & 3], nn1 = (2 * k + 1 < 4) ? n0[(2 * k + 1) & 3] : n1[(2 * k + 1) & 3];
          ov[2 * k] = vals[d8 * 8 + 2 * k] * rstd * nn0 / (1.f + __expf(-g0)); ov[2 * k + 1] = vals[d8 * 8 + 2 * k + 1] * rstd * nn1 / (1.f + __expf(-g1)); }
        u32x4 o4; o4[0] = pk2(ov[0], ov[1]); o4[1] = pk2(ov[2], ov[3]); o4[2] = pk2(ov[4], ov[5]); o4[3] = pk2(ov[6], ov[7]);
        *(u32x4*)(MIX + t * 2048 + 1024 + hh * 256 + dv) = o4;
      }
    }
  }
}
DI int f2key(float x) { const int b = __float_as_int(x); return b ^ ((b >> 31) & 0x7fffffff); }
DI float key2f(int k) { return __int_as_float(k ^ ((k >> 31) & 0x7fffffff)); }
DI void phase_topk(const Params& p, int bid, int nblk, int tid) {
  asm volatile("" : "+v"(tid));
  const int lane = tid & 63, wave = tid >> 6, r = lane & 31, h = lane >> 5;
  const bf16_t* QP = (const bf16_t*)(p.ws + OFF_QP); int* IDX = (int*)(p.ws + OFF_IDX); float* GW = (float*)(p.ws + OFF_GW);
  for (int unit = bid * 8 + wave; unit < 2048; unit += nblk * 8) {
    const int tt = unit >> 3, hd = unit & 7;
    const size_t t = (size_t)tt * 32 + r;
    int top[2][16];
#pragma unroll
    for (int c = 0; c < 2; ++c) {
      f32x16 acc[4];
#pragma unroll
      for (int nt = 0; nt < 4; ++nt) acc[nt] = zero16();
      const float* sk = p.sub_keys + (size_t)((hd * 2 + c) * 128) * 128;
      const bf16_t* qrow = QP + t * 2048 + (hd * 2 + c) * 128;
#pragma unroll 1
      for (int ks = 0; ks < 8; ++ks) {
        const bf16x8 bq = *(const bf16x8*)(qrow + 16 * ks + 8 * h);
#pragma unroll
        for (int nt = 0; nt < 4; ++nt) { const float* as = sk + (nt * 32 + r) * 128 + 16 * ks + 8 * h; const f32x4 a0 = *(const f32x4*)as, a1 = *(const f32x4*)(as + 4);
          u32x4 ap; ap[0] = pk2(a0[0], a0[1]); ap[1] = pk2(a0[2], a0[3]); ap[2] = pk2(a1[0], a1[1]); ap[3] = pk2(a1[2], a1[3]);
          acc[nt] = mfma32(__builtin_bit_cast(bf16x8, ap), bq, acc[nt]); }
      }
      int v[64];
#pragma unroll
      for (int nt = 0; nt < 4; ++nt)
#pragma unroll
        for (int i = 0; i < 16; ++i) v[nt * 16 + i] = (f2key(acc[nt][i]) & ~127) | (nt * 32 + crow(i, h));
#pragma unroll
      for (int k = 0; k < 16; ++k) {
        int m = v[0];
#pragma unroll
        for (int i = 1; i < 64; ++i) m = max(m, v[i]);
        m = max(m, __shfl_xor(m, 32));
        top[c][k] = m;
#pragma unroll
        for (int i = 0; i < 64; ++i) v[i] = (v[i] == m) ? (int)0x80000000 : v[i];
      }
    }
    float sa[16], sb[16]; int ia[16], ib[16];
#pragma unroll
    for (int k = 0; k < 16; ++k) { sa[k] = key2f(top[0][k] & ~127); ia[k] = top[0][k] & 127; sb[k] = key2f(top[1][k] & ~127); ib[k] = top[1][k] & 127; }
    constexpr int A0[25] = {0,0,0,0,0,0,0,0,0,0,0,0,0,0,0,0, 4,4,4, 6,6, 8,10,12,14};
    constexpr int B0[25] = {0,1,2,3,4,5,6,7,8,9,10,11,12,13,14,15, 0,1,2, 0,1, 0,0,0,0};
    constexpr int A1[25] = {1,1,1,1,1,1,1,1, 2,2,2,2,2, 3,3,3,3, 5,5, 7,7, 9,11,13,15};
    constexpr int B1[25] = {0,1,2,3,4,5,6,7, 0,1,2,3,4, 0,1,2,3, 0,1, 0,1, 0,0,0,0};
    int ck[25], ce[25];
#pragma unroll
    for (int k = 0; k < 25; ++k) {
      const float c0 = sa[A0[k]] + sb[B0[k]], c1 = sa[A1[k]] + sb[B1[k]];
      const int e0 = ia[A0[k]] * 128 + ib[B0[k]], e1 = ia[A1[k]] * 128 + ib[B1[k]];
      ck[k] = (f2key(h ? c1 : c0) & ~63) | (k + 25 * h);
      ce[k] = h ? e1 : e0;
    }
    float fv[16]; int fe[16];
#pragma unroll
    for (int k = 0; k < 16; ++k) {
      int m = ck[0];
#pragma unroll
      for (int i = 1; i < 25; ++i) m = max(m, ck[i]);
      m = max(m, __shfl_xor(m, 32));
      int se = 0;
#pragma unroll
      for (int i = 0; i < 25; ++i) { const bool hit = (ck[i] == m); se |= hit ? ce[i] : 0; ck[i] = hit ? (int)0x80000000 : ck[i]; }
      se |= __shfl_xor(se, 32);
      fv[k] = key2f(m & ~63); fe[k] = se;
    }
    const float mxv = fv[0];
    float sum = 0.f;
#pragma unroll
    for (int k = 0; k < 16; ++k) { fv[k] = expf(fv[k] - mxv); sum += fv[k]; }
    const float isum = 1.0f / sum;
#pragma unroll
    for (int k = 0; k < 16; ++k) { if (h == 0) { IDX[t * 128 + hd * 16 + k] = fe[k]; GW[t * 128 + hd * 16 + k] = fv[k] * isum; } }
  }
}
DI void up8(const u32x4 a, const u32x4 b, float (&f)[16]) {
#pragma unroll
  for (int k = 0; k < 4; ++k) { f[2 * k] = bflo(a[k]); f[2 * k + 1] = bfhi(a[k]); f[8 + 2 * k] = bflo(b[k]); f[8 + 2 * k + 1] = bfhi(b[k]); }
}
DI float gelu_exact(float x) { return 0.5f * x * (1.0f + erff(x * 0.70710678118654752f)); }
DI void gather_pair(const bf16_t* PU, const bf16_t* PV, int e0, int e1, float g0, float g1, int lane, const float (&hr)[32], float (&y)[32]) {
  const bf16_t* u0 = PU + (size_t)e0 * 2048 + lane * 8; const bf16_t* u1 = PU + (size_t)e1 * 2048 + lane * 8;
  const bf16_t* v0 = PV + (size_t)e0 * 2048 + lane * 8; const bf16_t* v1 = PV + (size_t)e1 * 2048 + lane * 8;
  u32x4 ur0[4], ur1[4], vr0[4], vr1[4];
#pragma unroll
  for (int q = 0; q < 4; ++q) { ur0[q] = *(const u32x4*)(u0 + q * 512); ur1[q] = *(const u32x4*)(u1 + q * 512); }
#pragma unroll
  for (int q = 0; q < 4; ++q) { vr0[q] = *(const u32x4*)(v0 + q * 512); vr1[q] = *(const u32x4*)(v1 + q * 512); }
  float d0 = 0.f, d1 = 0.f;
#pragma unroll
  for (int q = 0; q < 4; ++q)
#pragma unroll
    for (int k = 0; k < 4; ++k) { d0 += hr[q * 8 + 2 * k] * bflo(ur0[q][k]) + hr[q * 8 + 2 * k + 1] * bfhi(ur0[q][k]); d1 += hr[q * 8 + 2 * k] * bflo(ur1[q][k]) + hr[q * 8 + 2 * k + 1] * bfhi(ur1[q][k]); }
  d0 = wave_sum(d0); d1 = wave_sum(d1);
  const float w0 = g0 * gelu_exact(d0), w1 = g1 * gelu_exact(d1);
#pragma unroll
  for (int q = 0; q < 4; ++q)
#pragma unroll
    for (int k = 0; k < 4; ++k) { y[q * 8 + 2 * k] += w0 * bflo(vr0[q][k]) + w1 * bflo(vr1[q][k]); y[q * 8 + 2 * k + 1] += w0 * bfhi(vr0[q][k]) + w1 * bfhi(vr1[q][k]); }
}
DI void phase_gather(const Params& p, int bid, int nblk, int tid) {
  const int lane = tid & 63, wave = tid >> 6;
  const bf16_t* HB = (const bf16_t*)(p.ws + OFF_HB); const bf16_t* PU = (const bf16_t*)(p.ws + OFF_PU); const bf16_t* PV = (const bf16_t*)(p.ws + OFF_PV);
  const int* IDX = (const int*)(p.ws + OFF_IDX); const float* GW = (const float*)(p.ws + OFF_GW);
  const float* X1 = (const float*)(p.ws + OFF_X1); const float* MOD = (const float*)(p.ws + OFF_MOD);
  for (int t = bid * 8 + wave; t < T_; t += nblk * 8) {
    const int b = t >> 11;
    float hr[32], y[32];
#pragma unroll
    for (int q = 0; q < 4; ++q) { const u32x4 hv = *(const u32x4*)(HB + (size_t)t * 2048 + q * 512 + lane * 8);
#pragma unroll
      for (int k = 0; k < 4; ++k) { hr[q * 8 + 2 * k] = bflo(hv[k]); hr[q * 8 + 2 * k + 1] = bfhi(hv[k]); } }
#pragma unroll
    for (int i = 0; i < 32; ++i) y[i] = 0.f;
    const int ia = IDX[(size_t)t * 128 + lane], ib = IDX[(size_t)t * 128 + 64 + lane];
    const float ga = GW[(size_t)t * 128 + lane], gb = GW[(size_t)t * 128 + 64 + lane];
    for (int n = 0; n < 64; n += 2) {
      const int e0 = __builtin_amdgcn_readlane(ia, n), e1 = __builtin_amdgcn_readlane(ia, n + 1);
      const float g0 = __int_as_float(__builtin_amdgcn_readlane(__float_as_int(ga), n)), g1 = __int_as_float(__builtin_amdgcn_readlane(__float_as_int(ga), n + 1));
      gather_pair(PU, PV, e0, e1, g0, g1, lane, hr, y);
    }
    for (int n = 0; n < 64; n += 2) {
      const int e0 = __builtin_amdgcn_readlane(ib, n), e1 = __builtin_amdgcn_readlane(ib, n + 1);
      const float g0 = __int_as_float(__builtin_amdgcn_readlane(__float_as_int(gb), n)), g1 = __int_as_float(__builtin_amdgcn_readlane(__float_as_int(gb), n + 1));
      gather_pair(PU, PV, e0, e1, g0, g1, lane, hr, y);
    }
    const float* gt = MOD + b * 16384 + 5 * 2048; const float* sho = MOD + b * 16384 + 12288; const float* sco = sho + 2048;
    float ss = 0.f;
#pragma unroll
    for (int q = 0; q < 4; ++q)
#pragma unroll
      for (int hh = 0; hh < 2; ++hh) { const int e = q * 512 + lane * 8 + hh * 4; const f32x4 xv = *(const f32x4*)(X1 + (size_t)t * 2048 + e), g4 = *(const f32x4*)(gt + e);
#pragma unroll
        for (int k = 0; k < 4; ++k) { const float v = xv[k] + g4[k] * y[q * 8 + hh * 4 + k]; y[q * 8 + hh * 4 + k] = v; ss += v * v; } }
    ss = wave_sum(ss);
    const float rstd = 1.0f / sqrtf(ss * (1.f / 2048.f) + 1e-6f);
#pragma unroll
    for (int q = 0; q < 4; ++q)
#pragma unroll
      for (int hh = 0; hh < 2; ++hh) { const int e = q * 512 + lane * 8 + hh * 4; const f32x4 gf = *(const f32x4*)(p.g_final + e), s4 = *(const f32x4*)(sco + e), h4 = *(const f32x4*)(sho + e);
        f32x4 ov;
#pragma unroll
        for (int k = 0; k < 4; ++k) ov[k] = y[q * 8 + hh * 4 + k] * rstd * gf[k] * (1.f + s4[k]) + h4[k];
        *(f32x4*)(p.out + (size_t)t * 2048 + e) = ov; }
  }
}
#ifndef ONLY
#define ONLY -1
#endif
#define PH(k) ((ONLY < 0 || ONLY == (k)) && ph == (k))
__global__ void __launch_bounds__(512) mega(Params p, int ph_lo, int ph_hi) {
  extern __shared__ __attribute__((aligned(16))) unsigned char shm[];
  cg::grid_group grid = cg::this_grid();
  const int bid = blockIdx.x, nblk = gridDim.x, tid = threadIdx.x;
#define RUNPH(k, ...) if ((ONLY < 0 || ONLY == (k)) && ph_lo <= (k) && (k) <= ph_hi) { __VA_ARGS__ } if (ph_lo <= (k) && (k) < ph_hi) grid.sync();
  RUNPH(0, phase0(p, shm, bid, nblk, tid);)
  RUNPH(1, phase_norm<true>(p, p.x, p.g_mix, 0, 1, bid, nblk, tid);)
  RUNPH(2, pg8::Gemm g{(const bf16_t*)(p.ws + OFF_HB), (const bf16_t*)(p.ws + OFF_WINT), 8192, 6144, 2048}; pg8::StaticOrder S; S.init(8192, 6144, nblk, bid);
      EpiProj E{(bf16_t*)(p.ws + OFF_PB), (const float*)(p.ws + OFF_ROPE), (const float*)(p.ws + OFF_ROPE) + 65536};
      pg8::gemm_phase<EpiProj, pg8::StaticOrder, false>((PG8_LAS unsigned char*)shm, g, S, E, nullptr);)
  RUNPH(3, phase_attn(p, shm, bid, nblk, tid); phase_mlA(p, shm, bid, nblk, tid);)
  RUNPH(4, phase_scan(p, bid, nblk, tid);)
  RUNPH(5, phase_mlC(p, shm, bid, nblk, tid);)
  RUNPH(6, pg8::Gemm g{(const bf16_t*)(p.ws + OFF_MIX), (const bf16_t*)(p.ws + OFF_WOUTT), 8192, 2048, 2048}; pg8::StaticOrder S; S.init(8192, 2048, nblk, bid);
      EpiRes E{(float*)(p.ws + OFF_X1), p.x, (const float*)(p.ws + OFF_MOD)};
      pg8::gemm_phase<EpiRes, pg8::StaticOrder, false>((PG8_LAS unsigned char*)shm, g, S, E, nullptr);)
  RUNPH(7, phase_norm<false>(p, (const float*)(p.ws + OFF_X1), p.g_ffn, 3, 4, bid, nblk, tid);)
  RUNPH(8, pg8::Gemm g{(const bf16_t*)(p.ws + OFF_HB), (const bf16_t*)(p.ws + OFF_WPQT), 8192, 2048, 2048}; pg8::StaticOrder S; S.init(8192, 2048, nblk, bid);
      EpiBf E{(bf16_t*)(p.ws + OFF_QP)};
      pg8::gemm_phase<EpiBf, pg8::StaticOrder, false>((PG8_LAS unsigned char*)shm, g, S, E, nullptr);)
  RUNPH(9, phase_topk(p, bid, nblk, tid);)
  RUNPH(10, phase_gather(p, bid, nblk, tid);)
}
#ifndef MK_ONE_LAUNCH
#define MK_ONE_LAUNCH 0
#endif
extern "C" void kernel_launch(void* const* d_in, const int* in_sizes, int n_in, void* d_out, int out_size, void* d_ws, size_t ws_size, hipStream_t stream) {
  (void)in_sizes; (void)n_in; (void)out_size;
  if (ws_size < WS_TOTAL) { fprintf(stderr, "kernel_launch: workspace too small (%zu < %zu)\n", ws_size, (size_t)WS_TOTAL); return; }
  Params p{};
  const float** f = (const float**)&p;
  for (int i = 0; i < 25; ++i) f[i] = (const float*)d_in[i];
  p.out = (float*)d_out; p.ws = (unsigned char*)d_ws;
  static bool attr_set = false;
  if (!attr_set) { if (hipFuncSetAttribute((const void*)mega, hipFuncAttributeMaxDynamicSharedMemorySize, LDS_BYTES) != hipSuccess) { fprintf(stderr, "kernel_launch: hipFuncSetAttribute failed\n"); return; } attr_set = true; }
  (void)hipMemsetAsync((unsigned char*)d_ws + OFF_CTL, 0, 4096, stream);
#if MK_ONE_LAUNCH
  int lo = 0, hi = 10; void* args[] = {&p, &lo, &hi};
  hipError_t e = hipLaunchCooperativeKernel((const void*)mega, dim3(256), dim3(512), args, LDS_BYTES, stream);
  if (e != hipSuccess) fprintf(stderr, "cooperative launch failed: %s\n", hipGetErrorString(e));
#else
  for (int ph = 0; ph <= 10; ++ph) hipLaunchKernelGGL(mega, dim3(256), dim3(512), LDS_BYTES, stream, p, ph, ph);
#endif
}
```

```cpp
#include <hip/hip_runtime.h>
#include <hip/hip_cooperative_groups.h>
#include <cstdio>
#include <cstdint>
namespace cg = cooperative_groups;
#define DI __device__ __forceinline__
namespace pg8 {
#define PG8_LAS __attribute__((address_space(3)))
typedef unsigned short bf16_t;
typedef short bf16x8 __attribute__((ext_vector_type(8)));
typedef float f32x4 __attribute__((ext_vector_type(4)));
typedef unsigned u32x4 __attribute__((ext_vector_type(4)));
constexpr int BM = 256, BK = 64, HALF = 128, HTB = HALF * BK * 2  , STAGE_BYTES = 8 * HTB, NXCD = 8, WGM = 8;

__host__ __device__ __forceinline__ int lds_byte(int r, int c) { const int st = (r >> 4) * 2 + (c >> 5), rr = r & 15, cc = c & 31, ob = rr * 64 + cc * 2; return st * 1024 + (ob ^ (((ob >> 9) & 1) << 5)); }
__host__ __device__ __forceinline__ void stage_rc(int b, int& R, int& C) { const int st = b / 1024, sb = b % 1024, swz = sb ^ (((sb >> 9) & 1) << 5); R = (st >> 1) * 16 + swz / 64; C = (st & 1) * 32 + (swz % 64) / 2; }
__host__ __device__ __forceinline__ int perm32(int rho) { const int n = rho >> 4, i = rho & 15; return 8 * (i >> 2) + 4 * n + (i & 3); }

struct Unit { int pm, pn; };
struct Gemm { const bf16_t* A; const bf16_t* Bt; int M, N, K; };

struct StaticOrder {
    int nM, nN, nwg, G, c;
    __host__ __device__ void init(int M, int N, int G_, int c_) { nM = M / BM; nN = N / BM; nwg = nM * nN; G = G_; c = c_; }
    __host__ __device__ bool next(int i, Unit& u) const {
        const long L = (long)i * G + c; if (L >= nwg) return false;
        int wgid = (int)L; { const int q = nwg / NXCD, r = nwg % NXCD, xcd = wgid % NXCD, off = wgid / NXCD; wgid = (xcd < r ? xcd * (q + 1) : r * (q + 1) + (xcd - r) * q) + off; }
        const int nig = WGM * nN, gid = wgid / nig, fm = gid * WGM, gsz = (nM - fm) < WGM ? (nM - fm) : WGM;
        u.pm = fm + ((wgid % nig) % gsz); u.pn = (wgid % nig) / gsz; return true;
    }
    __device__ __forceinline__ void a_ready(const Unit&) const {}
    __device__ __forceinline__ void done(const Unit&) const {}
};
template <class Epi, class Sched, bool STAMP = false>
__device__ __forceinline__ void gemm_phase(PG8_LAS unsigned char* lds, const Gemm g, const Sched& S, const Epi& E, unsigned long long* stamps) {
    const int tid = threadIdx.x, wid = __builtin_amdgcn_readfirstlane(tid >> 6), lane = tid & 63, wr = wid >> 2, wc = wid & 3, fr = lane & 15, fq = lane >> 4;
    const int K = g.K, nt = K / BK;
    int ts_lo = 0, ts_hi = 0, nts = 0; const unsigned long long rt_entry = STAMP ? (unsigned long long)wall_clock64() : 0ull;
#define PG8_STAMP() do { if (STAMP && wid == 0 && nts < 64) { const unsigned long long _c = (unsigned long long)clock64(); \
        ts_lo = (lane == nts) ? (int)(unsigned)_c : ts_lo; ts_hi = (lane == nts) ? (int)(unsigned)(_c >> 32) : ts_hi; ++nts; } } while (0)
    PG8_STAMP();
    unsigned voffA[2], voffB[2];
#pragma unroll
    for (int i = 0; i < 2; ++i) { int R, C; stage_rc(tid * 16 + i * 8192, R, C); const int Rb = Epi::PERM ? ((R & ~31) + perm32(R & 31)) : R;
        voffA[i] = (unsigned)(R * K + C) * 2u; voffB[i] = (unsigned)(Rb * K + C) * 2u; }
    const size_t kstep = (size_t)(BK * 2);
    const size_t hstep = (size_t)HALF * K * 2;
    const size_t tstep = 2 * hstep;
    const unsigned ldsw = (unsigned)wid * 1024u;
    const int aoff = lds_byte(wr * 64 + fr, fq * 8), boff = lds_byte(wc * 32 + fr, fq * 8);
#define PG8_SA(b, h) (((b) * 2 + (h)) * HTB)
#define PG8_SB(b, h) ((4 + (b) * 2 + (h)) * HTB)
#define PG8_STAGE(bufoff, gbase, voff) do { _Pragma("unroll") for (int _i = 0; _i < 2; ++_i) \
        __builtin_amdgcn_global_load_lds((const unsigned*)((const char*)(gbase) + (voff)[_i]), (PG8_LAS unsigned*)(lds + (bufoff) + ldsw + _i * 8192), 16, 0, 0); } while (0)
#define PG8_LDA(dst, b, h) do { _Pragma("unroll") for (int m = 0; m < 4; ++m) _Pragma("unroll") for (int k = 0; k < 2; ++k) dst[m][k] = *(const PG8_LAS bf16x8*)(lds + PG8_SA(b, h) + aoff + m * 2048 + k * 1024); } while (0)
#define PG8_LDB(dst, b, h) do { _Pragma("unroll") for (int n = 0; n < 2; ++n) _Pragma("unroll") for (int k = 0; k < 2; ++k) dst[n][k] = *(const PG8_LAS bf16x8*)(lds + PG8_SB(b, h) + boff + n * 2048 + k * 1024); } while (0)
#define PG8_MMA(ai, bj, At, Bt) do { __builtin_amdgcn_s_setprio(1); _Pragma("unroll") for (int m = 0; m < 4; ++m) _Pragma("unroll") for (int n = 0; n < 2; ++n) _Pragma("unroll") for (int k = 0; k < 2; ++k) \
        acc[ai][bj][m][n] = __builtin_amdgcn_mfma_f32_16x16x32_bf16(Bt[n][k], At[m][k], acc[ai][bj][m][n], 0, 0, 0); __builtin_amdgcn_s_setprio(0); } while (0)
#define PG8_WAIT_V(n) asm volatile("s_waitcnt vmcnt(" #n ")" ::: "memory")
#define PG8_WAIT_L(n) asm volatile("s_waitcnt lgkmcnt(" #n ")" ::: "memory")
#define PG8_BAR __builtin_amdgcn_s_barrier()
#define PG8_SCHED __builtin_amdgcn_sched_barrier(0)
    Unit cur, nxt; int ui = 0;
    if (!S.next(0, cur)) return;
    f32x4 acc[2][2][4][2];
#pragma unroll
    for (int a = 0; a < 2; ++a)
#pragma unroll
        for (int b = 0; b < 2; ++b)
#pragma unroll
            for (int m = 0; m < 4; ++m)
#pragma unroll
                for (int n = 0; n < 2; ++n) acc[a][b][m][n] = (f32x4){0.f, 0.f, 0.f, 0.f};
    bf16x8 At[4][2], B0[2][2], B1[2][2];
    const char* cA = (const char*)g.A + (size_t)cur.pm * tstep; const char* cB = (const char*)g.Bt + (size_t)cur.pn * tstep;
    S.a_ready(cur);
    PG8_STAGE(PG8_SB(0, 0), cB, voffB); PG8_STAGE(PG8_SA(0, 0), cA, voffA); PG8_STAGE(PG8_SB(0, 1), cB + hstep, voffB); PG8_STAGE(PG8_SA(0, 1), cA + hstep, voffA);
    if (wr == 1) PG8_BAR;
    PG8_WAIT_V(4); PG8_BAR;
    PG8_STAGE(PG8_SB(1, 0), cB + kstep, voffB); PG8_STAGE(PG8_SA(1, 0), cA + kstep, voffA); PG8_STAGE(PG8_SB(1, 1), cB + hstep + kstep, voffB);
    PG8_WAIT_V(6); PG8_BAR;
    PG8_STAMP();
    for (;;) {
        const bool has_next = S.next(ui + 1, nxt);
        const char* nA = has_next ? (const char*)g.A + (size_t)nxt.pm * tstep : cA; const char* nB = has_next ? (const char*)g.Bt + (size_t)nxt.pn * tstep : cB;
        for (int t = 0; t < nt; t += 2) {
            const bool last = (t == nt - 2);
            const char* a1 = cA + (size_t)(t + 1) * kstep;
            const char* a2 = last ? nA : cA + (size_t)(t + 2) * kstep; const char* b2 = last ? nB : cB + (size_t)(t + 2) * kstep;
            const char* a3 = a2 + kstep; const char* b3 = b2 + kstep;
            if (last && has_next) S.a_ready(nxt);
            PG8_LDB(B0, 0, 0); PG8_SCHED; PG8_LDA(At, 0, 0); PG8_STAGE(PG8_SA(1, 1), a1 + hstep, voffA);
            PG8_WAIT_L(8); PG8_BAR; PG8_WAIT_L(0); PG8_MMA(0, 0, At, B0); PG8_BAR; PG8_SCHED;
            PG8_LDB(B1, 0, 1); PG8_STAGE(PG8_SB(0, 0), b2, voffB);
            PG8_BAR; PG8_WAIT_L(0); PG8_MMA(0, 1, At, B1); PG8_BAR;
            PG8_LDA(At, 0, 1); PG8_STAGE(PG8_SA(0, 0), a2, voffA);
            PG8_BAR; PG8_WAIT_L(0); PG8_MMA(1, 0, At, B0); PG8_BAR; PG8_SCHED;
            PG8_STAGE(PG8_SB(0, 1), b2 + hstep, voffB);
            PG8_WAIT_V(6); PG8_BAR; PG8_MMA(1, 1, At, B1); PG8_BAR;
            PG8_LDB(B0, 1, 0); PG8_SCHED; PG8_LDA(At, 1, 0); PG8_STAGE(PG8_SA(0, 1), a2 + hstep, voffA);
            PG8_WAIT_L(8); PG8_BAR; PG8_WAIT_L(0); PG8_MMA(0, 0, At, B0); PG8_BAR; PG8_SCHED;
            PG8_LDB(B1, 1, 1); PG8_STAGE(PG8_SB(1, 0), b3, voffB);
            PG8_BAR; PG8_WAIT_L(0); PG8_MMA(0, 1, At, B1); PG8_BAR;
            PG8_LDA(At, 1, 1); PG8_STAGE(PG8_SA(1, 0), a3, voffA);
            PG8_BAR; PG8_WAIT_L(0); PG8_MMA(1, 0, At, B0); PG8_BAR; PG8_SCHED;
            PG8_STAGE(PG8_SB(1, 1), b3 + hstep, voffB);
            PG8_WAIT_V(6); PG8_BAR; PG8_MMA(1, 1, At, B1); PG8_BAR;
        }
        PG8_STAMP();
        if constexpr (!Epi::AFTER_DRAIN) { E(acc, cur, wr, wc, fr, fq); S.done(cur); }
        PG8_STAMP();
        if (!has_next) break;
#pragma unroll
        for (int a = 0; a < 2; ++a)
#pragma unroll
            for (int b = 0; b < 2; ++b)
#pragma unroll
                for (int m = 0; m < 4; ++m)
#pragma unroll
                    for (int n = 0; n < 2; ++n) acc[a][b][m][n] = (f32x4){0.f, 0.f, 0.f, 0.f};
        cur = nxt; cA = nA; cB = nB; ++ui;
    }
    PG8_WAIT_V(0);
    if (wr == 0) PG8_BAR;
    PG8_BAR;
    if constexpr (Epi::AFTER_DRAIN) { E.fused(acc, cur, wr, wc, fr, fq, lds, wid, lane); S.done(cur); }
    PG8_STAMP();
    if (STAMP && wid == 0) { stamps[lane] = lane < nts ? (((unsigned long long)(unsigned)ts_hi << 32) | (unsigned)ts_lo) : 0ull;
        if (lane == 62) stamps[62] = rt_entry; if (lane == 63) stamps[63] = (unsigned long long)wall_clock64(); }
#undef PG8_STAMP
#undef PG8_SA
#undef PG8_SB
#undef PG8_STAGE
#undef PG8_LDA
#undef PG8_LDB
#undef PG8_MMA
#undef PG8_WAIT_V
#undef PG8_WAIT_L
#undef PG8_BAR
#undef PG8_SCHED
}
}
using pg8::bf16_t; using pg8::bf16x8; using pg8::f32x4; using pg8::u32x4;
typedef short s16x4 __attribute__((ext_vector_type(4)));
typedef float f32x16 __attribute__((ext_vector_type(16)));
typedef float f32x2 __attribute__((ext_vector_type(2)));
typedef unsigned u32x2 __attribute__((ext_vector_type(2)));
typedef int i32x4 __attribute__((ext_vector_type(4)));
typedef __bf16 bfv2 __attribute__((ext_vector_type(2)));

constexpr int T_ = 8192, D_ = 2048;
constexpr size_t OFF_CTL = 0;
constexpr size_t OFF_MOD = 16384;
constexpr size_t OFF_ROPE = OFF_MOD + 262144;
constexpr size_t OFF_WG = OFF_ROPE + 524288;
constexpr size_t OFF_GATES = OFF_WG + 65536;
constexpr size_t OFF_IDX = OFF_GATES + 262144;
constexpr size_t OFF_GW = OFF_IDX + 4194304;
constexpr size_t OFF_NST = OFF_GW + 4194304;
constexpr size_t OFF_DEC = OFF_NST + 262144;
constexpr size_t OFF_SU = OFF_DEC + 4096;
constexpr size_t OFF_SV = OFF_SU + 65536;
constexpr size_t OFF_AACC = OFF_SV + 65536;
constexpr size_t OFF_SKB = OFF_AACC + 4194304;
constexpr size_t OFF_WINT = OFF_SKB + 524288;
constexpr size_t OFF_WOUTT = OFF_WINT + 25165824;
constexpr size_t OFF_WPQT = OFF_WOUTT + 8388608;
constexpr size_t OFF_PU = OFF_WPQT + 8388608;
constexpr size_t OFF_PV = OFF_PU + 67108864;
constexpr size_t OFF_HB = OFF_PV + 67108864;
constexpr size_t OFF_PB = OFF_HB + 33554432;
constexpr size_t OFF_X1 = OFF_PB;
constexpr size_t OFF_QP = OFF_PB + 67108864;
constexpr size_t OFF_MIX = OFF_PB + 100663296;
constexpr size_t OFF_CST = OFF_MIX + 33554432;
constexpr size_t OFF_PA = OFF_QP;
constexpr size_t OFF_Y = OFF_CST;
constexpr size_t WS_TOTAL = OFF_CST + 67108864;
constexpr int LDS_BYTES = 147456;

struct Params {
  const float *x, *c, *w_ada, *b_ada, *g_mix, *w_in, *conv_w, *conv_b, *b_igate, *b_fgate,
              *lq1, *lk1, *lq2, *lk2, *da_norm, *ml_norm, *w_out, *g_ffn, *w_pq, *sub_keys,
              *peer_u, *peer_v, *w_ada_final, *b_ada_final, *g_final;
  float* out;
  unsigned char* ws;
};

DI unsigned pk2(float lo, float hi) { f32x2 v = {lo, hi}; bfv2 r = __builtin_convertvector(v, bfv2); return __builtin_bit_cast(unsigned, r); }
DI float bflo(unsigned u) { return __uint_as_float(u << 16); }
DI float bfhi(unsigned u) { return __uint_as_float(u & 0xffff0000u); }
DI float bf2f(bf16_t b) { return __uint_as_float(((unsigned)b) << 16); }
DI float wave_sum(float v) {
#pragma unroll
  for (int o = 1; o < 64; o <<= 1) v += __shfl_xor(v, o);
  return v;
}
DI f32x16 mfma32(bf16x8 a, bf16x8 b, f32x16 c) { return __builtin_amdgcn_mfma_f32_32x32x16_bf16(a, b, c, 0, 0, 0); }
DI int crow(int i, int h) { return (i & 3) + 8 * (i >> 2) + 4 * h; }
template <int S> DI bf16x8 pack8(const f32x16& x) {
  u32x4 p; p[0] = pk2(x[8 * S], x[8 * S + 1]); p[1] = pk2(x[8 * S + 2], x[8 * S + 3]); p[2] = pk2(x[8 * S + 4], x[8 * S + 5]); p[3] = pk2(x[8 * S + 6], x[8 * S + 7]);
  return __builtin_bit_cast(bf16x8, p);
}
DI bf16x8 cat4(s16x4 lo, s16x4 hi) { return __builtin_shufflevector(lo, hi, 0, 1, 2, 3, 4, 5, 6, 7); }
DI f32x16 zero16() { f32x16 z; for (int i = 0; i < 16; ++i) z[i] = 0.f; return z; }
#define LDS_WAIT() asm volatile("s_waitcnt lgkmcnt(0)" ::: "memory")
DI int newpos_in(int o) { if (o >= 2048) return o; const int hd = o >> 6, j = o & 63; return hd * 64 + (j < 32 ? 2 * j : 2 * (j - 32) + 1); }
DI void transpose_item(const float* W, int ldw, int nblk, bf16_t* WT, int K, float* scr, int item, int lane, bool perm) {
  const int kb = item / nblk, nb = item % nblk, k0 = 64 * kb, n0 = 32 * nb;
#pragma unroll 8
  for (int i = 0; i < 32; ++i) { const int kk = 2 * i + (lane >> 5); scr[kk * 33 + (lane & 31)] = W[(size_t)(k0 + kk) * ldw + n0 + (lane & 31)]; }
  LDS_WAIT();
  const int c = lane & 7;
#pragma unroll
  for (int j = 0; j < 4; ++j) { const int n = (lane >> 3) + 8 * j; const float* s = scr + (8 * c) * 33 + n;
    u32x4 o; o[0] = pk2(s[0 * 33], s[1 * 33]); o[1] = pk2(s[2 * 33], s[3 * 33]); o[2] = pk2(s[4 * 33], s[5 * 33]); o[3] = pk2(s[6 * 33], s[7 * 33]);
    const int orow = perm ? newpos_in(n0 + n) : (n0 + n);
    *(u32x4*)(WT + (size_t)orow * K + k0 + 8 * c) = o; }
  LDS_WAIT();
}
#define CPR_LOAD(dst, rowx) { const int r_ = (rowx); const float* src_ = (r_ < 16384 ? p.peer_u + (size_t)r_ * 2048 : p.peer_v + (size_t)(r_ - 16384) * 2048); \
    _Pragma("unroll") for (int j_ = 0; j_ < 8; ++j_) dst[j_] = *(const f32x4*)(src_ + (j_ >> 2) * 1024 + lane * 16 + (j_ & 3) * 4); }
DI void convert_peer_rows(const Params& p, int gw, int NGW, int lane) {
  unsigned char* PU8 = (unsigned char*)(p.ws + OFF_PU); unsigned char* PV8 = (unsigned char*)(p.ws + OFF_PV);
  float* SU = (float*)(p.ws + OFF_SU); float* SV = (float*)(p.ws + OFF_SV);
  if (gw >= 32768) return;
  f32x4 va[8], vb[8];
  CPR_LOAD(va, gw);
  CPR_LOAD(vb, (gw + NGW < 32768) ? gw + NGW : gw);
  for (int row = gw; row < 32768; row += NGW) {
    const bool isu = row < 16384; const int rr = isu ? row : row - 16384;
    f32x4 v[8]; float am = 0.f;
#pragma unroll
    for (int j = 0; j < 8; ++j) { v[j] = va[j]; va[j] = vb[j]; am = fmaxf(am, fmaxf(fmaxf(fabsf(v[j][0]), fabsf(v[j][1])), fmaxf(fabsf(v[j][2]), fabsf(v[j][3])))); }
    CPR_LOAD(vb, (row + 2 * NGW < 32768) ? row + 2 * NGW : row);
#pragma unroll
    for (int o = 1; o < 64; o <<= 1) am = fmaxf(am, __shfl_xor(am, o));
    const float sc = am > 0.f ? 448.0f / am : 1.0f, inv = am > 0.f ? am * (1.0f / 448.0f) : 1.0f;
#pragma unroll
    for (int q = 0; q < 2; ++q) { u32x4 o4;
#pragma unroll
      for (int k = 0; k < 4; ++k) { const f32x4 a = v[q * 4 + k] * sc; int r = __builtin_amdgcn_cvt_pk_fp8_f32(a[0], a[1], 0, false); r = __builtin_amdgcn_cvt_pk_fp8_f32(a[2], a[3], r, true); o4[k] = (unsigned)r; }
      *(u32x4*)((isu ? PU8 : PV8) + ((size_t)(q * 4 + (lane >> 4)) * 16384 + rr) * 256 + (lane & 15) * 16) = o4; }
    if (lane == 0) (isu ? SU : SV)[rr] = inv;
  }
}
#undef CPR_LOAD
DI void phase0(const Params& p, unsigned char* lds, int bid, int nblk, int tid) {
  const int lane = tid & 63, wave = tid >> 6;
  float* MOD = (float*)(p.ws + OFF_MOD);
  float* cs = (float*)lds;
  float* red = (float*)(lds + 32768);
  for (int item = bid; item < 256; item += nblk) {
    const int col0 = item * 64;
    __syncthreads();
    for (int i = tid; i < 8192; i += 512) { const float v = p.c[i]; cs[i] = v / (1.f + expf(-v)); }
    __syncthreads();
    const int cg = tid & 15, dg = tid >> 4;
    const int col = col0 + cg * 4;
    const float* W; int ldw, wc; const float* bb;
    if (col < 12288) { W = p.w_ada; ldw = 12288; wc = col; bb = p.b_ada + col0; } else { W = p.w_ada_final; ldw = 4096; wc = col - 12288; bb = p.b_ada_final + (col0 - 12288); }
    f32x4 acc[4];
#pragma unroll
    for (int b = 0; b < 4; ++b) acc[b] = (f32x4){0.f, 0.f, 0.f, 0.f};
#pragma unroll 8
    for (int i = 0; i < 64; ++i) {
      const int d = dg * 64 + i;
      const f32x4 w = *(const f32x4*)(W + (size_t)d * ldw + wc);
#pragma unroll
      for (int b = 0; b < 4; ++b) acc[b] += cs[b * 2048 + d] * w;
    }
#pragma unroll
    for (int b = 0; b < 4; ++b) *(f32x4*)(red + (dg * 4 + b) * 64 + cg * 4) = acc[b];
    __syncthreads();
    if (tid < 256) { const int b = tid >> 6, cc = tid & 63; float sm = bb[cc];
      for (int g = 0; g < 32; ++g) sm += red[(g * 4 + b) * 64 + cc];
      MOD[b * 16384 + col0 + cc] = sm; }
  }
  __syncthreads();
  float* scr = (float*)(lds + 65536 + wave * 8448);
  const int gw = bid * 8 + wave, NGW = nblk * 8;
  constexpr int I_IN = 32 * 192, I_O = 32 * 64;
  bf16_t* WINT = (bf16_t*)(p.ws + OFF_WINT); bf16_t* WOUTT = (bf16_t*)(p.ws + OFF_WOUTT); bf16_t* WPQT = (bf16_t*)(p.ws + OFF_WPQT);
  for (int it = gw; it < I_IN + 2 * I_O; it += NGW) {
    if (it < I_IN) transpose_item(p.w_in, 6152, 192, WINT, 2048, scr, it, lane, true);
    else if (it < I_IN + I_O) transpose_item(p.w_out, 2048, 64, WOUTT, 2048, scr, it - I_IN, lane, false);
    else transpose_item(p.w_pq, 2048, 64, WPQT, 2048, scr, it - I_IN - I_O, lane, false);
  }
  {
    bf16_t* SKB = (bf16_t*)(p.ws + OFF_SKB);
    for (int i = bid * 512 + tid; i < 32768; i += nblk * 512) { const f32x4 a0 = *(const f32x4*)(p.sub_keys + (size_t)i * 8), a1 = *(const f32x4*)(p.sub_keys + (size_t)i * 8 + 4);
      u32x4 ap; ap[0] = pk2(a0[0], a0[1]); ap[1] = pk2(a0[2], a0[3]); ap[2] = pk2(a1[0], a1[1]); ap[3] = pk2(a1[2], a1[3]); *(u32x4*)(SKB + (size_t)i * 8) = ap; }
    float* WG = (float*)(p.ws + OFF_WG);
    for (int i = bid * 512 + tid; i < 16384; i += nblk * 512) { const int j = i >> 11, k = i & 2047; WG[i] = p.w_in[(size_t)k * 6152 + 6144 + j]; }
  }
}
template <bool GATES> DI void phase_norm(const Params& p, const float* src, const float* gvec, int sh_idx, int sc_idx, int bid, int nblk, int tid, unsigned char* lds) {
  const int lane = tid & 63, wave = tid >> 6;
  float* WGs = (float*)lds;
  if (GATES) {
    const float* WGg = (const float*)(p.ws + OFF_WG);
#pragma unroll
    for (int i = 0; i < 8; ++i) { const int e4 = (tid + 512 * i) * 4, j = e4 >> 11, e = e4 & 2047, r = e >> 9, ln = (e & 511) >> 3, q = (e >> 2) & 1;
      *(f32x4*)(WGs + j * 2048 + r * 512 + q * 256 + ln * 4) = *(const f32x4*)(WGg + e4); }
    __syncthreads();
  }
  float* G1s = (float*)(lds + 65536); float* SHs = (float*)(lds + 98304);
  { const float* MODg = (const float*)(p.ws + OFF_MOD);
#pragma unroll 1
    for (int i = 0; i < 4; ++i) { const int e4 = (tid + 512 * i) * 4, b = e4 >> 11, e = e4 & 2047, r = e >> 9, ln = (e & 511) >> 3, q = (e >> 2) & 1;
      const f32x4 g4 = *(const f32x4*)(gvec + e), sc4 = *(const f32x4*)(MODg + b * 16384 + sc_idx * 2048 + e), sh4 = *(const f32x4*)(MODg + b * 16384 + sh_idx * 2048 + e);
      *(f32x4*)(G1s + b * 2048 + r * 512 + q * 256 + ln * 4) = g4 * (1.f + sc4); *(f32x4*)(SHs + b * 2048 + r * 512 + q * 256 + ln * 4) = sh4; }
    __syncthreads(); }
  const float* MOD = (const float*)(p.ws + OFF_MOD);
  bf16_t* HB = (bf16_t*)(p.ws + OFF_HB);
  const float* WG = (const float*)(p.ws + OFF_WG);
  float* GT = (float*)(p.ws + OFF_GATES);
  for (int t = bid * 8 + wave; t < T_; t += nblk * 8) {
    const int b = t >> 11;
    const float* xr = src + (size_t)t * 2048;
    f32x4 v[8];
    float ss = 0.f;
#pragma unroll
    for (int r = 0; r < 4; ++r) {
      v[2 * r] = *(const f32x4*)(xr + r * 512 + lane * 8); v[2 * r + 1] = *(const f32x4*)(xr + r * 512 + lane * 8 + 4);
#pragma unroll
      for (int q = 0; q < 2; ++q) ss += v[2 * r + q][0] * v[2 * r + q][0] + v[2 * r + q][1] * v[2 * r + q][1] + v[2 * r + q][2] * v[2 * r + q][2] + v[2 * r + q][3] * v[2 * r + q][3];
    }
    ss = wave_sum(ss);
    const float rstd = 1.0f / sqrtf(ss * (1.f / 2048.f) + 1e-6f);
    const float* sh = MOD + b * 16384 + sh_idx * 2048; const float* sc = MOD + b * 16384 + sc_idx * 2048;
#pragma unroll
    for (int r = 0; r < 4; ++r) {
#pragma unroll
      for (int q = 0; q < 2; ++q) {
        const f32x4 g4 = *(const f32x4*)(G1s + b * 2048 + r * 512 + q * 256 + lane * 4), sh4 = *(const f32x4*)(SHs + b * 2048 + r * 512 + q * 256 + lane * 4);
        v[2 * r + q] = v[2 * r + q] * rstd * g4 + sh4;
      }
    }
#pragma unroll
    for (int r = 0; r < 4; ++r) {
      u32x4 o; o[0] = pk2(v[2 * r][0], v[2 * r][1]); o[1] = pk2(v[2 * r][2], v[2 * r][3]); o[2] = pk2(v[2 * r + 1][0], v[2 * r + 1][1]); o[3] = pk2(v[2 * r + 1][2], v[2 * r + 1][3]);
      *(u32x4*)(HB + (size_t)t * 2048 + r * 512 + lane * 8) = o;
    }
    if (GATES) {
      float mine = 0.f;
#pragma unroll 1
      for (int j = 0; j < 8; ++j) {
        float d = 0.f;
#pragma unroll
        for (int r = 0; r < 4; ++r)
#pragma unroll
          for (int q = 0; q < 2; ++q) { const f32x4 w = *(const f32x4*)(WGs + j * 2048 + r * 512 + q * 256 + lane * 4); const f32x4 a = v[2 * r + q]; d += a[0] * w[0] + a[1] * w[1] + a[2] * w[2] + a[3] * w[3]; }
        d = wave_sum(d);
        if (lane == j) mine = d;
      }
      if (lane < 8) GT[t * 8 + lane] = mine;
    }
  }
}
struct EpiProj {
  static constexpr bool PERM = true, AFTER_DRAIN = false;
  bf16_t* PB;
  DI void operator()(const f32x4 (&acc)[2][2][4][2], const pg8::Unit& u, int wr, int wc, int fr, int fq) const {
    const int row0 = u.pm * 256 + wr * 64 + fr, col0 = u.pn * 256 + wc * 32 + 8 * fq;
    const bool rope = u.pn < 8; const float qs = u.pn < 4 ? 0.125f * 1.4426950408889634f : 1.0f;
    float ir[2][4];
#pragma unroll
    for (int bj = 0; bj < 2; ++bj) { const int i0 = ((col0 + bj * 128) & 63) >> 1;
#pragma unroll
      for (int k = 0; k < 4; ++k) ir[bj][k] = exp2f(-(float)(i0 + k) * 0.41524101186092029f) * 0.15915494309189535f; }
#pragma unroll
    for (int ai = 0; ai < 2; ++ai)
#pragma unroll
      for (int m = 0; m < 4; ++m) {
        const int row = row0 + ai * 128 + m * 16; const float fpos = (float)(row & 2047);
#pragma unroll
        for (int bj = 0; bj < 2; ++bj) {
          float v[8];
#pragma unroll
          for (int n = 0; n < 2; ++n)
#pragma unroll
            for (int k = 0; k < 4; ++k) v[4 * n + k] = acc[ai][bj][m][n][k];
          if (rope) {
#pragma unroll
            for (int k = 0; k < 4; ++k) { const float rr = __builtin_amdgcn_fractf(fpos * ir[bj][k]); const float cc = __builtin_amdgcn_cosf(rr), sn = __builtin_amdgcn_sinf(rr);
              const float a0 = v[2 * k] * cc - v[2 * k + 1] * sn, a1 = v[2 * k + 1] * cc + v[2 * k] * sn; v[2 * k] = a0 * qs; v[2 * k + 1] = a1 * qs; }
          }
          u32x4 o; o[0] = pk2(v[0], v[1]); o[1] = pk2(v[2], v[3]); o[2] = pk2(v[4], v[5]); o[3] = pk2(v[6], v[7]);
          *(u32x4*)(PB + (size_t)row * 6144 + col0 + bj * 128) = o;
        }
      }
  }
};
struct EpiRes {
  static constexpr bool PERM = false, AFTER_DRAIN = false;
  float* X1; const float* x; const float* MOD;
  DI void operator()(const f32x4 (&acc)[2][2][4][2], const pg8::Unit& u, int wr, int wc, int fr, int fq) const {
    const int row0 = u.pm * 256 + wr * 64 + fr, col0 = u.pn * 256 + wc * 32 + 4 * fq;
    const int b = (u.pm * 256) >> 11;
    f32x4 gt[2][2];
#pragma unroll
    for (int bj = 0; bj < 2; ++bj)
#pragma unroll
      for (int n = 0; n < 2; ++n) gt[bj][n] = *(const f32x4*)(MOD + b * 16384 + 2 * 2048 + col0 + bj * 128 + n * 16);
#pragma unroll
    for (int ai = 0; ai < 2; ++ai) {
      f32x4 xv[4][2][2];
#pragma unroll
      for (int m = 0; m < 4; ++m)
#pragma unroll
        for (int bj = 0; bj < 2; ++bj)
#pragma unroll
          for (int n = 0; n < 2; ++n) xv[m][bj][n] = *(const f32x4*)(x + (size_t)(row0 + ai * 128 + m * 16) * 2048 + col0 + bj * 128 + n * 16);
#pragma unroll
      for (int m = 0; m < 4; ++m)
#pragma unroll
        for (int bj = 0; bj < 2; ++bj)
#pragma unroll
          for (int n = 0; n < 2; ++n) *(f32x4*)(X1 + (size_t)(row0 + ai * 128 + m * 16) * 2048 + col0 + bj * 128 + n * 16) = xv[m][bj][n] + gt[bj][n] * acc[ai][bj][m][n];
    }
  }
};
struct EpiBf {
  static constexpr bool PERM = true, AFTER_DRAIN = false;
  bf16_t* O;
  DI void operator()(const f32x4 (&acc)[2][2][4][2], const pg8::Unit& u, int wr, int wc, int fr, int fq) const {
    const int row0 = u.pm * 256 + wr * 64 + fr, col0 = u.pn * 256 + wc * 32 + 8 * fq;
#pragma unroll
    for (int ai = 0; ai < 2; ++ai)
#pragma unroll
      for (int m = 0; m < 4; ++m) {
        const size_t ro = (size_t)(row0 + ai * 128 + m * 16) * 2048;
#pragma unroll
        for (int bj = 0; bj < 2; ++bj) { const f32x4 v0 = acc[ai][bj][m][0], v1 = acc[ai][bj][m][1]; u32x4 o; o[0] = pk2(v0[0], v0[1]); o[1] = pk2(v0[2], v0[3]); o[2] = pk2(v1[0], v1[1]); o[3] = pk2(v1[2], v1[3]); *(u32x4*)(O + ro + col0 + bj * 128) = o; }
      }
  }
};
DI bf16_t f2bf1(float x) { return (bf16_t)(pk2(x, 0.f) & 0xffffu); }
DI void phase_attn(const Params& p, unsigned char* lds, int bid, int nblk, int tid_in) {
  const bf16_t* PB = (const bf16_t*)(p.ws + OFF_PB); bf16_t* MIX = (bf16_t*)(p.ws + OFF_MIX);
  float* XE = (float*)(lds + 71680);
  float d1 = 0.f, d2 = 0.f;
  for (int i = 0; i < 64; ++i) { d1 += p.lq1[i] * p.lk1[i]; d2 += p.lq2[i] * p.lk2[i]; }
  const float lam = expf(d1) - expf(d2) + 0.2f;
  for (int u0 = bid; u0 < 256; u0 += nblk) {
    const int u = (nblk == 256) ? ((u0 & 7) * 32 + (u0 >> 3)) : u0;
    const int bh = u >> 3, pi = u & 7, b = bh >> 3, hd = bh & 7;
    u32x4 kreg[2], vreg[2];
    for (int half = 0; half < 2; ++half) {
      int tid = tid_in; asm volatile("" : "+v"(tid));
      const int lane = tid & 63, wave = tid >> 6, r = lane & 31, h = lane >> 5;
      const int map = wave & 1, qs = wave >> 1;
      const int qb = half ? 15 - pi : pi;
      const int qg = qb * 128 + qs * 32 + r;
      const size_t tq = (size_t)b * 2048 + qg;
      bf16x8 bq[4];
#pragma unroll
      for (int s = 0; s < 4; ++s) bq[s] = *(const bf16x8*)(PB + tq * 6144 + (2 * hd + map) * 64 + 16 * s + 8 * h);
      f32x16 o[4];
#pragma unroll
      for (int et = 0; et < 4; ++et) o[et] = zero16();
      float m_run = -INFINITY, l_run = 0.f;
      const int nkt = 2 * qb + 2;
      const int vc16 = tid & 15, vrp = tid >> 4;
      const bf16_t* kbase = PB + (size_t)b * 2048 * 6144 + 1024 + hd * 128;
      const bf16_t* vbase = PB + (size_t)b * 2048 * 6144 + 2048 + hd * 128 + vc16 * 8;
#define AT_GK(kt) _Pragma("unroll") for (int i_ = 0; i_ < 2; ++i_) { const int q_ = tid + 512 * i_; kreg[i_] = *(const u32x4*)(kbase + (size_t)((kt) * 64 + (q_ >> 4)) * 6144 + (q_ & 15) * 8); }
#define AT_GV(kt) _Pragma("unroll") for (int i_ = 0; i_ < 2; ++i_) vreg[i_] = *(const u32x4*)(vbase + (size_t)((kt) * 64 + 2 * vrp + i_) * 6144);
#define AT_WK(buf) _Pragma("unroll") for (int i_ = 0; i_ < 2; ++i_) { const int q_ = tid + 512 * i_; *(u32x4*)((bf16_t*)(lds + (buf) * 17408) + (q_ >> 4) * 136 + (q_ & 15) * 8) = kreg[i_]; }
#define AT_WV(buf) { bf16_t* VT_ = (bf16_t*)(lds + 34816 + (buf) * 18432); const int pk_ = (2 * vrp + 4 * vc16) & 63; _Pragma("unroll") for (int d_ = 0; d_ < 4; ++d_) { const unsigned a_ = vreg[0][d_], b_ = vreg[1][d_]; \
          *(unsigned*)(VT_ + (vc16 * 8 + 2 * d_) * 72 + pk_) = (a_ & 0xffffu) | (b_ << 16); *(unsigned*)(VT_ + (vc16 * 8 + 2 * d_ + 1) * 72 + pk_) = (a_ >> 16) | (b_ & 0xffff0000u); } }
#define AT_QK(dst, buf) { const bf16_t* Ks_ = (const bf16_t*)(lds + (buf) * 17408); _Pragma("unroll") for (int kk = 0; kk < 2; ++kk) { dst[kk] = zero16(); \
          _Pragma("unroll") for (int s = 0; s < 4; ++s) { const bf16x8 a_ = *(const bf16x8*)(Ks_ + (kk * 32 + r) * 136 + map * 64 + 16 * s + 8 * h); dst[kk] = mfma32(a_, bq[s], dst[kk]); } } }
      if (half == 0) { AT_GK(0); AT_GV(0); }
      __syncthreads();
      AT_WK(0); AT_WV(0);
      AT_GK(1);
      AT_WK(1);
      __syncthreads();
      if (nkt > 2) { AT_GK(2); }
      AT_GV(1);
      f32x16 st[2], sn[2];
      AT_QK(st, 0);
      __syncthreads();
      for (int kt = 0; kt < nkt; ++kt) {
        if (kt + 2 < nkt) { AT_WK(kt & 1); }
        if (kt + 1 < nkt) { AT_WV((kt + 1) & 1); }
        if (kt + 3 < nkt) { AT_GK(kt + 3); }
        if (kt + 2 < nkt) { AT_GV(kt + 2); }
        AT_QK(sn, (kt + 1) & 1);
        const bool diag = (kt >= 2 * qb);
        if (diag) {
#pragma unroll
          for (int kk = 0; kk < 2; ++kk)
#pragma unroll
            for (int i = 0; i < 16; ++i) { const int kg = kt * 64 + kk * 32 + crow(i, h); if (kg > qg) st[kk][i] = -INFINITY; }
        }
        float mx = -INFINITY;
#pragma unroll
        for (int kk = 0; kk < 2; ++kk)
#pragma unroll
          for (int i = 0; i < 16; ++i) mx = fmaxf(mx, st[kk][i]);
        mx = fmaxf(mx, __shfl_xor(mx, 32));
        const float m_new = fmaxf(m_run, mx);
        const bool need = (m_new - m_run) > 8.0f;
        if (__any(need)) {
          const float m_use = need ? m_new : m_run;
          const float corr = __builtin_amdgcn_exp2f(m_run - m_use);
          l_run *= corr;
#pragma unroll
          for (int et = 0; et < 4; ++et) o[et] *= corr;
          m_run = m_use;
        }
        float ps = 0.f;
#pragma unroll
        for (int kk = 0; kk < 2; ++kk)
#pragma unroll
          for (int i = 0; i < 16; ++i) { const float pv = __builtin_amdgcn_exp2f(st[kk][i] - m_run); st[kk][i] = pv; ps += pv; }
        l_run += ps;
        const bf16_t* VT = (const bf16_t*)(lds + 34816 + (kt & 1) * 18432);
#pragma unroll
        for (int kk = 0; kk < 2; ++kk) {
          const bf16x8 pf0 = pack8<0>(st[kk]), pf1 = pack8<1>(st[kk]);
#pragma unroll
          for (int et = 0; et < 4; ++et) {
            const int ev = et * 32 + r, rot = 4 * ((ev >> 3) & 15) + kk * 32 + 4 * h;
            const bf16_t* vrow = VT + ev * 72;
            const bf16x8 a0 = cat4(*(const s16x4*)(vrow + (rot & 63)), *(const s16x4*)(vrow + ((rot + 8) & 63))), a1 = cat4(*(const s16x4*)(vrow + ((rot + 16) & 63)), *(const s16x4*)(vrow + ((rot + 24) & 63)));
            o[et] = mfma32(a0, pf0, o[et]); o[et] = mfma32(a1, pf1, o[et]);
          }
        }
        st[0] = sn[0]; st[1] = sn[1];
        __syncthreads();
      }
      if (half == 0) { AT_GK(0); AT_GV(0); }
#undef AT_GK
#undef AT_GV
#undef AT_WK
#undef AT_WV
#undef AT_QK
      const float inv = 1.0f / (l_run + __shfl_xor(l_run, 32));
      if (map == 1) {
#pragma unroll
        for (int et = 0; et < 4; ++et)
#pragma unroll
          for (int i = 0; i < 16; ++i) XE[(qs * 128 + et * 32 + crow(i, h)) * 32 + r] = lam * o[et][i] * inv;
      }
      __syncthreads();
      if (map == 0) {
        float ss = 0.f;
#pragma unroll
        for (int et = 0; et < 4; ++et)
#pragma unroll
          for (int i = 0; i < 16; ++i) { const float v = o[et][i] * inv - XE[(qs * 128 + et * 32 + crow(i, h)) * 32 + r]; o[et][i] = v; ss += v * v; }
        ss += __shfl_xor(ss, 32);
        const float rstd = 0.8f / sqrtf(ss * (1.f / 128.f) + 1e-6f);
        f32x4 dnv[4][4];
#pragma unroll
        for (int et = 0; et < 4; ++et)
#pragma unroll
          for (int g = 0; g < 4; ++g) dnv[et][g] = *(const f32x4*)(p.da_norm + et * 32 + 8 * g + 4 * h);
#pragma unroll
        for (int et = 0; et < 4; ++et)
#pragma unroll
          for (int g = 0; g < 4; ++g) { const int e0 = et * 32 + 8 * g + 4 * h; const f32x4 dn = dnv[et][g];
            u32x2 ov; ov[0] = pk2(o[et][4 * g] * rstd * dn[0], o[et][4 * g + 1] * rstd * dn[1]); ov[1] = pk2(o[et][4 * g + 2] * rstd * dn[2], o[et][4 * g + 3] * rstd * dn[3]);
            *(u32x2*)(MIX + tq * 2048 + hd * 128 + e0) = ov; }
      }
    }
  }
  __syncthreads();
}
DI void conv8(const Params& p, const bf16_t* PB, int b, int spos, int pbcol, int cch, float (&out)[8]) {
  const f32x4 b0 = *(const f32x4*)(p.conv_b + cch), b1 = *(const f32x4*)(p.conv_b + cch + 4);
#pragma unroll
  for (int j = 0; j < 4; ++j) { out[j] = b0[j]; out[4 + j] = b1[j]; }
#pragma unroll
  for (int kw = 0; kw < 4; ++kw) {
    const int sp = spos - 3 + kw;
    if (sp >= 0) {
      const u32x4 xv = *(const u32x4*)(PB + ((size_t)b * 2048 + sp) * 6144 + pbcol);
      const f32x4 w0 = *(const f32x4*)(p.conv_w + kw * 1024 + cch), w1 = *(const f32x4*)(p.conv_w + kw * 1024 + cch + 4);
      out[0] += w0[0] * bflo(xv[0]); out[1] += w0[1] * bfhi(xv[0]); out[2] += w0[2] * bflo(xv[1]); out[3] += w0[3] * bfhi(xv[1]);
      out[4] += w1[0] * bflo(xv[2]); out[5] += w1[1] * bfhi(xv[2]); out[6] += w1[2] * bflo(xv[3]); out[7] += w1[3] * bfhi(xv[3]);
    }
  }
#pragma unroll
  for (int j = 0; j < 8; ++j) out[j] = out[j] / (1.f + __expf(-out[j]));
}
DI void gates64(const Params& p, int t0, int hh, int lane, float& li, float& bc) {
  const float* GT = (const float*)(p.ws + OFF_GATES);
  const float gi = GT[(t0 + lane) * 8 + hh] + p.b_igate[hh], gf = GT[(t0 + lane) * 8 + 4 + hh] + p.b_fgate[hh];
  li = 15.f * tanhf(gi * (1.f / 15.f));
  const float z = 15.f * tanhf(gf * (1.f / 15.f));
  const float lf = fminf(z, 0.f) - log1pf(expf(-fabsf(z)));
  bc = lf;
#pragma unroll
  for (int o = 1; o < 64; o <<= 1) { const float n = __shfl_up(bc, o); if (lane >= o) bc += n; }
}
DI void stage_vt256(const bf16_t* PB, bf16_t* VT, int t0, int hh, int tid) {
  const int c32 = tid & 31, rp = tid >> 5;
#pragma unroll
  for (int i = 0; i < 2; ++i) { const int r2 = 2 * (rp + 16 * i);
    const u32x4 va = *(const u32x4*)(PB + (size_t)(t0 + r2) * 6144 + 4096 + hh * 256 + c32 * 8), vb = *(const u32x4*)(PB + (size_t)(t0 + r2 + 1) * 6144 + 4096 + hh * 256 + c32 * 8);
    const int pk = (r2 + 4 * (c32 & 15)) & 63;
#pragma unroll
    for (int d = 0; d < 4; ++d) { *(unsigned*)(VT + (c32 * 8 + 2 * d) * 72 + pk) = (va[d] & 0xffffu) | (vb[d] << 16); *(unsigned*)(VT + (c32 * 8 + 2 * d + 1) * 72 + pk) = (va[d] >> 16) | (vb[d] & 0xffff0000u); } }
}
DI void phase_mlA(const Params& p, unsigned char* lds, int bid, int nblk, int tid_in) {
  const bf16_t* PB = (const bf16_t*)(p.ws + OFF_PB);
  bf16_t* CST = (bf16_t*)(p.ws + OFF_CST); float* NST = (float*)(p.ws + OFF_NST); float* DEC = (float*)(p.ws + OFF_DEC);
  bf16_t* KwT = (bf16_t*)lds;
  bf16_t* VT = (bf16_t*)(lds + 18432);
  float* wsv = (float*)(lds + 55296);
  for (int u = bid; u < 512; u += nblk) {
    int tid = tid_in; asm volatile("" : "+v"(tid));
    const int lane = tid & 63, wave = tid >> 6, r = lane & 31, h = lane >> 5;
    const int bh = u >> 5, c = u & 31, b = bh >> 2, hh = bh & 3;
    const int t0 = b * 2048 + c * 64;
    __syncthreads();
    if (wave == 0) {
      float li, bc; gates64(p, t0, hh, lane, li, bc);
      const float bL = __shfl(bc, 63);
      wsv[lane] = expf(bL - bc + li);
      if (lane == 0) DEC[u] = expf(bL);
    }
    __syncthreads();
    { const int c8 = tid & 15, rp = tid >> 4; float oa[8], ob[8];
      conv8(p, PB, b, c * 64 + 2 * rp, 3584 + hh * 128 + c8 * 8, 512 + hh * 128 + c8 * 8, oa);
      conv8(p, PB, b, c * 64 + 2 * rp + 1, 3584 + hh * 128 + c8 * 8, 512 + hh * 128 + c8 * 8, ob);
      const float wa = wsv[2 * rp] * 0.08838834764831845f, wb = wsv[2 * rp + 1] * 0.08838834764831845f;
      const int pk = (2 * rp + 4 * c8) & 63;
#pragma unroll
      for (int j = 0; j < 8; ++j) *(unsigned*)(KwT + (c8 * 8 + j) * 72 + pk) = pk2(oa[j] * wa, ob[j] * wb); }
    stage_vt256(PB, VT, t0, hh, tid);
    __syncthreads();
    f32x16 acc[4];
#pragma unroll
    for (int d = 0; d < 4; ++d) acc[d] = zero16();
#pragma unroll
    for (int ks = 0; ks < 4; ++ks) { const int ev = wave * 32 + r, rv = 4 * ((ev >> 3) & 15) + 16 * ks + 4 * h;
      const bf16x8 a = cat4(*(const s16x4*)(VT + ev * 72 + (rv & 63)), *(const s16x4*)(VT + ev * 72 + ((rv + 8) & 63)));
#pragma unroll
      for (int d = 0; d < 4; ++d) { const int dk = d * 32 + r, rk = 4 * ((dk >> 3) & 15) + 16 * ks + 4 * h;
        const bf16x8 bb = cat4(*(const s16x4*)(KwT + dk * 72 + (rk & 63)), *(const s16x4*)(KwT + dk * 72 + ((rk + 8) & 63))); acc[d] = mfma32(a, bb, acc[d]); } }
    bf16_t* C = CST + (size_t)u * 32768;
#pragma unroll
    for (int d = 0; d < 4; ++d)
#pragma unroll
      for (int i = 0; i < 16; ++i) C[(wave * 32 + crow(i, h)) * 128 + d * 32 + r] = f2bf1(acc[d][i]);
    if (tid < 128) { float s = 0.f; for (int ss = 0; ss < 64; ++ss) s += bf2f(KwT[tid * 72 + ss]); NST[u * 128 + tid] = s; }
  }
}
DI void phase_scan(const Params& p, int bid, int nblk, int tid) {
  u32x2* CST = (u32x2*)(p.ws + OFF_CST); float* NST = (float*)(p.ws + OFF_NST); const float* DEC = (const float*)(p.ws + OFF_DEC);
  for (int e = bid * 512 + tid; e < 16 * 8192 + 16 * 128; e += nblk * 512) {
    if (e < 131072) {
      const int bh = e >> 13; u32x2* base = CST + (size_t)bh * 32 * 8192 + (e & 8191);
      u32x2 v[32];
#pragma unroll
      for (int c = 0; c < 32; ++c) v[c] = base[(size_t)c * 8192];
      float c0 = 0.f, c1 = 0.f, c2 = 0.f, c3 = 0.f;
#pragma unroll
      for (int c = 0; c < 32; ++c) { const float d = DEC[bh * 32 + c]; u32x2 o; o[0] = pk2(c0, c1); o[1] = pk2(c2, c3); base[(size_t)c * 8192] = o;
        c0 = d * c0 + bflo(v[c][0]); c1 = d * c1 + bfhi(v[c][0]); c2 = d * c2 + bflo(v[c][1]); c3 = d * c3 + bfhi(v[c][1]); }
    } else {
      const int e2 = e - 131072, bh = e2 >> 7; float* base = NST + (size_t)bh * 32 * 128 + (e2 & 127);
      float v[32];
#pragma unroll
      for (int c = 0; c < 32; ++c) v[c] = base[c * 128];
      float carry = 0.f;
#pragma unroll
      for (int c = 0; c < 32; ++c) { const float d = DEC[bh * 32 + c]; base[c * 128] = carry; carry = d * carry + v[c]; }
    }
  }
}
DI void phase_mlC(const Params& p, unsigned char* lds, int bid, int nblk, int tid_in) {
  const bf16_t* PB = (const bf16_t*)(p.ws + OFF_PB); bf16_t* MIX = (bf16_t*)(p.ws + OFF_MIX);
  const bf16_t* CST = (const bf16_t*)(p.ws + OFF_CST); const float* NST = (const float*)(p.ws + OFF_NST);
  bf16_t* Qs = (bf16_t*)lds;
  bf16_t* Ks = (bf16_t*)(lds + 17408);
  bf16_t* VT = (bf16_t*)(lds + 34816);
  bf16_t* CT = (bf16_t*)(lds + 71680);
  float* bvec = (float*)(lds + 141312);
  float* liv = bvec + 64; float* nvec = liv + 64; float* qn = nvec + 128;
  float* Hout = (float*)lds;
  for (int u = bid; u < 512; u += nblk) {
    int tid = tid_in; asm volatile("" : "+v"(tid));
    const int lane = tid & 63, wave = tid >> 6, r = lane & 31, h = lane >> 5;
    const int bh = u >> 5, c = u & 31, b = bh >> 2, hh = bh & 3;
    const int t0 = b * 2048 + c * 64;
    __syncthreads();
    if (wave == 0) { float li, bc; gates64(p, t0, hh, lane, li, bc); bvec[lane] = bc; liv[lane] = li; }
    if (tid >= 64 && tid < 192) nvec[tid - 64] = NST[u * 128 + tid - 64];
#pragma unroll 1
    for (int i = 0; i < 2; ++i) { const int q = tid + 512 * i, s = q >> 4, c8 = q & 15; float o8[8];
      conv8(p, PB, b, c * 64 + s, 3072 + hh * 128 + c8 * 8, hh * 128 + c8 * 8, o8);
      u32x4 ov; ov[0] = pk2(o8[0], o8[1]); ov[1] = pk2(o8[2], o8[3]); ov[2] = pk2(o8[4], o8[5]); ov[3] = pk2(o8[6], o8[7]);
      *(u32x4*)(Qs + s * 136 + c8 * 8) = ov;
      conv8(p, PB, b, c * 64 + s, 3584 + hh * 128 + c8 * 8, 512 + hh * 128 + c8 * 8, o8);
      const float w = 0.08838834764831845f;
      ov[0] = pk2(o8[0] * w, o8[1] * w); ov[1] = pk2(o8[2] * w, o8[3] * w); ov[2] = pk2(o8[4] * w, o8[5] * w); ov[3] = pk2(o8[6] * w, o8[7] * w);
      *(u32x4*)(Ks + s * 136 + c8 * 8) = ov; }
    stage_vt256(PB, VT, t0, hh, tid);
#pragma unroll
    for (int i = 0; i < 8; ++i) { const int q = tid + 512 * i, dv = q >> 4, c8 = q & 15;
      *(u32x4*)(CT + dv * 136 + c8 * 8) = *(const u32x4*)(CST + (size_t)u * 32768 + dv * 128 + c8 * 8); }
    __syncthreads();
    { const int j = tid >> 3, seg = tid & 7; float s = 0.f;
#pragma unroll
      for (int d = 0; d < 16; ++d) s += bf2f(Qs[j * 136 + seg * 16 + d]) * nvec[seg * 16 + d];
      s += __shfl_xor(s, 1); s += __shfl_xor(s, 2); s += __shfl_xor(s, 4);
      if (seg == 0) qn[j] = s; }
    __syncthreads();
    f32x16 hv[2];
#pragma unroll
    for (int jt = 0; jt < 2; ++jt) {
      f32x16 st[2]; st[0] = zero16(); st[1] = zero16();
#pragma unroll 2
      for (int ks = 0; ks < 8; ++ks) { const bf16x8 bqf = *(const bf16x8*)(Qs + (jt * 32 + r) * 136 + 16 * ks + 8 * h);
#pragma unroll
        for (int s2 = 0; s2 < 2; ++s2) { const bf16x8 a = *(const bf16x8*)(Ks + (s2 * 32 + r) * 136 + 16 * ks + 8 * h); st[s2] = mfma32(a, bqf, st[s2]); } }
      const int jj = jt * 32 + r; const float bj = bvec[jj]; float rs = 0.f;
#pragma unroll
      for (int s2 = 0; s2 < 2; ++s2)
#pragma unroll
        for (int i = 0; i < 16; ++i) { const int s = s2 * 32 + crow(i, h); const float w = (s <= jj) ? __expf(bj - bvec[s] + liv[s]) : 0.f; const float v = st[s2][i] * w; st[s2][i] = v; rs += v; }
      rs += __shfl_xor(rs, 32);
      const float den = __expf(bj) * qn[jj] + rs;
      const float dinv = 1.0f / fmaxf(fabsf(den), 1.0f);
      f32x16 z = zero16();
#pragma unroll
      for (int s2 = 0; s2 < 2; ++s2) { const bf16x8 pf0 = pack8<0>(st[s2]), pf1 = pack8<1>(st[s2]);
        const int ev = wave * 32 + r, rot = 4 * ((ev >> 3) & 15) + s2 * 32 + 4 * h;
        const bf16_t* vrow = VT + ev * 72;
        const bf16x8 b0 = cat4(*(const s16x4*)(vrow + (rot & 63)), *(const s16x4*)(vrow + ((rot + 8) & 63))), b1 = cat4(*(const s16x4*)(vrow + ((rot + 16) & 63)), *(const s16x4*)(vrow + ((rot + 24) & 63)));
        z = mfma32(pf0, b0, z); z = mfma32(pf1, b1, z); }
      f32x16 z2 = zero16();
#pragma unroll 2
      for (int ks = 0; ks < 8; ++ks) { const bf16x8 a = *(const bf16x8*)(Qs + (jt * 32 + r) * 136 + 16 * ks + 8 * h); const bf16x8 bb = *(const bf16x8*)(CT + (wave * 32 + r) * 136 + 16 * ks + 8 * h); z2 = mfma32(a, bb, z2); }
#pragma unroll
      for (int i = 0; i < 16; ++i) { const int jr = jt * 32 + crow(i, h); const float eb = __expf(bvec[jr]); const float di = __shfl(dinv, crow(i, h)); hv[jt][i] = (eb * z2[i] + z[i]) * di; }
    }
    __syncthreads();
#pragma unroll
    for (int jt = 0; jt < 2; ++jt)
#pragma unroll
      for (int i = 0; i < 16; ++i) Hout[(jt * 32 + crow(i, h)) * 256 + wave * 32 + r] = hv[jt][i];
    __syncthreads();
    { const int j = tid >> 3, seg = tid & 7; const size_t t = (size_t)t0 + j; float vals[32]; float ss = 0.f;
#pragma unroll
      for (int d = 0; d < 32; ++d) { vals[d] = Hout[j * 256 + seg * 32 + d]; ss += vals[d] * vals[d]; }
      ss += __shfl_xor(ss, 1); ss += __shfl_xor(ss, 2); ss += __shfl_xor(ss, 4);
      const float rstd = 1.0f / sqrtf(ss * (1.f / 256.f) + 1e-6f);
      u32x4 ogv[4];
#pragma unroll
      for (int d8 = 0; d8 < 4; ++d8) ogv[d8] = *(const u32x4*)(PB + t * 6144 + 5120 + hh * 256 + seg * 32 + d8 * 8);
#pragma unroll
      for (int d8 = 0; d8 < 4; ++d8) {
        const int dv = seg * 32 + d8 * 8;
        const u32x4 og = ogv[d8];
        const f32x4 n0 = *(const f32x4*)(p.ml_norm + dv), n1 = *(const f32x4*)(p.ml_norm + dv + 4);
        float ov[8];
#pragma unroll
        for (int k = 0; k < 4; ++k) { const float g0 = bflo(og[k]), g1 = bfhi(og[k]);
          const float nn0 = (2 * k < 4) ? n0[(2 * k) & 3] : n1[(2 * k) & 3], nn1 = (2 * k + 1 < 4) ? n0[(2 * k + 1) & 3] : n1[(2 * k + 1) & 3];
          ov[2 * k] = vals[d8 * 8 + 2 * k] * rstd * nn0 / (1.f + __expf(-g0)); ov[2 * k + 1] = vals[d8 * 8 + 2 * k + 1] * rstd * nn1 / (1.f + __expf(-g1)); }
        u32x4 o4; o4[0] = pk2(ov[0], ov[1]); o4[1] = pk2(ov[2], ov[3]); o4[2] = pk2(ov[4], ov[5]); o4[3] = pk2(ov[6], ov[7]);
        *(u32x4*)(MIX + t * 2048 + 1024 + hh * 256 + dv) = o4;
      }
    }
  }
}
DI int f2key(float x) { const int b = __float_as_int(x); return b ^ ((b >> 31) & 0x7fffffff); }
DI float key2f(int k) { return __int_as_float(k ^ ((k >> 31) & 0x7fffffff)); }
template <int N> DI void bitonic_sort_desc(int (&a)[N]) {
#pragma unroll
  for (int k = 2; k <= N; k <<= 1)
#pragma unroll
    for (int j = k >> 1; j > 0; j >>= 1)
#pragma unroll
      for (int i = 0; i < N; ++i) { const int l = i ^ j; if (l > i) { const bool desc = ((i & k) == 0); const int hi = max(a[i], a[l]), lo = min(a[i], a[l]); a[i] = desc ? hi : lo; a[l] = desc ? lo : hi; } }
}
template <int N> DI void bitonic_merge_desc(int (&a)[N]) {
#pragma unroll
  for (int j = N >> 1; j > 0; j >>= 1)
#pragma unroll
    for (int i = 0; i < N; ++i) { const int l = i ^ j; if (l > i) { const int hi = max(a[i], a[l]), lo = min(a[i], a[l]); a[i] = hi; a[l] = lo; } }
}
DI void top16_merge(int (&a)[16], const int (&b)[16]) {
#pragma unroll
  for (int i = 0; i < 16; ++i) a[i] = max(a[i], b[15 - i]);
  bitonic_merge_desc<16>(a);
}
DI void top16_xlane(int (&a)[16]) {
  int b[16];
#pragma unroll
  for (int i = 0; i < 16; ++i) b[i] = __shfl_xor(a[i], 32);
  top16_merge(a, b);
}
DI void topk_unit(const Params& p, const bf16_t* q0, const bf16_t* q1, size_t t, int hd, int r, int h) {
  int* IDX = (int*)(p.ws + OFF_IDX); float* GW = (float*)(p.ws + OFF_GW); float* AACC = (float*)(p.ws + OFF_AACC);
    int top[2][16];
#pragma unroll
    for (int c = 0; c < 2; ++c) {
      f32x16 acc[4];
#pragma unroll
      for (int nt = 0; nt < 4; ++nt) acc[nt] = zero16();
      const bf16_t* sk = (const bf16_t*)(p.ws + OFF_SKB) + (size_t)((hd * 2 + c) * 128) * 128;
      const bf16_t* qrow = c ? q1 : q0;
#pragma unroll 4
      for (int ks = 0; ks < 8; ++ks) {
        const bf16x8 bq = *(const bf16x8*)(qrow + 16 * ks + 8 * h);
#pragma unroll
        for (int nt = 0; nt < 4; ++nt) { const bf16x8 a = *(const bf16x8*)(sk + (nt * 32 + r) * 128 + 16 * ks + 8 * h); acc[nt] = mfma32(a, bq, acc[nt]); }
      }
      int l0[16], l1[16], l2[16], l3[16];
#pragma unroll
      for (int i = 0; i < 16; ++i) { l0[i] = (f2key(acc[0][i]) & ~127) | (crow(i, h)); l1[i] = (f2key(acc[1][i]) & ~127) | (32 + crow(i, h)); l2[i] = (f2key(acc[2][i]) & ~127) | (64 + crow(i, h)); l3[i] = (f2key(acc[3][i]) & ~127) | (96 + crow(i, h)); }
      bitonic_sort_desc<16>(l0); bitonic_sort_desc<16>(l1); bitonic_sort_desc<16>(l2); bitonic_sort_desc<16>(l3);
      top16_merge(l0, l1); top16_merge(l2, l3); top16_merge(l0, l2);
      top16_xlane(l0);
#pragma unroll
      for (int k = 0; k < 16; ++k) top[c][k] = l0[k];
    }
    float sa[16], sb[16]; int ia[16], ib[16];
#pragma unroll
    for (int k = 0; k < 16; ++k) { sa[k] = key2f(top[0][k] & ~127); ia[k] = top[0][k] & 127; sb[k] = key2f(top[1][k] & ~127); ib[k] = top[1][k] & 127; }
    constexpr int A0[25] = {0,0,0,0,0,0,0,0,0,0,0,0,0,0,0,0, 4,4,4, 6,6, 8,10,12,14};
    constexpr int B0[25] = {0,1,2,3,4,5,6,7,8,9,10,11,12,13,14,15, 0,1,2, 0,1, 0,0,0,0};
    constexpr int A1[25] = {1,1,1,1,1,1,1,1, 2,2,2,2,2, 3,3,3,3, 5,5, 7,7, 9,11,13,15};
    constexpr int B1[25] = {0,1,2,3,4,5,6,7, 0,1,2,3,4, 0,1,2,3, 0,1, 0,1, 0,0,0,0};
    int c0[16], c1[16];
#pragma unroll
    for (int k = 0; k < 32; ++k) {
      int key = (int)0x80000000;
      if (k < 25) { const float x0 = sa[A0[k]] + sb[B0[k]], x1 = sa[A1[k]] + sb[B1[k]];
        const int e0 = ia[A0[k]] * 128 + ib[B0[k]], e1 = ia[A1[k]] * 128 + ib[B1[k]];
        key = (f2key(h ? x1 : x0) & ~16383) | (h ? e1 : e0); }
      if (k < 16) c0[k] = key; else c1[k - 16] = key;
    }
    bitonic_sort_desc<16>(c0); bitonic_sort_desc<16>(c1);
    top16_merge(c0, c1);
    top16_xlane(c0);
    float fv[16]; int fe[16];
#pragma unroll
    for (int k = 0; k < 16; ++k) { fv[k] = key2f(c0[k] & ~16383); fe[k] = c0[k] & 16383; }
    const float mxv = fv[0];
    float sum = 0.f;
#pragma unroll
    for (int k = 0; k < 16; ++k) { fv[k] = expf(fv[k] - mxv); sum += fv[k]; }
    const float isum = 1.0f / sum;
#pragma unroll
    for (int k = 0; k < 16; ++k) { if (h == 0) { IDX[t * 128 + hd * 16 + k] = fe[k]; GW[t * 128 + hd * 16 + k] = fv[k] * isum; AACC[t * 128 + hd * 16 + k] = 0.f; } }
}
DI void phase_topk(const Params& p, int bid, int nblk, int tid) {
  asm volatile("" : "+v"(tid));
  const int lane = tid & 63, wave = tid >> 6, r = lane & 31, h = lane >> 5;
  const bf16_t* QP = (const bf16_t*)(p.ws + OFF_QP);
  if (!(wave & 4)) convert_peer_rows(p, bid * 8 + wave, nblk * 8, lane);
  for (int unit = bid * 8 + wave; unit < 2048; unit += nblk * 8) {
    const int tt = unit >> 3, hd = unit & 7;
    const size_t t = (size_t)tt * 32 + r;
    topk_unit(p, QP + t * 2048 + hd * 256, QP + t * 2048 + hd * 256 + 128, t, hd, r, h);
  }
  if (wave & 4) convert_peer_rows(p, bid * 8 + wave, nblk * 8, lane);
}
struct EpiTopk {
  static constexpr bool PERM = true, AFTER_DRAIN = true;
  const Params* pp; int bid, nblk;
  DI void fused(const f32x4 (&acc)[2][2][4][2], const pg8::Unit& u, int wr, int wc, int fr, int fq, PG8_LAS unsigned char* ldsp, int wid, int lane) const {
    bf16_t* Qt = (bf16_t*)(unsigned char*)ldsp;
#pragma unroll
    for (int ai = 0; ai < 2; ++ai)
#pragma unroll
      for (int m = 0; m < 4; ++m) {
        const int row = ai * 128 + wr * 64 + m * 16 + fr;
#pragma unroll
        for (int bj = 0; bj < 2; ++bj) { const f32x4 v0 = acc[ai][bj][m][0], v1 = acc[ai][bj][m][1]; u32x4 o; o[0] = pk2(v0[0], v0[1]); o[1] = pk2(v0[2], v0[3]); o[2] = pk2(v1[0], v1[1]); o[3] = pk2(v1[2], v1[3]);
          *(u32x4*)(Qt + row * 264 + bj * 128 + wc * 32 + 8 * fq) = o; }
      }
    __syncthreads();
    const Params& p = *pp;
    const int r = lane & 31, h = lane >> 5;
    if (!(wid & 4)) convert_peer_rows(p, bid * 8 + wid, nblk * 8, lane);
    const bf16_t* q0 = Qt + (32 * wid + r) * 264;
    topk_unit(p, q0, q0 + 128, (size_t)u.pm * 256 + 32 * wid + r, u.pn, r, h);
    if (wid & 4) convert_peer_rows(p, bid * 8 + wid, nblk * 8, lane);
  }
};
DI float gelu_exact(float x) { return 0.5f * x * (1.0f + erff(x * 0.70710678118654752f)); }
DI float reduce16(const float (&v)[16], int c) {
  float a8[8], a4[4], a2[2];
  const bool b8 = (c & 8) != 0, b4 = (c & 4) != 0, b2 = (c & 2) != 0, b1 = (c & 1) != 0;
#pragma unroll
  for (int j = 0; j < 8; ++j) { const float send = b8 ? v[j] : v[j + 8], keep = b8 ? v[j + 8] : v[j]; a8[j] = keep + __shfl_xor(send, 8); }
#pragma unroll
  for (int j = 0; j < 4; ++j) { const float send = b4 ? a8[j] : a8[j + 4], keep = b4 ? a8[j + 4] : a8[j]; a4[j] = keep + __shfl_xor(send, 4); }
#pragma unroll
  for (int j = 0; j < 2; ++j) { const float send = b2 ? a4[j] : a4[j + 2], keep = b2 ? a4[j + 2] : a4[j]; a2[j] = keep + __shfl_xor(send, 2); }
  const float send = b1 ? a2[0] : a2[1], keep = b1 ? a2[1] : a2[0];
  return keep + __shfl_xor(send, 1);
}
DI void phase_gA(const Params& p, int gi, int nblk, int tid) {
  const int lane = tid & 63, wave = tid >> 6, c = lane & 15, es = lane >> 4;
  const int NG = nblk >> 3, sl = gi & 7, tr = gi >> 3;
  const bf16_t* HB = (const bf16_t*)(p.ws + OFF_HB); const unsigned char* PU8 = (const unsigned char*)(p.ws + OFF_PU);
  const int* IDX = (const int*)(p.ws + OFF_IDX); float* AACC = (float*)(p.ws + OFF_AACC);
  const unsigned char* PUs = PU8 + (size_t)sl * 16384 * 256;
  const int tstep = NG * 8;
  int tcur = tr * 8 + wave;
  if (tcur >= T_) return;
  int ex[32]; u32x4 hraw[2];
#pragma unroll
  for (int m = 0; m < 8; ++m) { const i32x4 q4 = *(const i32x4*)(IDX + (unsigned)(tcur * 128 + 32 * es + 4 * m)); ex[4 * m] = q4[0]; ex[4 * m + 1] = q4[1]; ex[4 * m + 2] = q4[2]; ex[4 * m + 3] = q4[3]; }
  hraw[0] = *(const u32x4*)(HB + (size_t)tcur * 2048 + sl * 256 + c * 16); hraw[1] = *(const u32x4*)(HB + (size_t)tcur * 2048 + sl * 256 + c * 16 + 8);
  for (int t = tcur; t < T_; t += tstep) {
    const int tn = (t + tstep < T_) ? t + tstep : t;
    f32x2 hs[8];
#pragma unroll
    for (int q = 0; q < 2; ++q)
#pragma unroll
      for (int k = 0; k < 4; ++k) { hs[q * 4 + k][0] = bflo(hraw[q][k]); hs[q * 4 + k][1] = bfhi(hraw[q][k]); }
    int exn[32];
#pragma unroll
    for (int bt = 0; bt < 2; ++bt) {
      float v[16];
      u32x4 sg[16];
#pragma unroll
      for (int i = 0; i < 16; ++i) sg[i] = *(const u32x4*)(PUs + (unsigned)(ex[16 * bt + i] * 256 + c * 16));
      if (bt == 0) {
#pragma unroll
        for (int m = 0; m < 8; ++m) { const i32x4 q4 = *(const i32x4*)(IDX + (unsigned)(tn * 128 + 32 * es + 4 * m)); exn[4 * m] = q4[0]; exn[4 * m + 1] = q4[1]; exn[4 * m + 2] = q4[2]; exn[4 * m + 3] = q4[3]; }
        hraw[0] = *(const u32x4*)(HB + (size_t)tn * 2048 + sl * 256 + c * 16); hraw[1] = *(const u32x4*)(HB + (size_t)tn * 2048 + sl * 256 + c * 16 + 8);
      }
#pragma unroll
      for (int i = 0; i < 16; ++i) {
        f32x2 d2 = {0.f, 0.f};
#pragma unroll
        for (int dw = 0; dw < 4; ++dw) { const f32x2 lo = __builtin_amdgcn_cvt_pk_f32_fp8((int)sg[i][dw], false), hi = __builtin_amdgcn_cvt_pk_f32_fp8((int)sg[i][dw], true);
          d2 = __builtin_elementwise_fma(lo, hs[dw * 2], d2); d2 = __builtin_elementwise_fma(hi, hs[dw * 2 + 1], d2); }
        v[i] = d2[0] + d2[1];
      }
      const float tot = reduce16(v, c);
      __hip_atomic_fetch_add(AACC + (size_t)t * 128 + 32 * es + 16 * bt + c, tot, __ATOMIC_RELAXED, __HIP_MEMORY_SCOPE_AGENT);
    }
#pragma unroll
    for (int i = 0; i < 32; ++i) ex[i] = exn[i];
  }
}
DI void phase_gB(const Params& p, unsigned char* lds, int gi, int nblk, int tid) {
  const int lane = tid & 63, wave = tid >> 6, c = lane & 15, es = lane >> 4;
  const int NG = nblk >> 3, sl = gi & 7, tr = gi >> 3;
  const unsigned char* PV8 = (const unsigned char*)(p.ws + OFF_PV);
  const float* SU = (const float*)(p.ws + OFF_SU); const float* SV = (const float*)(p.ws + OFF_SV);
  const int* IDX = (const int*)(p.ws + OFF_IDX); const float* GW = (const float*)(p.ws + OFF_GW);
  const float* AACC = (const float*)(p.ws + OFF_AACC); bf16_t* Y = (bf16_t*)(p.ws + OFF_Y);
  float* wl = (float*)(lds + wave * 1024); int* el = (int*)(lds + wave * 1024 + 512);
  const unsigned char* PVs = PV8 + (size_t)sl * 16384 * 256;
  const int tstep = NG * 8;
  int t0 = tr * 8 + wave;
  if (t0 >= T_) return;
  float pa[2], pg[2], psu[2], psv[2]; int pe[2];
#pragma unroll
  for (int hf = 0; hf < 2; ++hf) { const unsigned k = (unsigned)(t0 * 128 + lane + 64 * hf); pa[hf] = AACC[k]; pe[hf] = IDX[k]; pg[hf] = GW[k]; }
#pragma unroll
  for (int hf = 0; hf < 2; ++hf) { psu[hf] = SU[pe[hf]]; psv[hf] = SV[pe[hf]]; }
  for (int t = t0; t < T_; t += tstep) {
    const int tn = (t + tstep < T_) ? t + tstep : t;
#pragma unroll
    for (int hf = 0; hf < 2; ++hf) { const int k = lane + 64 * hf; wl[k] = pg[hf] * gelu_exact(pa[hf] * psu[hf]) * psv[hf]; el[k] = pe[hf]; }
    LDS_WAIT();
#pragma unroll
    for (int hf = 0; hf < 2; ++hf) { const unsigned k = (unsigned)(tn * 128 + lane + 64 * hf); pa[hf] = AACC[k]; pe[hf] = IDX[k]; pg[hf] = GW[k]; }
    f32x2 y2[8];
#pragma unroll
    for (int j = 0; j < 8; ++j) y2[j] = (f32x2){0.f, 0.f};
#pragma unroll
    for (int bt = 0; bt < 2; ++bt) {
      u32x4 sg[16]; float wv[16];
#pragma unroll
      for (int m = 0; m < 4; ++m) { const i32x4 e4 = *(const i32x4*)(el + 32 * es + 16 * bt + 4 * m); const f32x4 w4 = *(const f32x4*)(wl + 32 * es + 16 * bt + 4 * m);
#pragma unroll
        for (int k = 0; k < 4; ++k) { wv[4 * m + k] = w4[k]; sg[4 * m + k] = *(const u32x4*)(PVs + (unsigned)(e4[k] * 256 + c * 16)); } }
#pragma unroll
      for (int i = 0; i < 16; ++i) { const f32x2 w2 = {wv[i], wv[i]};
#pragma unroll
        for (int dw = 0; dw < 4; ++dw) { const f32x2 lo = __builtin_amdgcn_cvt_pk_f32_fp8((int)sg[i][dw], false), hi = __builtin_amdgcn_cvt_pk_f32_fp8((int)sg[i][dw], true);
          y2[dw * 2] = __builtin_elementwise_fma(w2, lo, y2[dw * 2]); y2[dw * 2 + 1] = __builtin_elementwise_fma(w2, hi, y2[dw * 2 + 1]); } }
      if (bt == 0) {
#pragma unroll
        for (int hf = 0; hf < 2; ++hf) { psu[hf] = SU[pe[hf]]; psv[hf] = SV[pe[hf]]; }
      }
    }
    float ys[16];
#pragma unroll
    for (int j = 0; j < 8; ++j) { ys[2 * j] = y2[j][0]; ys[2 * j + 1] = y2[j][1]; }
#pragma unroll
    for (int j = 0; j < 16; ++j) { ys[j] += __shfl_xor(ys[j], 16); ys[j] += __shfl_xor(ys[j], 32); }
    if (es == 0) { bf16_t* yo = Y + (size_t)t * 2048 + sl * 256 + c * 16;
#pragma unroll
      for (int q = 0; q < 2; ++q) { u32x4 o; o[0] = pk2(ys[q * 8], ys[q * 8 + 1]); o[1] = pk2(ys[q * 8 + 2], ys[q * 8 + 3]); o[2] = pk2(ys[q * 8 + 4], ys[q * 8 + 5]); o[3] = pk2(ys[q * 8 + 6], ys[q * 8 + 7]); *(u32x4*)(yo + q * 8) = o; } }
    LDS_WAIT();
  }
}
DI void phase_final(const Params& p, int bid, int nblk, int tid) {
  const int lane = tid & 63, wave = tid >> 6;
  const float* X1 = (const float*)(p.ws + OFF_X1); const float* MOD = (const float*)(p.ws + OFF_MOD); const bf16_t* Y = (const bf16_t*)(p.ws + OFF_Y);
  for (int t = bid * 8 + wave; t < T_; t += nblk * 8) {
    const int b = t >> 11;
    const float* gt = MOD + b * 16384 + 5 * 2048; const float* sho = MOD + b * 16384 + 12288; const float* sco = sho + 2048;
    f32x4 v[8]; float ss = 0.f;
#pragma unroll
    for (int j = 0; j < 8; ++j) { const int e = j * 256 + lane * 4; const f32x4 xv = *(const f32x4*)(X1 + (size_t)t * 2048 + e), g4 = *(const f32x4*)(gt + e); const u32x2 yb = *(const u32x2*)(Y + (size_t)t * 2048 + e); f32x4 yv; yv[0] = bflo(yb[0]); yv[1] = bfhi(yb[0]); yv[2] = bflo(yb[1]); yv[3] = bfhi(yb[1]);
      v[j] = xv + g4 * yv; ss += v[j][0] * v[j][0] + v[j][1] * v[j][1] + v[j][2] * v[j][2] + v[j][3] * v[j][3]; }
    ss = wave_sum(ss);
    const float rstd = 1.0f / sqrtf(ss * (1.f / 2048.f) + 1e-6f);
#pragma unroll
    for (int j = 0; j < 8; ++j) { const int e = j * 256 + lane * 4; const f32x4 gf = *(const f32x4*)(p.g_final + e), s4 = *(const f32x4*)(sco + e), h4 = *(const f32x4*)(sho + e);
      v[j] = v[j] * rstd * gf * (1.f + s4) + h4; }
#pragma unroll
    for (int j = 0; j < 8; ++j) *(f32x4*)(p.out + (size_t)t * 2048 + j * 256 + lane * 4) = v[j];
  }
}
#define XB_TMO      128
#define XB_XCNT(j)  (256  + 64 * (j))
#define XB_XSUB(j)  (1280 + 64 * (j))
#define XB_XGEN(j)  (2304 + 64 * (j))
#define XB_TOP      3328
#define XB_TOPGEN   3392
#define XB_SPIN_CAP (1u << 20)
#define XB_LAS __attribute__((address_space(3)))
DI unsigned xb_ld(unsigned* p)              { return __hip_atomic_load(p, __ATOMIC_RELAXED, __HIP_MEMORY_SCOPE_AGENT); }
DI unsigned xb_add(unsigned* p, unsigned v) { return __hip_atomic_fetch_add(p, v, __ATOMIC_RELAXED, __HIP_MEMORY_SCOPE_AGENT); }
DI unsigned xb_xcc_id() { return (unsigned)__builtin_amdgcn_s_getreg((3 << 11) | 20) & 0xFu; }
#define XB_SPIN(cond, bar) do { unsigned _sp = 0; while (cond) { __builtin_amdgcn_s_sleep(1); \
    if ((++_sp & 255u) == 0u) { if (xb_ld(&(bar)[XB_TMO])) break; if (_sp > XB_SPIN_CAP) { atomicAdd(&(bar)[XB_TMO], 1u); break; } } } } while (0)
struct XcdBarrier { unsigned* bar; unsigned x; volatile XB_LAS unsigned* st; };
DI XcdBarrier xcd_barrier_post(unsigned* bar, volatile XB_LAS unsigned* st) {
    XcdBarrier b; b.bar = bar; b.x = xb_xcc_id(); b.st = st;
    if (threadIdx.x == 0) st[2] = xb_add(&bar[XB_XCNT(b.x)], 1u);
    return b;
}
DI void xcd_barrier_complete(unsigned* bar, unsigned x, unsigned& nloc, unsigned& nx) {
    const unsigned G = gridDim.x * gridDim.y * gridDim.z;
    unsigned sum, cnt, mine, sp = 0u;
    for (;;) {
        sum = 0u; cnt = 0u; mine = 0u;
#pragma unroll
        for (unsigned j = 0; j < 16; ++j) { const unsigned c = xb_ld(&bar[XB_XCNT(j)]); sum += c; cnt += (c > 0u) ? 1u : 0u; mine = (j == x) ? c : mine; }
        if (sum == G) break;
        __builtin_amdgcn_s_sleep(1);
        if ((++sp & 255u) == 0u) { if (xb_ld(&bar[XB_TMO])) break; if (sp > XB_SPIN_CAP) { atomicAdd(&bar[XB_TMO], 1u); break; } }
    }
    nloc = mine > 0u ? mine : 1u; nx = cnt > 0u ? cnt : 1u;
}
DI void xcd_barrier(const XcdBarrier& b) {
    asm volatile("s_waitcnt vmcnt(0)" ::: "memory");
    __syncthreads();
    if (threadIdx.x == 0) {
        unsigned* bar = b.bar;
        __builtin_amdgcn_s_waitcnt(0);
        unsigned nloc = b.st[0], nx = b.st[1];
        if (nloc == 0u) { xcd_barrier_complete(bar, b.x, nloc, nx); b.st[0] = nloc; b.st[1] = nx; }
        const unsigned old = xb_add(&bar[XB_XSUB(b.x)], 1u);
        const unsigned gen = old / nloc;
        if (old + 1u == (gen + 1u) * nloc) {
            __builtin_amdgcn_fence(__ATOMIC_RELEASE, "agent");
            asm volatile("s_waitcnt vmcnt(0)" ::: "memory");
            const unsigned og = xb_add(&bar[XB_TOP], 1u);
            const unsigned tg = og / nx;
            if (og + 1u == (tg + 1u) * nx) xb_add(&bar[XB_TOPGEN], 1u);
            else XB_SPIN(xb_ld(&bar[XB_TOPGEN]) == tg, bar);
            __builtin_amdgcn_fence(__ATOMIC_ACQUIRE, "agent");
            xb_add(&bar[XB_XGEN(b.x)], 1u);
            asm volatile("s_waitcnt vmcnt(0)" ::: "memory");
        } else {
            XB_SPIN(xb_ld(&bar[XB_XGEN(b.x)]) == gen, bar);
            __builtin_amdgcn_fence(__ATOMIC_ACQUIRE, "agent");
            asm volatile("s_waitcnt vmcnt(0)" ::: "memory");
        }
    }
    __syncthreads();
}
#ifndef ONLY
#define ONLY -1
#endif
#define PH(k) ((ONLY < 0 || ONLY == (k)) && ph == (k))
__global__ void __launch_bounds__(512) mega(Params p, int ph_lo, int ph_hi) {
  extern __shared__ __attribute__((aligned(16))) unsigned char shm[];
  cg::grid_group grid = cg::this_grid();
  const int bid = blockIdx.x, nblk = gridDim.x, tid = threadIdx.x;
  volatile XB_LAS unsigned* xst = (volatile XB_LAS unsigned*)((PG8_LAS unsigned char*)shm + (LDS_BYTES - 16));
  if (tid < 4) xst[tid] = 0u;
  __syncthreads();
  const XcdBarrier xb = xcd_barrier_post((unsigned*)(p.ws + OFF_CTL), xst);
  if (ph_lo > 100) grid.sync();
#ifndef REPMASK
#define REPMASK 0
#endif
#define RUNPH(k, ...) if ((ONLY < 0 || ONLY == (k)) && ph_lo <= (k) && (k) <= ph_hi) { __VA_ARGS__ } if (((REPMASK >> (k)) & 1) && ph_lo <= (k) && (k) <= ph_hi) { __syncthreads(); __VA_ARGS__ } if (ph_lo <= (k) && (k) < ph_hi) xcd_barrier(xb);
  RUNPH(0, phase0(p, shm, bid, nblk, tid);)
  RUNPH(1, phase_norm<true>(p, p.x, p.g_mix, 0, 1, bid, nblk, tid, shm);)
  RUNPH(2, pg8::Gemm g{(const bf16_t*)(p.ws + OFF_HB), (const bf16_t*)(p.ws + OFF_WINT), 8192, 6144, 2048}; pg8::StaticOrder S; S.init(8192, 6144, nblk, bid);
      EpiProj E{(bf16_t*)(p.ws + OFF_PB)};
      pg8::gemm_phase<EpiProj, pg8::StaticOrder, false>((PG8_LAS unsigned char*)shm, g, S, E, nullptr);)
  RUNPH(3, phase_attn(p, shm, bid, nblk, tid); if ((REPMASK >> 13) & 1) { __syncthreads(); phase_attn(p, shm, bid, nblk, tid); } phase_mlA(p, shm, bid, nblk, tid); if ((REPMASK >> 14) & 1) { __syncthreads(); phase_mlA(p, shm, bid, nblk, tid); })
  RUNPH(4, phase_scan(p, bid, nblk, tid);)
  RUNPH(5, phase_mlC(p, shm, bid, nblk, tid);)
  RUNPH(6, pg8::Gemm g{(const bf16_t*)(p.ws + OFF_MIX), (const bf16_t*)(p.ws + OFF_WOUTT), 8192, 2048, 2048}; pg8::StaticOrder S; S.init(8192, 2048, nblk, bid);
      EpiRes E{(float*)(p.ws + OFF_X1), p.x, (const float*)(p.ws + OFF_MOD)};
      pg8::gemm_phase<EpiRes, pg8::StaticOrder, false>((PG8_LAS unsigned char*)shm, g, S, E, nullptr);)
  RUNPH(7, phase_norm<false>(p, (const float*)(p.ws + OFF_X1), p.g_ffn, 3, 4, bid, nblk, tid, shm);)
  if (nblk == 256) {
    RUNPH(8, pg8::Gemm g{(const bf16_t*)(p.ws + OFF_HB), (const bf16_t*)(p.ws + OFF_WPQT), 8192, 2048, 2048}; pg8::StaticOrder S; S.init(8192, 2048, nblk, bid);
        EpiTopk E{&p, bid, nblk};
        pg8::gemm_phase<EpiTopk, pg8::StaticOrder, false>((PG8_LAS unsigned char*)shm, g, S, E, nullptr);)
  } else {
    RUNPH(8, pg8::Gemm g{(const bf16_t*)(p.ws + OFF_HB), (const bf16_t*)(p.ws + OFF_WPQT), 8192, 2048, 2048}; pg8::StaticOrder S; S.init(8192, 2048, nblk, bid);
        EpiBf E{(bf16_t*)(p.ws + OFF_QP)};
        pg8::gemm_phase<EpiBf, pg8::StaticOrder, false>((PG8_LAS unsigned char*)shm, g, S, E, nullptr);)
    RUNPH(9, phase_topk(p, bid, nblk, tid);)
  }
  RUNPH(10, phase_gA(p, bid, nblk, tid);)
  RUNPH(11, phase_gB(p, shm, bid, nblk, tid);)
  RUNPH(12, phase_final(p, bid, nblk, tid);)

}
extern "C" void kernel_launch(void* const* d_in, const int* in_sizes, int n_in, void* d_out, int out_size, void* d_ws, size_t ws_size, hipStream_t stream) {
  (void)in_sizes; (void)n_in; (void)out_size;
  if (ws_size < WS_TOTAL) { fprintf(stderr, "kernel_launch: workspace too small (%zu < %zu)\n", ws_size, (size_t)WS_TOTAL); return; }
  Params p{};
  const float** f = (const float**)&p;
  for (int i = 0; i < 25; ++i) f[i] = (const float*)d_in[i];
  p.out = (float*)d_out; p.ws = (unsigned char*)d_ws;
  static bool attr_set = false;
  if (!attr_set) { if (hipFuncSetAttribute((const void*)mega, hipFuncAttributeMaxDynamicSharedMemorySize, LDS_BYTES) != hipSuccess) { fprintf(stderr, "kernel_launch: hipFuncSetAttribute failed\n"); return; } attr_set = true; }
  (void)hipMemsetAsync((unsigned char*)d_ws + OFF_CTL, 0, 16384, stream);
    int lo = 0, hi = 12;
  void* args[] = {&p, &lo, &hi};
  static int grid_blocks = 0;
  if (!grid_blocks) { int dev = 0, cus = 0, per_cu = 0; (void)hipGetDevice(&dev); (void)hipDeviceGetAttribute(&cus, hipDeviceAttributeMultiprocessorCount, dev);
    (void)hipOccupancyMaxActiveBlocksPerMultiprocessor(&per_cu, (const void*)mega, 512, LDS_BYTES);
    int g = cus * (per_cu > 0 ? per_cu : 1); if (g > 256) g = 256; g &= ~7; if (g < 8) g = 8; grid_blocks = g; }
  hipError_t e = hipLaunchCooperativeKernel((const void*)mega, dim3(grid_blocks), dim3(512), args, LDS_BYTES, stream);
  if (e != hipSuccess) fprintf(stderr, "cooperative launch failed: %s\n", hipGetErrorString(e));
}
```

```cpp
#include <hip/hip_runtime.h>
#include <hip/hip_cooperative_groups.h>
#include <cstdio>
#include <cstdint>
namespace cg = cooperative_groups;
#define DI __device__ __forceinline__
namespace pg8 {
#define PG8_LAS __attribute__((address_space(3)))
typedef unsigned short bf16_t;
typedef short bf16x8 __attribute__((ext_vector_type(8)));
typedef float f32x4 __attribute__((ext_vector_type(4)));
typedef unsigned u32x4 __attribute__((ext_vector_type(4)));
constexpr int BM = 256, BK = 64, HALF = 128, HTB = HALF * BK * 2  , STAGE_BYTES = 8 * HTB, NXCD = 8, WGM = 8;

__host__ __device__ __forceinline__ int lds_byte(int r, int c) { const int st = (r >> 4) * 2 + (c >> 5), rr = r & 15, cc = c & 31, ob = rr * 64 + cc * 2; return st * 1024 + (ob ^ (((ob >> 9) & 1) << 5)); }
__host__ __device__ __forceinline__ void stage_rc(int b, int& R, int& C) { const int st = b / 1024, sb = b % 1024, swz = sb ^ (((sb >> 9) & 1) << 5); R = (st >> 1) * 16 + swz / 64; C = (st & 1) * 32 + (swz % 64) / 2; }
__host__ __device__ __forceinline__ int perm32(int rho) { const int n = rho >> 4, i = rho & 15; return 8 * (i >> 2) + 4 * n + (i & 3); }

struct Unit { int pm, pn; };
struct Gemm { const bf16_t* A; const bf16_t* Bt; int M, N, K; };

struct StaticOrder {
    int nM, nN, nwg, G, c;
    __host__ __device__ void init(int M, int N, int G_, int c_) { nM = M / BM; nN = N / BM; nwg = nM * nN; G = G_; c = c_; }
    __host__ __device__ bool next(int i, Unit& u) const {
        const long L = (long)i * G + c; if (L >= nwg) return false;
        int wgid = (int)L; { const int q = nwg / NXCD, r = nwg % NXCD, xcd = wgid % NXCD, off = wgid / NXCD; wgid = (xcd < r ? xcd * (q + 1) : r * (q + 1) + (xcd - r) * q) + off; }
        const int nig = WGM * nN, gid = wgid / nig, fm = gid * WGM, gsz = (nM - fm) < WGM ? (nM - fm) : WGM;
        u.pm = fm + ((wgid % nig) % gsz); u.pn = (wgid % nig) / gsz; return true;
    }
    __device__ __forceinline__ void a_ready(const Unit&) const {}
    __device__ __forceinline__ void done(const Unit&) const {}
};
template <class Epi, class Sched, bool STAMP = false>
__device__ __forceinline__ void gemm_phase(PG8_LAS unsigned char* lds, const Gemm g, const Sched& S, const Epi& E, unsigned long long* stamps) {
    const int tid = threadIdx.x, wid = __builtin_amdgcn_readfirstlane(tid >> 6), lane = tid & 63, wr = wid >> 2, wc = wid & 3, fr = lane & 15, fq = lane >> 4;
    const int K = g.K, nt = K / BK;
    int ts_lo = 0, ts_hi = 0, nts = 0; const unsigned long long rt_entry = STAMP ? (unsigned long long)wall_clock64() : 0ull;
#define PG8_STAMP() do { if (STAMP && wid == 0 && nts < 64) { const unsigned long long _c = (unsigned long long)clock64(); \
        ts_lo = (lane == nts) ? (int)(unsigned)_c : ts_lo; ts_hi = (lane == nts) ? (int)(unsigned)(_c >> 32) : ts_hi; ++nts; } } while (0)
    PG8_STAMP();
    unsigned voffA[2], voffB[2];
#pragma unroll
    for (int i = 0; i < 2; ++i) { int R, C; stage_rc(tid * 16 + i * 8192, R, C); const int Rb = Epi::PERM ? ((R & ~31) + perm32(R & 31)) : R;
        voffA[i] = (unsigned)(R * K + C) * 2u; voffB[i] = (unsigned)(Rb * K + C) * 2u; }
    const size_t kstep = (size_t)(BK * 2);
    const size_t hstep = (size_t)HALF * K * 2;
    const size_t tstep = 2 * hstep;
    const unsigned ldsw = (unsigned)wid * 1024u;
    const int aoff = lds_byte(wr * 64 + fr, fq * 8), boff = lds_byte(wc * 32 + fr, fq * 8);
#define PG8_SA(b, h) (((b) * 2 + (h)) * HTB)
#define PG8_SB(b, h) ((4 + (b) * 2 + (h)) * HTB)
#define PG8_STAGE(bufoff, gbase, voff) do { _Pragma("unroll") for (int _i = 0; _i < 2; ++_i) \
        __builtin_amdgcn_global_load_lds((const unsigned*)((const char*)(gbase) + (voff)[_i]), (PG8_LAS unsigned*)(lds + (bufoff) + ldsw + _i * 8192), 16, 0, 0); } while (0)
#define PG8_LDA(dst, b, h) do { _Pragma("unroll") for (int m = 0; m < 4; ++m) _Pragma("unroll") for (int k = 0; k < 2; ++k) dst[m][k] = *(const PG8_LAS bf16x8*)(lds + PG8_SA(b, h) + aoff + m * 2048 + k * 1024); } while (0)
#define PG8_LDB(dst, b, h) do { _Pragma("unroll") for (int n = 0; n < 2; ++n) _Pragma("unroll") for (int k = 0; k < 2; ++k) dst[n][k] = *(const PG8_LAS bf16x8*)(lds + PG8_SB(b, h) + boff + n * 2048 + k * 1024); } while (0)
#define PG8_MMA(ai, bj, At, Bt) do { __builtin_amdgcn_s_setprio(1); _Pragma("unroll") for (int m = 0; m < 4; ++m) _Pragma("unroll") for (int n = 0; n < 2; ++n) _Pragma("unroll") for (int k = 0; k < 2; ++k) \
        acc[ai][bj][m][n] = __builtin_amdgcn_mfma_f32_16x16x32_bf16(Bt[n][k], At[m][k], acc[ai][bj][m][n], 0, 0, 0); __builtin_amdgcn_s_setprio(0); } while (0)
#define PG8_WAIT_V(n) asm volatile("s_waitcnt vmcnt(" #n ")" ::: "memory")
#define PG8_WAIT_L(n) asm volatile("s_waitcnt lgkmcnt(" #n ")" ::: "memory")
#define PG8_BAR __builtin_amdgcn_s_barrier()
#define PG8_SCHED __builtin_amdgcn_sched_barrier(0)
    Unit cur, nxt; int ui = 0;
    if (!S.next(0, cur)) return;
    f32x4 acc[2][2][4][2];
#pragma unroll
    for (int a = 0; a < 2; ++a)
#pragma unroll
        for (int b = 0; b < 2; ++b)
#pragma unroll
            for (int m = 0; m < 4; ++m)
#pragma unroll
                for (int n = 0; n < 2; ++n) acc[a][b][m][n] = (f32x4){0.f, 0.f, 0.f, 0.f};
    bf16x8 At[4][2], B0[2][2], B1[2][2];
    const char* cA = (const char*)g.A + (size_t)cur.pm * tstep; const char* cB = (const char*)g.Bt + (size_t)cur.pn * tstep;
    S.a_ready(cur);
    PG8_STAGE(PG8_SB(0, 0), cB, voffB); PG8_STAGE(PG8_SA(0, 0), cA, voffA); PG8_STAGE(PG8_SB(0, 1), cB + hstep, voffB); PG8_STAGE(PG8_SA(0, 1), cA + hstep, voffA);
    if (wr == 1) PG8_BAR;
    PG8_WAIT_V(4); PG8_BAR;
    PG8_STAGE(PG8_SB(1, 0), cB + kstep, voffB); PG8_STAGE(PG8_SA(1, 0), cA + kstep, voffA); PG8_STAGE(PG8_SB(1, 1), cB + hstep + kstep, voffB);
    PG8_WAIT_V(6); PG8_BAR;
    PG8_STAMP();
    for (;;) {
        const bool has_next = S.next(ui + 1, nxt);
        const char* nA = has_next ? (const char*)g.A + (size_t)nxt.pm * tstep : cA; const char* nB = has_next ? (const char*)g.Bt + (size_t)nxt.pn * tstep : cB;
        for (int t = 0; t < nt; t += 2) {
            const bool last = (t == nt - 2);
            const char* a1 = cA + (size_t)(t + 1) * kstep;
            const char* a2 = last ? nA : cA + (size_t)(t + 2) * kstep; const char* b2 = last ? nB : cB + (size_t)(t + 2) * kstep;
            const char* a3 = a2 + kstep; const char* b3 = b2 + kstep;
            if (last && has_next) S.a_ready(nxt);
            PG8_LDB(B0, 0, 0); PG8_SCHED; PG8_LDA(At, 0, 0); PG8_STAGE(PG8_SA(1, 1), a1 + hstep, voffA);
            PG8_WAIT_L(8); PG8_BAR; PG8_WAIT_L(0); PG8_MMA(0, 0, At, B0); PG8_BAR; PG8_SCHED;
            PG8_LDB(B1, 0, 1); PG8_STAGE(PG8_SB(0, 0), b2, voffB);
            PG8_BAR; PG8_WAIT_L(0); PG8_MMA(0, 1, At, B1); PG8_BAR;
            PG8_LDA(At, 0, 1); PG8_STAGE(PG8_SA(0, 0), a2, voffA);
            PG8_BAR; PG8_WAIT_L(0); PG8_MMA(1, 0, At, B0); PG8_BAR; PG8_SCHED;
            PG8_STAGE(PG8_SB(0, 1), b2 + hstep, voffB);
            PG8_WAIT_V(6); PG8_BAR; PG8_MMA(1, 1, At, B1); PG8_BAR;
            PG8_LDB(B0, 1, 0); PG8_SCHED; PG8_LDA(At, 1, 0); PG8_STAGE(PG8_SA(0, 1), a2 + hstep, voffA);
            PG8_WAIT_L(8); PG8_BAR; PG8_WAIT_L(0); PG8_MMA(0, 0, At, B0); PG8_BAR; PG8_SCHED;
            PG8_LDB(B1, 1, 1); PG8_STAGE(PG8_SB(1, 0), b3, voffB);
            PG8_BAR; PG8_WAIT_L(0); PG8_MMA(0, 1, At, B1); PG8_BAR;
            PG8_LDA(At, 1, 1); PG8_STAGE(PG8_SA(1, 0), a3, voffA);
            PG8_BAR; PG8_WAIT_L(0); PG8_MMA(1, 0, At, B0); PG8_BAR; PG8_SCHED;
            PG8_STAGE(PG8_SB(1, 1), b3 + hstep, voffB);
            PG8_WAIT_V(6); PG8_BAR; PG8_MMA(1, 1, At, B1); PG8_BAR;
        }
        PG8_STAMP();
        if constexpr (!Epi::AFTER_DRAIN) { E(acc, cur, wr, wc, fr, fq); S.done(cur); }
        PG8_STAMP();
        if (!has_next) break;
#pragma unroll
        for (int a = 0; a < 2; ++a)
#pragma unroll
            for (int b = 0; b < 2; ++b)
#pragma unroll
                for (int m = 0; m < 4; ++m)
#pragma unroll
                    for (int n = 0; n < 2; ++n) acc[a][b][m][n] = (f32x4){0.f, 0.f, 0.f, 0.f};
        cur = nxt; cA = nA; cB = nB; ++ui;
    }
    PG8_WAIT_V(0);
    if (wr == 0) PG8_BAR;
    PG8_BAR;
    if constexpr (Epi::AFTER_DRAIN) { E.fused(acc, cur, wr, wc, fr, fq, lds, wid, lane); S.done(cur); }
    PG8_STAMP();
    if (STAMP && wid == 0) { stamps[lane] = lane < nts ? (((unsigned long long)(unsigned)ts_hi << 32) | (unsigned)ts_lo) : 0ull;
        if (lane == 62) stamps[62] = rt_entry; if (lane == 63) stamps[63] = (unsigned long long)wall_clock64(); }
#undef PG8_STAMP
#undef PG8_SA
#undef PG8_SB
#undef PG8_STAGE
#undef PG8_LDA
#undef PG8_LDB
#undef PG8_MMA
#undef PG8_WAIT_V
#undef PG8_WAIT_L
#undef PG8_BAR
#undef PG8_SCHED
}
}
using pg8::bf16_t; using pg8::bf16x8; using pg8::f32x4; using pg8::u32x4;
typedef short s16x4 __attribute__((ext_vector_type(4)));
typedef float f32x16 __attribute__((ext_vector_type(16)));
typedef float f32x2 __attribute__((ext_vector_type(2)));
typedef unsigned u32x2 __attribute__((ext_vector_type(2)));
typedef int i32x4 __attribute__((ext_vector_type(4)));
typedef __bf16 bfv2 __attribute__((ext_vector_type(2)));

constexpr int T_ = 8192, D_ = 2048;
constexpr size_t OFF_CTL = 0;
constexpr size_t OFF_MOD = 16384;
constexpr size_t OFF_ROPE = OFF_MOD + 262144;
constexpr size_t OFF_WG = OFF_ROPE + 524288;
constexpr size_t OFF_GATES = OFF_WG + 65536;
constexpr size_t OFF_IDX = OFF_GATES + 262144;
constexpr size_t OFF_GW = OFF_IDX + 4194304;
constexpr size_t OFF_NST = OFF_GW + 4194304;
constexpr size_t OFF_DEC = OFF_NST + 262144;
constexpr size_t OFF_SU = OFF_DEC + 4096;
constexpr size_t OFF_SV = OFF_SU + 65536;
constexpr size_t OFF_AACC = OFF_SV + 65536;
constexpr size_t OFF_SKB = OFF_AACC + 4194304;
constexpr size_t OFF_WINT = OFF_SKB + 524288;
constexpr size_t OFF_WOUTT = OFF_WINT + 25165824;
constexpr size_t OFF_WPQT = OFF_WOUTT + 8388608;
constexpr size_t OFF_PU = OFF_WPQT + 8388608;
constexpr size_t OFF_PV = OFF_PU + 67108864;
constexpr size_t OFF_HB = OFF_PV + 67108864;
constexpr size_t OFF_PB = OFF_HB + 33554432;
constexpr size_t OFF_X1 = OFF_PB;
constexpr size_t OFF_QP = OFF_PB + 67108864;
constexpr size_t OFF_MIX = OFF_PB + 100663296;
constexpr size_t OFF_CST = OFF_MIX + 33554432;
constexpr size_t OFF_PA = OFF_QP;
constexpr size_t OFF_Y = OFF_CST;
constexpr size_t WS_TOTAL = OFF_CST + 67108864;
constexpr int LDS_BYTES = 147456;

struct Params {
  const float *x, *c, *w_ada, *b_ada, *g_mix, *w_in, *conv_w, *conv_b, *b_igate, *b_fgate,
              *lq1, *lk1, *lq2, *lk2, *da_norm, *ml_norm, *w_out, *g_ffn, *w_pq, *sub_keys,
              *peer_u, *peer_v, *w_ada_final, *b_ada_final, *g_final;
  float* out;
  unsigned char* ws;
};

DI unsigned pk2(float lo, float hi) { f32x2 v = {lo, hi}; bfv2 r = __builtin_convertvector(v, bfv2); return __builtin_bit_cast(unsigned, r); }
DI float bflo(unsigned u) { return __uint_as_float(u << 16); }
DI float bfhi(unsigned u) { return __uint_as_float(u & 0xffff0000u); }
DI float bf2f(bf16_t b) { return __uint_as_float(((unsigned)b) << 16); }
DI float wave_sum(float v) {
#pragma unroll
  for (int o = 1; o < 64; o <<= 1) v += __shfl_xor(v, o);
  return v;
}
DI f32x16 mfma32(bf16x8 a, bf16x8 b, f32x16 c) { return __builtin_amdgcn_mfma_f32_32x32x16_bf16(a, b, c, 0, 0, 0); }
DI int crow(int i, int h) { return (i & 3) + 8 * (i >> 2) + 4 * h; }
template <int S> DI bf16x8 pack8(const f32x16& x) {
  u32x4 p; p[0] = pk2(x[8 * S], x[8 * S + 1]); p[1] = pk2(x[8 * S + 2], x[8 * S + 3]); p[2] = pk2(x[8 * S + 4], x[8 * S + 5]); p[3] = pk2(x[8 * S + 6], x[8 * S + 7]);
  return __builtin_bit_cast(bf16x8, p);
}
DI bf16x8 cat4(s16x4 lo, s16x4 hi) { return __builtin_shufflevector(lo, hi, 0, 1, 2, 3, 4, 5, 6, 7); }
DI f32x16 zero16() { f32x16 z; for (int i = 0; i < 16; ++i) z[i] = 0.f; return z; }
#define LDS_WAIT() asm volatile("s_waitcnt lgkmcnt(0)" ::: "memory")
DI int newpos_in(int o) { if (o >= 2048) return o; const int hd = o >> 6, j = o & 63; return hd * 64 + (j < 32 ? 2 * j : 2 * (j - 32) + 1); }
DI void transpose_item(const float* W, int ldw, int nblk, bf16_t* WT, int K, float* scr, int item, int lane, bool perm) {
  const int kb = item / nblk, nb = item % nblk, k0 = 64 * kb, n0 = 32 * nb;
#pragma unroll 8
  for (int i = 0; i < 32; ++i) { const int kk = 2 * i + (lane >> 5); scr[kk * 33 + (lane & 31)] = W[(size_t)(k0 + kk) * ldw + n0 + (lane & 31)]; }
  LDS_WAIT();
  const int c = lane & 7;
#pragma unroll
  for (int j = 0; j < 4; ++j) { const int n = (lane >> 3) + 8 * j; const float* s = scr + (8 * c) * 33 + n;
    u32x4 o; o[0] = pk2(s[0 * 33], s[1 * 33]); o[1] = pk2(s[2 * 33], s[3 * 33]); o[2] = pk2(s[4 * 33], s[5 * 33]); o[3] = pk2(s[6 * 33], s[7 * 33]);
    const int orow = perm ? newpos_in(n0 + n) : (n0 + n);
    *(u32x4*)(WT + (size_t)orow * K + k0 + 8 * c) = o; }
  LDS_WAIT();
}
#define CPR_LOAD(dst, rowx) { const int r_ = (rowx); const float* src_ = (r_ < 16384 ? p.peer_u + (size_t)r_ * 2048 : p.peer_v + (size_t)(r_ - 16384) * 2048); \
    _Pragma("unroll") for (int j_ = 0; j_ < 8; ++j_) dst[j_] = *(const f32x4*)(src_ + (j_ >> 2) * 1024 + lane * 16 + (j_ & 3) * 4); }
DI void convert_peer_rows(const Params& p, int gw, int NGW, int lane) {
  unsigned char* PU8 = (unsigned char*)(p.ws + OFF_PU); unsigned char* PV8 = (unsigned char*)(p.ws + OFF_PV);
  float* SU = (float*)(p.ws + OFF_SU); float* SV = (float*)(p.ws + OFF_SV);
  if (gw >= 32768) return;
  f32x4 va[8], vb[8];
  CPR_LOAD(va, gw);
  CPR_LOAD(vb, (gw + NGW < 32768) ? gw + NGW : gw);
  for (int row = gw; row < 32768; row += NGW) {
    const bool isu = row < 16384; const int rr = isu ? row : row - 16384;
    f32x4 v[8]; float am = 0.f;
#pragma unroll
    for (int j = 0; j < 8; ++j) { v[j] = va[j]; va[j] = vb[j]; am = fmaxf(am, fmaxf(fmaxf(fabsf(v[j][0]), fabsf(v[j][1])), fmaxf(fabsf(v[j][2]), fabsf(v[j][3])))); }
    CPR_LOAD(vb, (row + 2 * NGW < 32768) ? row + 2 * NGW : row);
#pragma unroll
    for (int o = 1; o < 64; o <<= 1) am = fmaxf(am, __shfl_xor(am, o));
    const float sc = am > 0.f ? 448.0f / am : 1.0f, inv = am > 0.f ? am * (1.0f / 448.0f) : 1.0f;
#pragma unroll
    for (int q = 0; q < 2; ++q) { u32x4 o4;
#pragma unroll
      for (int k = 0; k < 4; ++k) { const f32x4 a = v[q * 4 + k] * sc; int r = __builtin_amdgcn_cvt_pk_fp8_f32(a[0], a[1], 0, false); r = __builtin_amdgcn_cvt_pk_fp8_f32(a[2], a[3], r, true); o4[k] = (unsigned)r; }
      *(u32x4*)((isu ? PU8 : PV8) + ((size_t)(q * 4 + (lane >> 4)) * 16384 + rr) * 256 + (lane & 15) * 16) = o4; }
    if (lane == 0) (isu ? SU : SV)[rr] = inv;
  }
}
#undef CPR_LOAD
DI void phase0(const Params& p, unsigned char* lds, int bid, int nblk, int tid) {
  const int lane = tid & 63, wave = tid >> 6;
  float* MOD = (float*)(p.ws + OFF_MOD);
  float* cs = (float*)lds;
  float* red = (float*)(lds + 32768);
  for (int item = bid; item < 256; item += nblk) {
    const int col0 = item * 64;
    __syncthreads();
    for (int i = tid; i < 8192; i += 512) { const float v = p.c[i]; cs[i] = v / (1.f + expf(-v)); }
    __syncthreads();
    const int cg = tid & 15, dg = tid >> 4;
    const int col = col0 + cg * 4;
    const float* W; int ldw, wc; const float* bb;
    if (col < 12288) { W = p.w_ada; ldw = 12288; wc = col; bb = p.b_ada + col0; } else { W = p.w_ada_final; ldw = 4096; wc = col - 12288; bb = p.b_ada_final + (col0 - 12288); }
    f32x4 acc[4];
#pragma unroll
    for (int b = 0; b < 4; ++b) acc[b] = (f32x4){0.f, 0.f, 0.f, 0.f};
#pragma unroll 8
    for (int i = 0; i < 64; ++i) {
      const int d = dg * 64 + i;
      const f32x4 w = *(const f32x4*)(W + (size_t)d * ldw + wc);
#pragma unroll
      for (int b = 0; b < 4; ++b) acc[b] += cs[b * 2048 + d] * w;
    }
#pragma unroll
    for (int b = 0; b < 4; ++b) *(f32x4*)(red + (dg * 4 + b) * 64 + cg * 4) = acc[b];
    __syncthreads();
    if (tid < 256) { const int b = tid >> 6, cc = tid & 63; float sm = bb[cc];
      for (int g = 0; g < 32; ++g) sm += red[(g * 4 + b) * 64 + cc];
      MOD[b * 16384 + col0 + cc] = sm; }
  }
  __syncthreads();
  float* scr = (float*)(lds + 65536 + wave * 8448);
  const int gw = bid * 8 + wave, NGW = nblk * 8;
  constexpr int I_IN = 32 * 192, I_O = 32 * 64;
  bf16_t* WINT = (bf16_t*)(p.ws + OFF_WINT); bf16_t* WOUTT = (bf16_t*)(p.ws + OFF_WOUTT); bf16_t* WPQT = (bf16_t*)(p.ws + OFF_WPQT);
  for (int it = gw; it < I_IN + 2 * I_O; it += NGW) {
    if (it < I_IN) transpose_item(p.w_in, 6152, 192, WINT, 2048, scr, it, lane, true);
    else if (it < I_IN + I_O) transpose_item(p.w_out, 2048, 64, WOUTT, 2048, scr, it - I_IN, lane, false);
    else transpose_item(p.w_pq, 2048, 64, WPQT, 2048, scr, it - I_IN - I_O, lane, false);
  }
  {
    bf16_t* SKB = (bf16_t*)(p.ws + OFF_SKB);
    for (int i = bid * 512 + tid; i < 32768; i += nblk * 512) { const f32x4 a0 = *(const f32x4*)(p.sub_keys + (size_t)i * 8), a1 = *(const f32x4*)(p.sub_keys + (size_t)i * 8 + 4);
      u32x4 ap; ap[0] = pk2(a0[0], a0[1]); ap[1] = pk2(a0[2], a0[3]); ap[2] = pk2(a1[0], a1[1]); ap[3] = pk2(a1[2], a1[3]); *(u32x4*)(SKB + (size_t)i * 8) = ap; }
    float* WG = (float*)(p.ws + OFF_WG);
    for (int i = bid * 512 + tid; i < 16384; i += nblk * 512) { const int j = i >> 11, k = i & 2047; WG[i] = p.w_in[(size_t)k * 6152 + 6144 + j]; }
  }
}
template <bool GATES> DI void phase_norm(const Params& p, const float* src, const float* gvec, int sh_idx, int sc_idx, int bid, int nblk, int tid, unsigned char* lds) {
  const int lane = tid & 63, wave = tid >> 6;
  float* WGs = (float*)lds;
  if (GATES) {
    const float* WGg = (const float*)(p.ws + OFF_WG);
#pragma unroll
    for (int i = 0; i < 8; ++i) { const int e4 = (tid + 512 * i) * 4, j = e4 >> 11, e = e4 & 2047, r = e >> 9, ln = (e & 511) >> 3, q = (e >> 2) & 1;
      *(f32x4*)(WGs + j * 2048 + r * 512 + q * 256 + ln * 4) = *(const f32x4*)(WGg + e4); }
    __syncthreads();
  }
  float* G1s = (float*)(lds + 65536); float* SHs = (float*)(lds + 98304);
  { const float* MODg = (const float*)(p.ws + OFF_MOD);
#pragma unroll 1
    for (int i = 0; i < 4; ++i) { const int e4 = (tid + 512 * i) * 4, b = e4 >> 11, e = e4 & 2047, r = e >> 9, ln = (e & 511) >> 3, q = (e >> 2) & 1;
      const f32x4 g4 = *(const f32x4*)(gvec + e), sc4 = *(const f32x4*)(MODg + b * 16384 + sc_idx * 2048 + e), sh4 = *(const f32x4*)(MODg + b * 16384 + sh_idx * 2048 + e);
      *(f32x4*)(G1s + b * 2048 + r * 512 + q * 256 + ln * 4) = g4 * (1.f + sc4); *(f32x4*)(SHs + b * 2048 + r * 512 + q * 256 + ln * 4) = sh4; }
    __syncthreads(); }
  const float* MOD = (const float*)(p.ws + OFF_MOD);
  bf16_t* HB = (bf16_t*)(p.ws + OFF_HB);
  const float* WG = (const float*)(p.ws + OFF_WG);
  float* GT = (float*)(p.ws + OFF_GATES);
  for (int t = bid * 8 + wave; t < T_; t += nblk * 8) {
    const int b = t >> 11;
    const float* xr = src + (size_t)t * 2048;
    f32x4 v[8];
    float ss = 0.f;
#pragma unroll
    for (int r = 0; r < 4; ++r) {
      v[2 * r] = *(const f32x4*)(xr + r * 512 + lane * 8); v[2 * r + 1] = *(const f32x4*)(xr + r * 512 + lane * 8 + 4);
#pragma unroll
      for (int q = 0; q < 2; ++q) ss += v[2 * r + q][0] * v[2 * r + q][0] + v[2 * r + q][1] * v[2 * r + q][1] + v[2 * r + q][2] * v[2 * r + q][2] + v[2 * r + q][3] * v[2 * r + q][3];
    }
    ss = wave_sum(ss);
    const float rstd = 1.0f / sqrtf(ss * (1.f / 2048.f) + 1e-6f);
    const float* sh = MOD + b * 16384 + sh_idx * 2048; const float* sc = MOD + b * 16384 + sc_idx * 2048;
#pragma unroll
    for (int r = 0; r < 4; ++r) {
#pragma unroll
      for (int q = 0; q < 2; ++q) {
        const f32x4 g4 = *(const f32x4*)(G1s + b * 2048 + r * 512 + q * 256 + lane * 4), sh4 = *(const f32x4*)(SHs + b * 2048 + r * 512 + q * 256 + lane * 4);
        v[2 * r + q] = v[2 * r + q] * rstd * g4 + sh4;
      }
    }
#pragma unroll
    for (int r = 0; r < 4; ++r) {
      u32x4 o; o[0] = pk2(v[2 * r][0], v[2 * r][1]); o[1] = pk2(v[2 * r][2], v[2 * r][3]); o[2] = pk2(v[2 * r + 1][0], v[2 * r + 1][1]); o[3] = pk2(v[2 * r + 1][2], v[2 * r + 1][3]);
      *(u32x4*)(HB + (size_t)t * 2048 + r * 512 + lane * 8) = o;
    }
    if (GATES) {
      float mine = 0.f;
#pragma unroll 1
      for (int j = 0; j < 8; ++j) {
        float d = 0.f;
#pragma unroll
        for (int r = 0; r < 4; ++r)
#pragma unroll
          for (int q = 0; q < 2; ++q) { const f32x4 w = *(const f32x4*)(WGs + j * 2048 + r * 512 + q * 256 + lane * 4); const f32x4 a = v[2 * r + q]; d += a[0] * w[0] + a[1] * w[1] + a[2] * w[2] + a[3] * w[3]; }
        d = wave_sum(d);
        if (lane == j) mine = d;
      }
      if (lane < 8) GT[t * 8 + lane] = mine;
    }
  }
}
struct EpiProj {
  static constexpr bool PERM = true, AFTER_DRAIN = false;
  bf16_t* PB;
  DI void operator()(const f32x4 (&acc)[2][2][4][2], const pg8::Unit& u, int wr, int wc, int fr, int fq) const {
    const int row0 = u.pm * 256 + wr * 64 + fr, col0 = u.pn * 256 + wc * 32 + 8 * fq;
    const bool rope = u.pn < 8; const float qs = u.pn < 4 ? 0.125f * 1.4426950408889634f : 1.0f;
    float ir[2][4];
#pragma unroll
    for (int bj = 0; bj < 2; ++bj) { const int i0 = ((col0 + bj * 128) & 63) >> 1;
#pragma unroll
      for (int k = 0; k < 4; ++k) ir[bj][k] = exp2f(-(float)(i0 + k) * 0.41524101186092029f) * 0.15915494309189535f; }
#pragma unroll
    for (int ai = 0; ai < 2; ++ai)
#pragma unroll
      for (int m = 0; m < 4; ++m) {
        const int row = row0 + ai * 128 + m * 16; const float fpos = (float)(row & 2047);
#pragma unroll
        for (int bj = 0; bj < 2; ++bj) {
          float v[8];
#pragma unroll
          for (int n = 0; n < 2; ++n)
#pragma unroll
            for (int k = 0; k < 4; ++k) v[4 * n + k] = acc[ai][bj][m][n][k];
          if (rope) {
#pragma unroll
            for (int k = 0; k < 4; ++k) { const float rr = __builtin_amdgcn_fractf(fpos * ir[bj][k]); const float cc = __builtin_amdgcn_cosf(rr), sn = __builtin_amdgcn_sinf(rr);
              const float a0 = v[2 * k] * cc - v[2 * k + 1] * sn, a1 = v[2 * k + 1] * cc + v[2 * k] * sn; v[2 * k] = a0 * qs; v[2 * k + 1] = a1 * qs; }
          }
          u32x4 o; o[0] = pk2(v[0], v[1]); o[1] = pk2(v[2], v[3]); o[2] = pk2(v[4], v[5]); o[3] = pk2(v[6], v[7]);
          *(u32x4*)(PB + (size_t)row * 6144 + col0 + bj * 128) = o;
        }
      }
  }
};
struct EpiRes {
  static constexpr bool PERM = false, AFTER_DRAIN = false;
  float* X1; const float* x; const float* MOD;
  DI void operator()(const f32x4 (&acc)[2][2][4][2], const pg8::Unit& u, int wr, int wc, int fr, int fq) const {
    const int row0 = u.pm * 256 + wr * 64 + fr, col0 = u.pn * 256 + wc * 32 + 4 * fq;
    const int b = (u.pm * 256) >> 11;
    f32x4 gt[2][2];
#pragma unroll
    for (int bj = 0; bj < 2; ++bj)
#pragma unroll
      for (int n = 0; n < 2; ++n) gt[bj][n] = *(const f32x4*)(MOD + b * 16384 + 2 * 2048 + col0 + bj * 128 + n * 16);
#pragma unroll
    for (int ai = 0; ai < 2; ++ai) {
      f32x4 xv[4][2][2];
#pragma unroll
      for (int m = 0; m < 4; ++m)
#pragma unroll
        for (int bj = 0; bj < 2; ++bj)
#pragma unroll
          for (int n = 0; n < 2; ++n) xv[m][bj][n] = *(const f32x4*)(x + (size_t)(row0 + ai * 128 + m * 16) * 2048 + col0 + bj * 128 + n * 16);
#pragma unroll
      for (int m = 0; m < 4; ++m)
#pragma unroll
        for (int bj = 0; bj < 2; ++bj)
#pragma unroll
          for (int n = 0; n < 2; ++n) *(f32x4*)(X1 + (size_t)(row0 + ai * 128 + m * 16) * 2048 + col0 + bj * 128 + n * 16) = xv[m][bj][n] + gt[bj][n] * acc[ai][bj][m][n];
    }
  }
};
struct EpiBf {
  static constexpr bool PERM = true, AFTER_DRAIN = false;
  bf16_t* O;
  DI void operator()(const f32x4 (&acc)[2][2][4][2], const pg8::Unit& u, int wr, int wc, int fr, int fq) const {
    const int row0 = u.pm * 256 + wr * 64 + fr, col0 = u.pn * 256 + wc * 32 + 8 * fq;
#pragma unroll
    for (int ai = 0; ai < 2; ++ai)
#pragma unroll
      for (int m = 0; m < 4; ++m) {
        const size_t ro = (size_t)(row0 + ai * 128 + m * 16) * 2048;
#pragma unroll
        for (int bj = 0; bj < 2; ++bj) { const f32x4 v0 = acc[ai][bj][m][0], v1 = acc[ai][bj][m][1]; u32x4 o; o[0] = pk2(v0[0], v0[1]); o[1] = pk2(v0[2], v0[3]); o[2] = pk2(v1[0], v1[1]); o[3] = pk2(v1[2], v1[3]); *(u32x4*)(O + ro + col0 + bj * 128) = o; }
      }
  }
};
DI bf16_t f2bf1(float x) { return (bf16_t)(pk2(x, 0.f) & 0xffffu); }
DI void phase_attn(const Params& p, unsigned char* lds, int bid, int nblk, int tid_in) {
  const bf16_t* PB = (const bf16_t*)(p.ws + OFF_PB); bf16_t* MIX = (bf16_t*)(p.ws + OFF_MIX);
  float* XE = (float*)(lds + 71680);
  float d1 = 0.f, d2 = 0.f;
  for (int i = 0; i < 64; ++i) { d1 += p.lq1[i] * p.lk1[i]; d2 += p.lq2[i] * p.lk2[i]; }
  const float lam = expf(d1) - expf(d2) + 0.2f;
  for (int u0 = bid; u0 < 256; u0 += nblk) {
    const int u = (nblk == 256) ? ((u0 & 7) * 32 + (u0 >> 3)) : u0;
    const int bh = u >> 3, pi = u & 7, b = bh >> 3, hd = bh & 7;
    u32x4 kreg[2], vreg[2];
    for (int half = 0; half < 2; ++half) {
      int tid = tid_in; asm volatile("" : "+v"(tid));
      const int lane = tid & 63, wave = tid >> 6, r = lane & 31, h = lane >> 5;
      const int map = wave & 1, qs = wave >> 1;
      const int qb = half ? 15 - pi : pi;
      const int qg = qb * 128 + qs * 32 + r;
      const size_t tq = (size_t)b * 2048 + qg;
      bf16x8 bq[4];
#pragma unroll
      for (int s = 0; s < 4; ++s) bq[s] = *(const bf16x8*)(PB + tq * 6144 + (2 * hd + map) * 64 + 16 * s + 8 * h);
      f32x16 o[4];
#pragma unroll
      for (int et = 0; et < 4; ++et) o[et] = zero16();
      float m_run = -INFINITY, l_run = 0.f;
      const int nkt = 2 * qb + 2;
      const int vc16 = tid & 15, vrp = tid >> 4;
      const bf16_t* kbase = PB + (size_t)b * 2048 * 6144 + 1024 + hd * 128;
      const bf16_t* vbase = PB + (size_t)b * 2048 * 6144 + 2048 + hd * 128 + vc16 * 8;
#define AT_GK(kt) _Pragma("unroll") for (int i_ = 0; i_ < 2; ++i_) { const int q_ = tid + 512 * i_; kreg[i_] = *(const u32x4*)(kbase + (size_t)((kt) * 64 + (q_ >> 4)) * 6144 + (q_ & 15) * 8); }
#define AT_GV(kt) _Pragma("unroll") for (int i_ = 0; i_ < 2; ++i_) vreg[i_] = *(const u32x4*)(vbase + (size_t)((kt) * 64 + 2 * vrp + i_) * 6144);
#define AT_WK(buf) _Pragma("unroll") for (int i_ = 0; i_ < 2; ++i_) { const int q_ = tid + 512 * i_; *(u32x4*)((bf16_t*)(lds + (buf) * 17408) + (q_ >> 4) * 136 + (q_ & 15) * 8) = kreg[i_]; }
#define AT_WV(buf) { bf16_t* VT_ = (bf16_t*)(lds + 34816 + (buf) * 18432); const int pk_ = (2 * vrp + 4 * vc16) & 63; _Pragma("unroll") for (int d_ = 0; d_ < 4; ++d_) { const unsigned a_ = vreg[0][d_], b_ = vreg[1][d_]; \
          *(unsigned*)(VT_ + (vc16 * 8 + 2 * d_) * 72 + pk_) = (a_ & 0xffffu) | (b_ << 16); *(unsigned*)(VT_ + (vc16 * 8 + 2 * d_ + 1) * 72 + pk_) = (a_ >> 16) | (b_ & 0xffff0000u); } }
#define AT_QK(dst, buf) { const bf16_t* Ks_ = (const bf16_t*)(lds + (buf) * 17408); _Pragma("unroll") for (int kk = 0; kk < 2; ++kk) { dst[kk] = zero16(); \
          _Pragma("unroll") for (int s = 0; s < 4; ++s) { const bf16x8 a_ = *(const bf16x8*)(Ks_ + (kk * 32 + r) * 136 + map * 64 + 16 * s + 8 * h); dst[kk] = mfma32(a_, bq[s], dst[kk]); } } }
      if (half == 0) { AT_GK(0); AT_GV(0); }
      __syncthreads();
      AT_WK(0); AT_WV(0);
      AT_GK(1);
      AT_WK(1);
      __syncthreads();
      if (nkt > 2) { AT_GK(2); }
      AT_GV(1);
      f32x16 st[2], sn[2];
      AT_QK(st, 0);
      __syncthreads();
      for (int kt = 0; kt < nkt; ++kt) {
        if (kt + 2 < nkt) { AT_WK(kt & 1); }
        if (kt + 1 < nkt) { AT_WV((kt + 1) & 1); }
        if (kt + 3 < nkt) { AT_GK(kt + 3); }
        if (kt + 2 < nkt) { AT_GV(kt + 2); }
        AT_QK(sn, (kt + 1) & 1);
        const bool diag = (kt >= 2 * qb);
        if (diag) {
#pragma unroll
          for (int kk = 0; kk < 2; ++kk)
#pragma unroll
            for (int i = 0; i < 16; ++i) { const int kg = kt * 64 + kk * 32 + crow(i, h); if (kg > qg) st[kk][i] = -INFINITY; }
        }
        float mx = -INFINITY;
#pragma unroll
        for (int kk = 0; kk < 2; ++kk)
#pragma unroll
          for (int i = 0; i < 16; ++i) mx = fmaxf(mx, st[kk][i]);
        mx = fmaxf(mx, __shfl_xor(mx, 32));
        const float m_new = fmaxf(m_run, mx);
        const bool need = (m_new - m_run) > 8.0f;
        if (__any(need)) {
          const float m_use = need ? m_new : m_run;
          const float corr = __builtin_amdgcn_exp2f(m_run - m_use);
          l_run *= corr;
#pragma unroll
          for (int et = 0; et < 4; ++et) o[et] *= corr;
          m_run = m_use;
        }
        float ps = 0.f;
#pragma unroll
        for (int kk = 0; kk < 2; ++kk)
#pragma unroll
          for (int i = 0; i < 16; ++i) { const float pv = __builtin_amdgcn_exp2f(st[kk][i] - m_run); st[kk][i] = pv; ps += pv; }
        l_run += ps;
        const bf16_t* VT = (const bf16_t*)(lds + 34816 + (kt & 1) * 18432);
#pragma unroll
        for (int kk = 0; kk < 2; ++kk) {
          const bf16x8 pf0 = pack8<0>(st[kk]), pf1 = pack8<1>(st[kk]);
#pragma unroll
          for (int et = 0; et < 4; ++et) {
            const int ev = et * 32 + r, rot = 4 * ((ev >> 3) & 15) + kk * 32 + 4 * h;
            const bf16_t* vrow = VT + ev * 72;
            const bf16x8 a0 = cat4(*(const s16x4*)(vrow + (rot & 63)), *(const s16x4*)(vrow + ((rot + 8) & 63))), a1 = cat4(*(const s16x4*)(vrow + ((rot + 16) & 63)), *(const s16x4*)(vrow + ((rot + 24) & 63)));
            o[et] = mfma32(a0, pf0, o[et]); o[et] = mfma32(a1, pf1, o[et]);
          }
        }
        st[0] = sn[0]; st[1] = sn[1];
        __syncthreads();
      }
      if (half == 0) { AT_GK(0); AT_GV(0); }
#undef AT_GK
#undef AT_GV
#undef AT_WK
#undef AT_WV
#undef AT_QK
      const float inv = 1.0f / (l_run + __shfl_xor(l_run, 32));
      if (map == 1) {
#pragma unroll
        for (int et = 0; et < 4; ++et)
#pragma unroll
          for (int i = 0; i < 16; ++i) XE[(qs * 128 + et * 32 + crow(i, h)) * 32 + r] = lam * o[et][i] * inv;
      }
      __syncthreads();
      if (map == 0) {
        float ss = 0.f;
#pragma unroll
        for (int et = 0; et < 4; ++et)
#pragma unroll
          for (int i = 0; i < 16; ++i) { const float v = o[et][i] * inv - XE[(qs * 128 + et * 32 + crow(i, h)) * 32 + r]; o[et][i] = v; ss += v * v; }
        ss += __shfl_xor(ss, 32);
        const float rstd = 0.8f / sqrtf(ss * (1.f / 128.f) + 1e-6f);
        f32x4 dnv[4][4];
#pragma unroll
        for (int et = 0; et < 4; ++et)
#pragma unroll
          for (int g = 0; g < 4; ++g) dnv[et][g] = *(const f32x4*)(p.da_norm + et * 32 + 8 * g + 4 * h);
#pragma unroll
        for (int et = 0; et < 4; ++et)
#pragma unroll
          for (int g = 0; g < 4; ++g) { const int e0 = et * 32 + 8 * g + 4 * h; const f32x4 dn = dnv[et][g];
            u32x2 ov; ov[0] = pk2(o[et][4 * g] * rstd * dn[0], o[et][4 * g + 1] * rstd * dn[1]); ov[1] = pk2(o[et][4 * g + 2] * rstd * dn[2], o[et][4 * g + 3] * rstd * dn[3]);
            *(u32x2*)(MIX + tq * 2048 + hd * 128 + e0) = ov; }
      }
    }
  }
  __syncthreads();
}
DI void conv8(const Params& p, const bf16_t* PB, int b, int spos, int pbcol, int cch, float (&out)[8]) {
  const f32x4 b0 = *(const f32x4*)(p.conv_b + cch), b1 = *(const f32x4*)(p.conv_b + cch + 4);
#pragma unroll
  for (int j = 0; j < 4; ++j) { out[j] = b0[j]; out[4 + j] = b1[j]; }
#pragma unroll
  for (int kw = 0; kw < 4; ++kw) {
    const int sp = spos - 3 + kw;
    if (sp >= 0) {
      const u32x4 xv = *(const u32x4*)(PB + ((size_t)b * 2048 + sp) * 6144 + pbcol);
      const f32x4 w0 = *(const f32x4*)(p.conv_w + kw * 1024 + cch), w1 = *(const f32x4*)(p.conv_w + kw * 1024 + cch + 4);
      out[0] += w0[0] * bflo(xv[0]); out[1] += w0[1] * bfhi(xv[0]); out[2] += w0[2] * bflo(xv[1]); out[3] += w0[3] * bfhi(xv[1]);
      out[4] += w1[0] * bflo(xv[2]); out[5] += w1[1] * bfhi(xv[2]); out[6] += w1[2] * bflo(xv[3]); out[7] += w1[3] * bfhi(xv[3]);
    }
  }
#pragma unroll
  for (int j = 0; j < 8; ++j) out[j] = out[j] / (1.f + __expf(-out[j]));
}
DI void gates64(const Params& p, int t0, int hh, int lane, float& li, float& bc) {
  const float* GT = (const float*)(p.ws + OFF_GATES);
  const float gi = GT[(t0 + lane) * 8 + hh] + p.b_igate[hh], gf = GT[(t0 + lane) * 8 + 4 + hh] + p.b_fgate[hh];
  li = 15.f * tanhf(gi * (1.f / 15.f));
  const float z = 15.f * tanhf(gf * (1.f / 15.f));
  const float lf = fminf(z, 0.f) - log1pf(expf(-fabsf(z)));
  bc = lf;
#pragma unroll
  for (int o = 1; o < 64; o <<= 1) { const float n = __shfl_up(bc, o); if (lane >= o) bc += n; }
}
DI void stage_vt256(const bf16_t* PB, bf16_t* VT, int t0, int hh, int tid) {
  const int c32 = tid & 31, rp = tid >> 5;
#pragma unroll
  for (int i = 0; i < 2; ++i) { const int r2 = 2 * (rp + 16 * i);
    const u32x4 va = *(const u32x4*)(PB + (size_t)(t0 + r2) * 6144 + 4096 + hh * 256 + c32 * 8), vb = *(const u32x4*)(PB + (size_t)(t0 + r2 + 1) * 6144 + 4096 + hh * 256 + c32 * 8);
    const int pk = (r2 + 4 * (c32 & 15)) & 63;
#pragma unroll
    for (int d = 0; d < 4; ++d) { *(unsigned*)(VT + (c32 * 8 + 2 * d) * 72 + pk) = (va[d] & 0xffffu) | (vb[d] << 16); *(unsigned*)(VT + (c32 * 8 + 2 * d + 1) * 72 + pk) = (va[d] >> 16) | (vb[d] & 0xffff0000u); } }
}
DI void phase_mlA(const Params& p, unsigned char* lds, int bid, int nblk, int tid_in) {
  const bf16_t* PB = (const bf16_t*)(p.ws + OFF_PB);
  bf16_t* CST = (bf16_t*)(p.ws + OFF_CST); float* NST = (float*)(p.ws + OFF_NST); float* DEC = (float*)(p.ws + OFF_DEC);
  bf16_t* KwT = (bf16_t*)lds;
  bf16_t* VT = (bf16_t*)(lds + 18432);
  float* wsv = (float*)(lds + 55296);
  for (int u = bid; u < 512; u += nblk) {
    int tid = tid_in; asm volatile("" : "+v"(tid));
    const int lane = tid & 63, wave = tid >> 6, r = lane & 31, h = lane >> 5;
    const int bh = u >> 5, c = u & 31, b = bh >> 2, hh = bh & 3;
    const int t0 = b * 2048 + c * 64;
    __syncthreads();
    if (wave == 0) {
      float li, bc; gates64(p, t0, hh, lane, li, bc);
      const float bL = __shfl(bc, 63);
      wsv[lane] = expf(bL - bc + li);
      if (lane == 0) DEC[u] = expf(bL);
    }
    __syncthreads();
    { const int c8 = tid & 15, rp = tid >> 4; float oa[8], ob[8];
      conv8(p, PB, b, c * 64 + 2 * rp, 3584 + hh * 128 + c8 * 8, 512 + hh * 128 + c8 * 8, oa);
      conv8(p, PB, b, c * 64 + 2 * rp + 1, 3584 + hh * 128 + c8 * 8, 512 + hh * 128 + c8 * 8, ob);
      const float wa = wsv[2 * rp] * 0.08838834764831845f, wb = wsv[2 * rp + 1] * 0.08838834764831845f;
      const int pk = (2 * rp + 4 * c8) & 63;
#pragma unroll
      for (int j = 0; j < 8; ++j) *(unsigned*)(KwT + (c8 * 8 + j) * 72 + pk) = pk2(oa[j] * wa, ob[j] * wb); }
    stage_vt256(PB, VT, t0, hh, tid);
    __syncthreads();
    f32x16 acc[4];
#pragma unroll
    for (int d = 0; d < 4; ++d) acc[d] = zero16();
#pragma unroll
    for (int ks = 0; ks < 4; ++ks) { const int ev = wave * 32 + r, rv = 4 * ((ev >> 3) & 15) + 16 * ks + 4 * h;
      const bf16x8 a = cat4(*(const s16x4*)(VT + ev * 72 + (rv & 63)), *(const s16x4*)(VT + ev * 72 + ((rv + 8) & 63)));
#pragma unroll
      for (int d = 0; d < 4; ++d) { const int dk = d * 32 + r, rk = 4 * ((dk >> 3) & 15) + 16 * ks + 4 * h;
        const bf16x8 bb = cat4(*(const s16x4*)(KwT + dk * 72 + (rk & 63)), *(const s16x4*)(KwT + dk * 72 + ((rk + 8) & 63))); acc[d] = mfma32(a, bb, acc[d]); } }
    bf16_t* C = CST + (size_t)u * 32768;
#pragma unroll
    for (int d = 0; d < 4; ++d)
#pragma unroll
      for (int i = 0; i < 16; ++i) C[(wave * 32 + crow(i, h)) * 128 + d * 32 + r] = f2bf1(acc[d][i]);
    if (tid < 128) { float s = 0.f; for (int ss = 0; ss < 64; ++ss) s += bf2f(KwT[tid * 72 + ss]); NST[u * 128 + tid] = s; }
  }
}
DI void phase_scan(const Params& p, int bid, int nblk, int tid) {
  u32x2* CST = (u32x2*)(p.ws + OFF_CST); float* NST = (float*)(p.ws + OFF_NST); const float* DEC = (const float*)(p.ws + OFF_DEC);
  for (int e = bid * 512 + tid; e < 16 * 8192 + 16 * 128; e += nblk * 512) {
    if (e < 131072) {
      const int bh = e >> 13; u32x2* base = CST + (size_t)bh * 32 * 8192 + (e & 8191);
      u32x2 v[32];
#pragma unroll
      for (int c = 0; c < 32; ++c) v[c] = base[(size_t)c * 8192];
      float c0 = 0.f, c1 = 0.f, c2 = 0.f, c3 = 0.f;
#pragma unroll
      for (int c = 0; c < 32; ++c) { const float d = DEC[bh * 32 + c]; u32x2 o; o[0] = pk2(c0, c1); o[1] = pk2(c2, c3); base[(size_t)c * 8192] = o;
        c0 = d * c0 + bflo(v[c][0]); c1 = d * c1 + bfhi(v[c][0]); c2 = d * c2 + bflo(v[c][1]); c3 = d * c3 + bfhi(v[c][1]); }
    } else {
      const int e2 = e - 131072, bh = e2 >> 7; float* base = NST + (size_t)bh * 32 * 128 + (e2 & 127);
      float v[32];
#pragma unroll
      for (int c = 0; c < 32; ++c) v[c] = base[c * 128];
      float carry = 0.f;
#pragma unroll
      for (int c = 0; c < 32; ++c) { const float d = DEC[bh * 32 + c]; base[c * 128] = carry; carry = d * carry + v[c]; }
    }
  }
}
DI void phase_mlC(const Params& p, unsigned char* lds, int bid, int nblk, int tid_in) {
  const bf16_t* PB = (const bf16_t*)(p.ws + OFF_PB); bf16_t* MIX = (bf16_t*)(p.ws + OFF_MIX);
  const bf16_t* CST = (const bf16_t*)(p.ws + OFF_CST); const float* NST = (const float*)(p.ws + OFF_NST);
  bf16_t* Qs = (bf16_t*)lds;
  bf16_t* Ks = (bf16_t*)(lds + 17408);
  bf16_t* VT = (bf16_t*)(lds + 34816);
  bf16_t* CT = (bf16_t*)(lds + 71680);
  float* bvec = (float*)(lds + 141312);
  float* liv = bvec + 64; float* nvec = liv + 64; float* qn = nvec + 128;
  float* Hout = (float*)lds;
  for (int u = bid; u < 512; u += nblk) {
    int tid = tid_in; asm volatile("" : "+v"(tid));
    const int lane = tid & 63, wave = tid >> 6, r = lane & 31, h = lane >> 5;
    const int bh = u >> 5, c = u & 31, b = bh >> 2, hh = bh & 3;
    const int t0 = b * 2048 + c * 64;
    __syncthreads();
    if (wave == 0) { float li, bc; gates64(p, t0, hh, lane, li, bc); bvec[lane] = bc; liv[lane] = li; }
    if (tid >= 64 && tid < 192) nvec[tid - 64] = NST[u * 128 + tid - 64];
#pragma unroll 1
    for (int i = 0; i < 2; ++i) { const int q = tid + 512 * i, s = q >> 4, c8 = q & 15; float o8[8];
      conv8(p, PB, b, c * 64 + s, 3072 + hh * 128 + c8 * 8, hh * 128 + c8 * 8, o8);
      u32x4 ov; ov[0] = pk2(o8[0], o8[1]); ov[1] = pk2(o8[2], o8[3]); ov[2] = pk2(o8[4], o8[5]); ov[3] = pk2(o8[6], o8[7]);
      *(u32x4*)(Qs + s * 136 + c8 * 8) = ov;
      conv8(p, PB, b, c * 64 + s, 3584 + hh * 128 + c8 * 8, 512 + hh * 128 + c8 * 8, o8);
      const float w = 0.08838834764831845f;
      ov[0] = pk2(o8[0] * w, o8[1] * w); ov[1] = pk2(o8[2] * w, o8[3] * w); ov[2] = pk2(o8[4] * w, o8[5] * w); ov[3] = pk2(o8[6] * w, o8[7] * w);
      *(u32x4*)(Ks + s * 136 + c8 * 8) = ov; }
    stage_vt256(PB, VT, t0, hh, tid);
#pragma unroll
    for (int i = 0; i < 8; ++i) { const int q = tid + 512 * i, dv = q >> 4, c8 = q & 15;
      *(u32x4*)(CT + dv * 136 + c8 * 8) = *(const u32x4*)(CST + (size_t)u * 32768 + dv * 128 + c8 * 8); }
    __syncthreads();
    { const int j = tid >> 3, seg = tid & 7; float s = 0.f;
#pragma unroll
      for (int d = 0; d < 16; ++d) s += bf2f(Qs[j * 136 + seg * 16 + d]) * nvec[seg * 16 + d];
      s += __shfl_xor(s, 1); s += __shfl_xor(s, 2); s += __shfl_xor(s, 4);
      if (seg == 0) qn[j] = s; }
    __syncthreads();
    f32x16 hv[2];
#pragma unroll
    for (int jt = 0; jt < 2; ++jt) {
      f32x16 st[2]; st[0] = zero16(); st[1] = zero16();
#pragma unroll 2
      for (int ks = 0; ks < 8; ++ks) { const bf16x8 bqf = *(const bf16x8*)(Qs + (jt * 32 + r) * 136 + 16 * ks + 8 * h);
#pragma unroll
        for (int s2 = 0; s2 < 2; ++s2) { const bf16x8 a = *(const bf16x8*)(Ks + (s2 * 32 + r) * 136 + 16 * ks + 8 * h); st[s2] = mfma32(a, bqf, st[s2]); } }
      const int jj = jt * 32 + r; const float bj = bvec[jj]; float rs = 0.f;
#pragma unroll
      for (int s2 = 0; s2 < 2; ++s2)
#pragma unroll
        for (int i = 0; i < 16; ++i) { const int s = s2 * 32 + crow(i, h); const float w = (s <= jj) ? __expf(bj - bvec[s] + liv[s]) : 0.f; const float v = st[s2][i] * w; st[s2][i] = v; rs += v; }
      rs += __shfl_xor(rs, 32);
      const float den = __expf(bj) * qn[jj] + rs;
      const float dinv = 1.0f / fmaxf(fabsf(den), 1.0f);
      f32x16 z = zero16();
#pragma unroll
      for (int s2 = 0; s2 < 2; ++s2) { const bf16x8 pf0 = pack8<0>(st[s2]), pf1 = pack8<1>(st[s2]);
        const int ev = wave * 32 + r, rot = 4 * ((ev >> 3) & 15) + s2 * 32 + 4 * h;
        const bf16_t* vrow = VT + ev * 72;
        const bf16x8 b0 = cat4(*(const s16x4*)(vrow + (rot & 63)), *(const s16x4*)(vrow + ((rot + 8) & 63))), b1 = cat4(*(const s16x4*)(vrow + ((rot + 16) & 63)), *(const s16x4*)(vrow + ((rot + 24) & 63)));
        z = mfma32(pf0, b0, z); z = mfma32(pf1, b1, z); }
      f32x16 z2 = zero16();
#pragma unroll 2
      for (int ks = 0; ks < 8; ++ks) { const bf16x8 a = *(const bf16x8*)(Qs + (jt * 32 + r) * 136 + 16 * ks + 8 * h); const bf16x8 bb = *(const bf16x8*)(CT + (wave * 32 + r) * 136 + 16 * ks + 8 * h); z2 = mfma32(a, bb, z2); }
#pragma unroll
      for (int i = 0; i < 16; ++i) { const int jr = jt * 32 + crow(i, h); const float eb = __expf(bvec[jr]); const float di = __shfl(dinv, crow(i, h)); hv[jt][i] = (eb * z2[i] + z[i]) * di; }
    }
    __syncthreads();
#pragma unroll
    for (int jt = 0; jt < 2; ++jt)
#pragma unroll
      for (int i = 0; i < 16; ++i) Hout[(jt * 32 + crow(i, h)) * 256 + wave * 32 + r] = hv[jt][i];
    __syncthreads();
    { const int j = tid >> 3, seg = tid & 7; const size_t t = (size_t)t0 + j; float vals[32]; float ss = 0.f;
#pragma unroll
      for (int d = 0; d < 32; ++d) { vals[d] = Hout[j * 256 + seg * 32 + d]; ss += vals[d] * vals[d]; }
      ss += __shfl_xor(ss, 1); ss += __shfl_xor(ss, 2); ss += __shfl_xor(ss, 4);
      const float rstd = 1.0f / sqrtf(ss * (1.f / 256.f) + 1e-6f);
      u32x4 ogv[4];
#pragma unroll
      for (int d8 = 0; d8 < 4; ++d8) ogv[d8] = *(const u32x4*)(PB + t * 6144 + 5120 + hh * 256 + seg * 32 + d8 * 8);
#pragma unroll
      for (int d8 = 0; d8 < 4; ++d8) {
        const int dv = seg * 32 + d8 * 8;
        const u32x4 og = ogv[d8];
        const f32x4 n0 = *(const f32x4*)(p.ml_norm + dv), n1 = *(const f32x4*)(p.ml_norm + dv + 4);
        float ov[8];
#pragma unroll
        for (int k = 0; k < 4; ++k) { const float g0 = bflo(og[k]), g1 = bfhi(og[k]);
          const float nn0 = (2 * k < 4) ? n0[(2 * k) & 3] : n1[(2 * k) & 3], nn1 = (2 * k + 1 < 4) ? n0[(2 * k + 1) & 3] : n1[(2 * k + 1) & 3];
          ov[2 * k] = vals[d8 * 8 + 2 * k] * rstd * nn0 / (1.f + __expf(-g0)); ov[2 * k + 1] = vals[d8 * 8 + 2 * k + 1] * rstd * nn1 / (1.f + __expf(-g1)); }
        u32x4 o4; o4[0] = pk2(ov[0], ov[1]); o4[1] = pk2(ov[2], ov[3]); o4[2] = pk2(ov[4], ov[5]); o4[3] = pk2(ov[6], ov[7]);
        *(u32x4*)(MIX + t * 2048 + 1024 + hh * 256 + dv) = o4;
      }
    }
  }
}
DI int f2key(float x) { const int b = __float_as_int(x); return b ^ ((b >> 31) & 0x7fffffff); }
DI float key2f(int k) { return __int_as_float(k ^ ((k >> 31) & 0x7fffffff)); }
template <int N> DI void bitonic_sort_desc(int (&a)[N]) {
#pragma unroll
  for (int k = 2; k <= N; k <<= 1)
#pragma unroll
    for (int j = k >> 1; j > 0; j >>= 1)
#pragma unroll
      for (int i = 0; i < N; ++i) { const int l = i ^ j; if (l > i) { const bool desc = ((i & k) == 0); const int hi = max(a[i], a[l]), lo = min(a[i], a[l]); a[i] = desc ? hi : lo; a[l] = desc ? lo : hi; } }
}
template <int N> DI void bitonic_merge_desc(int (&a)[N]) {
#pragma unroll
  for (int j = N >> 1; j > 0; j >>= 1)
#pragma unroll
    for (int i = 0; i < N; ++i) { const int l = i ^ j; if (l > i) { const int hi = max(a[i], a[l]), lo = min(a[i], a[l]); a[i] = hi; a[l] = lo; } }
}
DI void top16_merge(int (&a)[16], const int (&b)[16]) {
#pragma unroll
  for (int i = 0; i < 16; ++i) a[i] = max(a[i], b[15 - i]);
  bitonic_merge_desc<16>(a);
}
DI void top16_xlane(int (&a)[16]) {
  int b[16];
#pragma unroll
  for (int i = 0; i < 16; ++i) b[i] = __shfl_xor(a[i], 32);
  top16_merge(a, b);
}
DI void topk_unit(const Params& p, const bf16_t* q0, const bf16_t* q1, size_t t, int hd, int r, int h) {
  int* IDX = (int*)(p.ws + OFF_IDX); float* GW = (float*)(p.ws + OFF_GW); float* AACC = (float*)(p.ws + OFF_AACC);
    int top[2][16];
#pragma unroll
    for (int c = 0; c < 2; ++c) {
      f32x16 acc[4];
#pragma unroll
      for (int nt = 0; nt < 4; ++nt) acc[nt] = zero16();
      const bf16_t* sk = (const bf16_t*)(p.ws + OFF_SKB) + (size_t)((hd * 2 + c) * 128) * 128;
      const bf16_t* qrow = c ? q1 : q0;
#pragma unroll 4
      for (int ks = 0; ks < 8; ++ks) {
        const bf16x8 bq = *(const bf16x8*)(qrow + 16 * ks + 8 * h);
#pragma unroll
        for (int nt = 0; nt < 4; ++nt) { const bf16x8 a = *(const bf16x8*)(sk + (nt * 32 + r) * 128 + 16 * ks + 8 * h); acc[nt] = mfma32(a, bq, acc[nt]); }
      }
      int l0[16], l1[16], l2[16], l3[16];
#pragma unroll
      for (int i = 0; i < 16; ++i) { l0[i] = (f2key(acc[0][i]) & ~127) | (crow(i, h)); l1[i] = (f2key(acc[1][i]) & ~127) | (32 + crow(i, h)); l2[i] = (f2key(acc[2][i]) & ~127) | (64 + crow(i, h)); l3[i] = (f2key(acc[3][i]) & ~127) | (96 + crow(i, h)); }
      bitonic_sort_desc<16>(l0); bitonic_sort_desc<16>(l1); bitonic_sort_desc<16>(l2); bitonic_sort_desc<16>(l3);
      top16_merge(l0, l1); top16_merge(l2, l3); top16_merge(l0, l2);
      top16_xlane(l0);
#pragma unroll
      for (int k = 0; k < 16; ++k) top[c][k] = l0[k];
    }
    float sa[16], sb[16]; int ia[16], ib[16];
#pragma unroll
    for (int k = 0; k < 16; ++k) { sa[k] = key2f(top[0][k] & ~127); ia[k] = top[0][k] & 127; sb[k] = key2f(top[1][k] & ~127); ib[k] = top[1][k] & 127; }
    constexpr int A0[25] = {0,0,0,0,0,0,0,0,0,0,0,0,0,0,0,0, 4,4,4, 6,6, 8,10,12,14};
    constexpr int B0[25] = {0,1,2,3,4,5,6,7,8,9,10,11,12,13,14,15, 0,1,2, 0,1, 0,0,0,0};
    constexpr int A1[25] = {1,1,1,1,1,1,1,1, 2,2,2,2,2, 3,3,3,3, 5,5, 7,7, 9,11,13,15};
    constexpr int B1[25] = {0,1,2,3,4,5,6,7, 0,1,2,3,4, 0,1,2,3, 0,1, 0,1, 0,0,0,0};
    int c0[16], c1[16];
#pragma unroll
    for (int k = 0; k < 32; ++k) {
      int key = (int)0x80000000;
      if (k < 25) { const float x0 = sa[A0[k]] + sb[B0[k]], x1 = sa[A1[k]] + sb[B1[k]];
        const int e0 = ia[A0[k]] * 128 + ib[B0[k]], e1 = ia[A1[k]] * 128 + ib[B1[k]];
        key = (f2key(h ? x1 : x0) & ~16383) | (h ? e1 : e0); }
      if (k < 16) c0[k] = key; else c1[k - 16] = key;
    }
    bitonic_sort_desc<16>(c0); bitonic_sort_desc<16>(c1);
    top16_merge(c0, c1);
    top16_xlane(c0);
    float fv[16]; int fe[16];
#pragma unroll
    for (int k = 0; k < 16; ++k) { fv[k] = key2f(c0[k] & ~16383); fe[k] = c0[k] & 16383; }
    const float mxv = fv[0];
    float sum = 0.f;
#pragma unroll
    for (int k = 0; k < 16; ++k) { fv[k] = expf(fv[k] - mxv); sum += fv[k]; }
    const float isum = 1.0f / sum;
#pragma unroll
    for (int m = 0; m < 4; ++m) { if (h == 0) {
        i32x4 e4; e4[0] = fe[4 * m]; e4[1] = fe[4 * m + 1]; e4[2] = fe[4 * m + 2]; e4[3] = fe[4 * m + 3];
        f32x4 g4; g4[0] = fv[4 * m] * isum; g4[1] = fv[4 * m + 1] * isum; g4[2] = fv[4 * m + 2] * isum; g4[3] = fv[4 * m + 3] * isum;
        *(i32x4*)(IDX + t * 128 + hd * 16 + 4 * m) = e4; *(f32x4*)(GW + t * 128 + hd * 16 + 4 * m) = g4; *(f32x4*)(AACC + t * 128 + hd * 16 + 4 * m) = (f32x4){0.f, 0.f, 0.f, 0.f}; } }
}
DI void phase_topk(const Params& p, int bid, int nblk, int tid) {
  asm volatile("" : "+v"(tid));
  const int lane = tid & 63, wave = tid >> 6, r = lane & 31, h = lane >> 5;
  const bf16_t* QP = (const bf16_t*)(p.ws + OFF_QP);
  if (!(wave & 4)) convert_peer_rows(p, bid * 8 + wave, nblk * 8, lane);
  for (int unit = bid * 8 + wave; unit < 2048; unit += nblk * 8) {
    const int tt = unit >> 3, hd = unit & 7;
    const size_t t = (size_t)tt * 32 + r;
    topk_unit(p, QP + t * 2048 + hd * 256, QP + t * 2048 + hd * 256 + 128, t, hd, r, h);
  }
  if (wave & 4) convert_peer_rows(p, bid * 8 + wave, nblk * 8, lane);
}
struct EpiTopk {
  static constexpr bool PERM = true, AFTER_DRAIN = true;
  const Params* pp; int bid, nblk;
  DI void fused(const f32x4 (&acc)[2][2][4][2], const pg8::Unit& u, int wr, int wc, int fr, int fq, PG8_LAS unsigned char* ldsp, int wid, int lane) const {
    bf16_t* Qt = (bf16_t*)(unsigned char*)ldsp;
#pragma unroll
    for (int ai = 0; ai < 2; ++ai)
#pragma unroll
      for (int m = 0; m < 4; ++m) {
        const int row = ai * 128 + wr * 64 + m * 16 + fr;
#pragma unroll
        for (int bj = 0; bj < 2; ++bj) { const f32x4 v0 = acc[ai][bj][m][0], v1 = acc[ai][bj][m][1]; u32x4 o; o[0] = pk2(v0[0], v0[1]); o[1] = pk2(v0[2], v0[3]); o[2] = pk2(v1[0], v1[1]); o[3] = pk2(v1[2], v1[3]);
          *(u32x4*)(Qt + row * 264 + bj * 128 + wc * 32 + 8 * fq) = o; }
      }
    __syncthreads();
    const Params& p = *pp;
    const int r = lane & 31, h = lane >> 5;
    if (!(wid & 4)) convert_peer_rows(p, bid * 8 + wid, nblk * 8, lane);
    const bf16_t* q0 = Qt + (32 * wid + r) * 264;
    topk_unit(p, q0, q0 + 128, (size_t)u.pm * 256 + 32 * wid + r, u.pn, r, h);
    if (wid & 4) convert_peer_rows(p, bid * 8 + wid, nblk * 8, lane);
  }
};
DI float gelu_exact(float x) { return 0.5f * x * (1.0f + erff(x * 0.70710678118654752f)); }
DI float reduce16(const float (&v)[16], int c) {
  float a8[8], a4[4], a2[2];
  const bool b8 = (c & 8) != 0, b4 = (c & 4) != 0, b2 = (c & 2) != 0, b1 = (c & 1) != 0;
#pragma unroll
  for (int j = 0; j < 8; ++j) { const float send = b8 ? v[j] : v[j + 8], keep = b8 ? v[j + 8] : v[j]; a8[j] = keep + __shfl_xor(send, 8); }
#pragma unroll
  for (int j = 0; j < 4; ++j) { const float send = b4 ? a8[j] : a8[j + 4], keep = b4 ? a8[j + 4] : a8[j]; a4[j] = keep + __shfl_xor(send, 4); }
#pragma unroll
  for (int j = 0; j < 2; ++j) { const float send = b2 ? a4[j] : a4[j + 2], keep = b2 ? a4[j + 2] : a4[j]; a2[j] = keep + __shfl_xor(send, 2); }
  const float send = b1 ? a2[0] : a2[1], keep = b1 ? a2[1] : a2[0];
  return keep + __shfl_xor(send, 1);
}
DI void phase_gA(const Params& p, int gi, int nblk, int tid) {
  const int lane = tid & 63, wave = tid >> 6, c = lane & 15, es = lane >> 4;
  const int NG = nblk >> 3, sl = gi & 7, tr = gi >> 3;
  const bf16_t* HB = (const bf16_t*)(p.ws + OFF_HB); const unsigned char* PU8 = (const unsigned char*)(p.ws + OFF_PU);
  const int* IDX = (const int*)(p.ws + OFF_IDX); float* AACC = (float*)(p.ws + OFF_AACC);
  const unsigned char* PUs = PU8 + (size_t)sl * 16384 * 256;
  const int tstep = NG * 8;
  int tcur = tr * 8 + wave;
  if (tcur >= T_) return;
  int ex[32]; u32x4 hraw[2];
#pragma unroll
  for (int m = 0; m < 8; ++m) { const i32x4 q4 = *(const i32x4*)(IDX + (unsigned)(tcur * 128 + 32 * es + 4 * m)); ex[4 * m] = q4[0]; ex[4 * m + 1] = q4[1]; ex[4 * m + 2] = q4[2]; ex[4 * m + 3] = q4[3]; }
  hraw[0] = *(const u32x4*)(HB + (size_t)tcur * 2048 + sl * 256 + c * 16); hraw[1] = *(const u32x4*)(HB + (size_t)tcur * 2048 + sl * 256 + c * 16 + 8);
  for (int t = tcur; t < T_; t += tstep) {
    const int tn = (t + tstep < T_) ? t + tstep : t;
    f32x2 hs[8];
#pragma unroll
    for (int q = 0; q < 2; ++q)
#pragma unroll
      for (int k = 0; k < 4; ++k) { hs[q * 4 + k][0] = bflo(hraw[q][k]); hs[q * 4 + k][1] = bfhi(hraw[q][k]); }
    int exn[32];
#pragma unroll
    for (int bt = 0; bt < 2; ++bt) {
      float v[16];
      u32x4 sg[16];
#pragma unroll
      for (int i = 0; i < 16; ++i) sg[i] = *(const u32x4*)(PUs + (unsigned)(ex[16 * bt + i] * 256 + c * 16));
      if (bt == 0) {
#pragma unroll
        for (int m = 0; m < 8; ++m) { const i32x4 q4 = *(const i32x4*)(IDX + (unsigned)(tn * 128 + 32 * es + 4 * m)); exn[4 * m] = q4[0]; exn[4 * m + 1] = q4[1]; exn[4 * m + 2] = q4[2]; exn[4 * m + 3] = q4[3]; }
        hraw[0] = *(const u32x4*)(HB + (size_t)tn * 2048 + sl * 256 + c * 16); hraw[1] = *(const u32x4*)(HB + (size_t)tn * 2048 + sl * 256 + c * 16 + 8);
      }
#pragma unroll
      for (int i = 0; i < 16; ++i) {
        f32x2 d2 = {0.f, 0.f};
#pragma unroll
        for (int dw = 0; dw < 4; ++dw) { const f32x2 lo = __builtin_amdgcn_cvt_pk_f32_fp8((int)sg[i][dw], false), hi = __builtin_amdgcn_cvt_pk_f32_fp8((int)sg[i][dw], true);
          d2 = __builtin_elementwise_fma(lo, hs[dw * 2], d2); d2 = __builtin_elementwise_fma(hi, hs[dw * 2 + 1], d2); }
        v[i] = d2[0] + d2[1];
      }
      const float tot = reduce16(v, c);
      __hip_atomic_fetch_add(AACC + (size_t)t * 128 + 32 * es + 16 * bt + c, tot, __ATOMIC_RELAXED, __HIP_MEMORY_SCOPE_AGENT);
    }
#pragma unroll
    for (int i = 0; i < 32; ++i) ex[i] = exn[i];
  }
}
DI void phase_gB(const Params& p, unsigned char* lds, int gi, int nblk, int tid) {
  const int lane = tid & 63, wave = tid >> 6, c = lane & 15, es = lane >> 4;
  const int NG = nblk >> 3, sl = gi & 7, tr = gi >> 3;
  const unsigned char* PV8 = (const unsigned char*)(p.ws + OFF_PV);
  const float* SU = (const float*)(p.ws + OFF_SU); const float* SV = (const float*)(p.ws + OFF_SV);
  const int* IDX = (const int*)(p.ws + OFF_IDX); const float* GW = (const float*)(p.ws + OFF_GW);
  const float* AACC = (const float*)(p.ws + OFF_AACC); bf16_t* Y = (bf16_t*)(p.ws + OFF_Y);
  float* wl = (float*)(lds + wave * 1024); int* el = (int*)(lds + wave * 1024 + 512);
  const unsigned char* PVs = PV8 + (size_t)sl * 16384 * 256;
  const int tstep = NG * 8;
  int t0 = tr * 8 + wave;
  if (t0 >= T_) return;
  float pa[2], pg[2], psu[2], psv[2]; int pe[2];
#pragma unroll
  for (int hf = 0; hf < 2; ++hf) { const unsigned k = (unsigned)(t0 * 128 + lane + 64 * hf); pa[hf] = AACC[k]; pe[hf] = IDX[k]; pg[hf] = GW[k]; }
#pragma unroll
  for (int hf = 0; hf < 2; ++hf) { psu[hf] = SU[pe[hf]]; psv[hf] = SV[pe[hf]]; }
  for (int t = t0; t < T_; t += tstep) {
    const int tn = (t + tstep < T_) ? t + tstep : t;
#pragma unroll
    for (int hf = 0; hf < 2; ++hf) { const int k = lane + 64 * hf; wl[k] = pg[hf] * gelu_exact(pa[hf] * psu[hf]) * psv[hf]; el[k] = pe[hf]; }
    LDS_WAIT();
#pragma unroll
    for (int hf = 0; hf < 2; ++hf) { const unsigned k = (unsigned)(tn * 128 + lane + 64 * hf); pa[hf] = AACC[k]; pe[hf] = IDX[k]; pg[hf] = GW[k]; }
    f32x2 y2[8];
#pragma unroll
    for (int j = 0; j < 8; ++j) y2[j] = (f32x2){0.f, 0.f};
#pragma unroll
    for (int bt = 0; bt < 2; ++bt) {
      u32x4 sg[16]; float wv[16];
#pragma unroll
      for (int i = 0; i < 16; ++i) { const int k = 64 * bt + 4 * i + es; const int e = el[k]; wv[i] = wl[k]; sg[i] = *(const u32x4*)(PVs + (unsigned)(e * 256 + c * 16)); }
#pragma unroll
      for (int i = 0; i < 16; ++i) { const f32x2 w2 = {wv[i], wv[i]};
#pragma unroll
        for (int dw = 0; dw < 4; ++dw) { const f32x2 lo = __builtin_amdgcn_cvt_pk_f32_fp8((int)sg[i][dw], false), hi = __builtin_amdgcn_cvt_pk_f32_fp8((int)sg[i][dw], true);
          y2[dw * 2] = __builtin_elementwise_fma(w2, lo, y2[dw * 2]); y2[dw * 2 + 1] = __builtin_elementwise_fma(w2, hi, y2[dw * 2 + 1]); } }
      if (bt == 0) {
#pragma unroll
        for (int hf = 0; hf < 2; ++hf) { psu[hf] = SU[pe[hf]]; psv[hf] = SV[pe[hf]]; }
      }
    }
    float ys[16];
#pragma unroll
    for (int j = 0; j < 8; ++j) { ys[2 * j] = y2[j][0]; ys[2 * j + 1] = y2[j][1]; }
#pragma unroll
    for (int j = 0; j < 16; ++j) { ys[j] += __shfl_xor(ys[j], 16); ys[j] += __shfl_xor(ys[j], 32); }
    if (es == 0) { bf16_t* yo = Y + (size_t)t * 2048 + sl * 256 + c * 16;
#pragma unroll
      for (int q = 0; q < 2; ++q) { u32x4 o; o[0] = pk2(ys[q * 8], ys[q * 8 + 1]); o[1] = pk2(ys[q * 8 + 2], ys[q * 8 + 3]); o[2] = pk2(ys[q * 8 + 4], ys[q * 8 + 5]); o[3] = pk2(ys[q * 8 + 6], ys[q * 8 + 7]); *(u32x4*)(yo + q * 8) = o; } }
    LDS_WAIT();
  }
}
DI void phase_final(const Params& p, int bid, int nblk, int tid) {
  const int lane = tid & 63, wave = tid >> 6;
  const float* X1 = (const float*)(p.ws + OFF_X1); const float* MOD = (const float*)(p.ws + OFF_MOD); const bf16_t* Y = (const bf16_t*)(p.ws + OFF_Y);
  for (int t = bid * 8 + wave; t < T_; t += nblk * 8) {
    const int b = t >> 11;
    const float* gt = MOD + b * 16384 + 5 * 2048; const float* sho = MOD + b * 16384 + 12288; const float* sco = sho + 2048;
    f32x4 v[8]; float ss = 0.f;
#pragma unroll
    for (int j = 0; j < 8; ++j) { const int e = j * 256 + lane * 4; const f32x4 xv = *(const f32x4*)(X1 + (size_t)t * 2048 + e), g4 = *(const f32x4*)(gt + e); const u32x2 yb = *(const u32x2*)(Y + (size_t)t * 2048 + e); f32x4 yv; yv[0] = bflo(yb[0]); yv[1] = bfhi(yb[0]); yv[2] = bflo(yb[1]); yv[3] = bfhi(yb[1]);
      v[j] = xv + g4 * yv; ss += v[j][0] * v[j][0] + v[j][1] * v[j][1] + v[j][2] * v[j][2] + v[j][3] * v[j][3]; }
    ss = wave_sum(ss);
    const float rstd = 1.0f / sqrtf(ss * (1.f / 2048.f) + 1e-6f);
#pragma unroll
    for (int j = 0; j < 8; ++j) { const int e = j * 256 + lane * 4; const f32x4 gf = *(const f32x4*)(p.g_final + e), s4 = *(const f32x4*)(sco + e), h4 = *(const f32x4*)(sho + e);
      v[j] = v[j] * rstd * gf * (1.f + s4) + h4; }
#pragma unroll
    for (int j = 0; j < 8; ++j) *(f32x4*)(p.out + (size_t)t * 2048 + j * 256 + lane * 4) = v[j];
  }
}
#define XB_TMO      128
#define XB_XCNT(j)  (256  + 64 * (j))
#define XB_XSUB(j)  (1280 + 64 * (j))
#define XB_XGEN(j)  (2304 + 64 * (j))
#define XB_TOP      3328
#define XB_TOPGEN   3392
#define XB_SPIN_CAP (1u << 20)
#define XB_LAS __attribute__((address_space(3)))
DI unsigned xb_ld(unsigned* p)              { return __hip_atomic_load(p, __ATOMIC_RELAXED, __HIP_MEMORY_SCOPE_AGENT); }
DI unsigned xb_add(unsigned* p, unsigned v) { return __hip_atomic_fetch_add(p, v, __ATOMIC_RELAXED, __HIP_MEMORY_SCOPE_AGENT); }
DI unsigned xb_xcc_id() { return (unsigned)__builtin_amdgcn_s_getreg((3 << 11) | 20) & 0xFu; }
#define XB_SPIN(cond, bar) do { unsigned _sp = 0; while (cond) { __builtin_amdgcn_s_sleep(1); \
    if ((++_sp & 255u) == 0u) { if (xb_ld(&(bar)[XB_TMO])) break; if (_sp > XB_SPIN_CAP) { atomicAdd(&(bar)[XB_TMO], 1u); break; } } } } while (0)
struct XcdBarrier { unsigned* bar; unsigned x; volatile XB_LAS unsigned* st; };
DI XcdBarrier xcd_barrier_post(unsigned* bar, volatile XB_LAS unsigned* st) {
    XcdBarrier b; b.bar = bar; b.x = xb_xcc_id(); b.st = st;
    if (threadIdx.x == 0) st[2] = xb_add(&bar[XB_XCNT(b.x)], 1u);
    return b;
}
DI void xcd_barrier_complete(unsigned* bar, unsigned x, unsigned& nloc, unsigned& nx) {
    const unsigned G = gridDim.x * gridDim.y * gridDim.z;
    unsigned sum, cnt, mine, sp = 0u;
    for (;;) {
        sum = 0u; cnt = 0u; mine = 0u;
#pragma unroll
        for (unsigned j = 0; j < 16; ++j) { const unsigned c = xb_ld(&bar[XB_XCNT(j)]); sum += c; cnt += (c > 0u) ? 1u : 0u; mine = (j == x) ? c : mine; }
        if (sum == G) break;
        __builtin_amdgcn_s_sleep(1);
        if ((++sp & 255u) == 0u) { if (xb_ld(&bar[XB_TMO])) break; if (sp > XB_SPIN_CAP) { atomicAdd(&bar[XB_TMO], 1u); break; } }
    }
    nloc = mine > 0u ? mine : 1u; nx = cnt > 0u ? cnt : 1u;
}
DI void xcd_barrier(const XcdBarrier& b) {
    asm volatile("s_waitcnt vmcnt(0)" ::: "memory");
    __syncthreads();
    if (threadIdx.x == 0) {
        unsigned* bar = b.bar;
        __builtin_amdgcn_s_waitcnt(0);
        unsigned nloc = b.st[0], nx = b.st[1];
        if (nloc == 0u) { xcd_barrier_complete(bar, b.x, nloc, nx); b.st[0] = nloc; b.st[1] = nx; }
        const unsigned old = xb_add(&bar[XB_XSUB(b.x)], 1u);
        const unsigned gen = old / nloc;
        if (old + 1u == (gen + 1u) * nloc) {
            __builtin_amdgcn_fence(__ATOMIC_RELEASE, "agent");
            asm volatile("s_waitcnt vmcnt(0)" ::: "memory");
            const unsigned og = xb_add(&bar[XB_TOP], 1u);
            const unsigned tg = og / nx;
            if (og + 1u == (tg + 1u) * nx) xb_add(&bar[XB_TOPGEN], 1u);
            else XB_SPIN(xb_ld(&bar[XB_TOPGEN]) == tg, bar);
            __builtin_amdgcn_fence(__ATOMIC_ACQUIRE, "agent");
            xb_add(&bar[XB_XGEN(b.x)], 1u);
            asm volatile("s_waitcnt vmcnt(0)" ::: "memory");
        } else {
            XB_SPIN(xb_ld(&bar[XB_XGEN(b.x)]) == gen, bar);
            __builtin_amdgcn_fence(__ATOMIC_ACQUIRE, "agent");
            asm volatile("s_waitcnt vmcnt(0)" ::: "memory");
        }
    }
    __syncthreads();
}
#ifndef ONLY
#define ONLY -1
#endif
#define PH(k) ((ONLY < 0 || ONLY == (k)) && ph == (k))
__global__ void __launch_bounds__(512) mega(Params p, int ph_lo, int ph_hi) {
  extern __shared__ __attribute__((aligned(16))) unsigned char shm[];
  cg::grid_group grid = cg::this_grid();
  const int bid = blockIdx.x, nblk = gridDim.x, tid = threadIdx.x;
  volatile XB_LAS unsigned* xst = (volatile XB_LAS unsigned*)((PG8_LAS unsigned char*)shm + (LDS_BYTES - 16));
  if (tid < 4) xst[tid] = 0u;
  __syncthreads();
  const XcdBarrier xb = xcd_barrier_post((unsigned*)(p.ws + OFF_CTL), xst);
  if (ph_lo > 100) grid.sync();
#ifndef REPMASK
#define REPMASK 0
#endif
#define RUNPH(k, ...) if ((ONLY < 0 || ONLY == (k)) && ph_lo <= (k) && (k) <= ph_hi) { __VA_ARGS__ } if (((REPMASK >> (k)) & 1) && ph_lo <= (k) && (k) <= ph_hi) { __syncthreads(); __VA_ARGS__ } if (ph_lo <= (k) && (k) < ph_hi) xcd_barrier(xb);
  RUNPH(0, phase0(p, shm, bid, nblk, tid);)
  RUNPH(1, phase_norm<true>(p, p.x, p.g_mix, 0, 1, bid, nblk, tid, shm);)
  RUNPH(2, pg8::Gemm g{(const bf16_t*)(p.ws + OFF_HB), (const bf16_t*)(p.ws + OFF_WINT), 8192, 6144, 2048}; pg8::StaticOrder S; S.init(8192, 6144, nblk, bid);
      EpiProj E{(bf16_t*)(p.ws + OFF_PB)};
      pg8::gemm_phase<EpiProj, pg8::StaticOrder, false>((PG8_LAS unsigned char*)shm, g, S, E, nullptr);)
  RUNPH(3, phase_attn(p, shm, bid, nblk, tid); if ((REPMASK >> 13) & 1) { __syncthreads(); phase_attn(p, shm, bid, nblk, tid); } phase_mlA(p, shm, bid, nblk, tid); if ((REPMASK >> 14) & 1) { __syncthreads(); phase_mlA(p, shm, bid, nblk, tid); })
  RUNPH(4, phase_scan(p, bid, nblk, tid);)
  RUNPH(5, phase_mlC(p, shm, bid, nblk, tid);)
  RUNPH(6, pg8::Gemm g{(const bf16_t*)(p.ws + OFF_MIX), (const bf16_t*)(p.ws + OFF_WOUTT), 8192, 2048, 2048}; pg8::StaticOrder S; S.init(8192, 2048, nblk, bid);
      EpiRes E{(float*)(p.ws + OFF_X1), p.x, (const float*)(p.ws + OFF_MOD)};
      pg8::gemm_phase<EpiRes, pg8::StaticOrder, false>((PG8_LAS unsigned char*)shm, g, S, E, nullptr);)
  RUNPH(7, phase_norm<false>(p, (const float*)(p.ws + OFF_X1), p.g_ffn, 3, 4, bid, nblk, tid, shm);)
  if (nblk == 256) {
    RUNPH(8, pg8::Gemm g{(const bf16_t*)(p.ws + OFF_HB), (const bf16_t*)(p.ws + OFF_WPQT), 8192, 2048, 2048}; pg8::StaticOrder S; S.init(8192, 2048, nblk, bid);
        EpiTopk E{&p, bid, nblk};
        pg8::gemm_phase<EpiTopk, pg8::StaticOrder, false>((PG8_LAS unsigned char*)shm, g, S, E, nullptr);)
  } else {
    RUNPH(8, pg8::Gemm g{(const bf16_t*)(p.ws + OFF_HB), (const bf16_t*)(p.ws + OFF_WPQT), 8192, 2048, 2048}; pg8::StaticOrder S; S.init(8192, 2048, nblk, bid);
        EpiBf E{(bf16_t*)(p.ws + OFF_QP)};
        pg8::gemm_phase<EpiBf, pg8::StaticOrder, false>((PG8_LAS unsigned char*)shm, g, S, E, nullptr);)
    RUNPH(9, phase_topk(p, bid, nblk, tid);)
  }
  RUNPH(10, phase_gA(p, bid, nblk, tid);)
  RUNPH(11, phase_gB(p, shm, bid, nblk, tid);)
  RUNPH(12, phase_final(p, bid, nblk, tid);)

}
extern "C" void kernel_launch(void* const* d_in, const int* in_sizes, int n_in, void* d_out, int out_size, void* d_ws, size_t ws_size, hipStream_t stream) {
  (void)in_sizes; (void)n_in; (void)out_size;
  if (ws_size < WS_TOTAL) { fprintf(stderr, "kernel_launch: workspace too small (%zu < %zu)\n", ws_size, (size_t)WS_TOTAL); return; }
  Params p{};
  const float** f = (const float**)&p;
  for (int i = 0; i < 25; ++i) f[i] = (const float*)d_in[i];
  p.out = (float*)d_out; p.ws = (unsigned char*)d_ws;
  static bool attr_set = false;
  if (!attr_set) { if (hipFuncSetAttribute((const void*)mega, hipFuncAttributeMaxDynamicSharedMemorySize, LDS_BYTES) != hipSuccess) { fprintf(stderr, "kernel_launch: hipFuncSetAttribute failed\n"); return; } attr_set = true; }
  (void)hipMemsetAsync((unsigned char*)d_ws + OFF_CTL, 0, 16384, stream);
    int lo = 0, hi = 12;
  void* args[] = {&p, &lo, &hi};
  static int grid_blocks = 0;
  if (!grid_blocks) { int dev = 0, cus = 0, per_cu = 0; (void)hipGetDevice(&dev); (void)hipDeviceGetAttribute(&cus, hipDeviceAttributeMultiprocessorCount, dev);
    (void)hipOccupancyMaxActiveBlocksPerMultiprocessor(&per_cu, (const void*)mega, 512, LDS_BYTES);
    int g = cus * (per_cu > 0 ? per_cu : 1); if (g > 256) g = 256; g &= ~7; if (g < 8) g = 8; grid_blocks = g; }
  hipError_t e = hipLaunchCooperativeKernel((const void*)mega, dim3(grid_blocks), dim3(512), args, LDS_BYTES, stream);
  if (e != hipSuccess) fprintf(stderr, "cooperative launch failed: %s\n", hipGetErrorString(e));
}
```

```cpp
#include <hip/hip_runtime.h>
#include <hip/hip_cooperative_groups.h>
#include <cstdio>
#include <cstdint>
namespace cg = cooperative_groups;
#define DI __device__ __forceinline__
namespace pg8 {
#define PG8_LAS __attribute__((address_space(3)))
typedef unsigned short bf16_t;
typedef short bf16x8 __attribute__((ext_vector_type(8)));
typedef float f32x4 __attribute__((ext_vector_type(4)));
typedef unsigned u32x4 __attribute__((ext_vector_type(4)));
constexpr int BM = 256, BK = 64, HALF = 128, HTB = HALF * BK * 2  , STAGE_BYTES = 8 * HTB, NXCD = 8, WGM = 8;

__host__ __device__ __forceinline__ int lds_byte(int r, int c) { const int st = (r >> 4) * 2 + (c >> 5), rr = r & 15, cc = c & 31, ob = rr * 64 + cc * 2; return st * 1024 + (ob ^ (((ob >> 9) & 1) << 5)); }
__host__ __device__ __forceinline__ void stage_rc(int b, int& R, int& C) { const int st = b / 1024, sb = b % 1024, swz = sb ^ (((sb >> 9) & 1) << 5); R = (st >> 1) * 16 + swz / 64; C = (st & 1) * 32 + (swz % 64) / 2; }
__host__ __device__ __forceinline__ int perm32(int rho) { const int n = rho >> 4, i = rho & 15; return 8 * (i >> 2) + 4 * n + (i & 3); }

struct Unit { int pm, pn; };
struct Gemm { const bf16_t* A; const bf16_t* Bt; int M, N, K; };

struct StaticOrder {
    int nM, nN, nwg, G, c;
    __host__ __device__ void init(int M, int N, int G_, int c_) { nM = M / BM; nN = N / BM; nwg = nM * nN; G = G_; c = c_; }
    __host__ __device__ bool next(int i, Unit& u) const {
        const long L = (long)i * G + c; if (L >= nwg) return false;
        int wgid = (int)L; { const int q = nwg / NXCD, r = nwg % NXCD, xcd = wgid % NXCD, off = wgid / NXCD; wgid = (xcd < r ? xcd * (q + 1) : r * (q + 1) + (xcd - r) * q) + off; }
        const int nig = WGM * nN, gid = wgid / nig, fm = gid * WGM, gsz = (nM - fm) < WGM ? (nM - fm) : WGM;
        u.pm = fm + ((wgid % nig) % gsz); u.pn = (wgid % nig) / gsz; return true;
    }
    __device__ __forceinline__ void a_ready(const Unit&) const {}
    __device__ __forceinline__ void done(const Unit&) const {}
};
template <class Epi, class Sched, bool STAMP = false>
__device__ __forceinline__ void gemm_phase(PG8_LAS unsigned char* lds, const Gemm g, const Sched& S, const Epi& E, unsigned long long* stamps) {
    const int tid = threadIdx.x, wid = __builtin_amdgcn_readfirstlane(tid >> 6), lane = tid & 63, wr = wid >> 2, wc = wid & 3, fr = lane & 15, fq = lane >> 4;
    const int K = g.K, nt = K / BK;
    int ts_lo = 0, ts_hi = 0, nts = 0; const unsigned long long rt_entry = STAMP ? (unsigned long long)wall_clock64() : 0ull;
#define PG8_STAMP() do { if (STAMP && wid == 0 && nts < 64) { const unsigned long long _c = (unsigned long long)clock64(); \
        ts_lo = (lane == nts) ? (int)(unsigned)_c : ts_lo; ts_hi = (lane == nts) ? (int)(unsigned)(_c >> 32) : ts_hi; ++nts; } } while (0)
    PG8_STAMP();
    unsigned voffA[2], voffB[2];
#pragma unroll
    for (int i = 0; i < 2; ++i) { int R, C; stage_rc(tid * 16 + i * 8192, R, C); const int Rb = Epi::PERM ? ((R & ~31) + perm32(R & 31)) : R;
        voffA[i] = (unsigned)(R * K + C) * 2u; voffB[i] = (unsigned)(Rb * K + C) * 2u; }
    const size_t kstep = (size_t)(BK * 2);
    const size_t hstep = (size_t)HALF * K * 2;
    const size_t tstep = 2 * hstep;
    const unsigned ldsw = (unsigned)wid * 1024u;
    const int aoff = lds_byte(wr * 64 + fr, fq * 8), boff = lds_byte(wc * 32 + fr, fq * 8);
#define PG8_SA(b, h) (((b) * 2 + (h)) * HTB)
#define PG8_SB(b, h) ((4 + (b) * 2 + (h)) * HTB)
#define PG8_STAGE(bufoff, gbase, voff) do { _Pragma("unroll") for (int _i = 0; _i < 2; ++_i) \
        __builtin_amdgcn_global_load_lds((const unsigned*)((const char*)(gbase) + (voff)[_i]), (PG8_LAS unsigned*)(lds + (bufoff) + ldsw + _i * 8192), 16, 0, 0); } while (0)
#define PG8_LDA(dst, b, h) do { _Pragma("unroll") for (int m = 0; m < 4; ++m) _Pragma("unroll") for (int k = 0; k < 2; ++k) dst[m][k] = *(const PG8_LAS bf16x8*)(lds + PG8_SA(b, h) + aoff + m * 2048 + k * 1024); } while (0)
#define PG8_LDB(dst, b, h) do { _Pragma("unroll") for (int n = 0; n < 2; ++n) _Pragma("unroll") for (int k = 0; k < 2; ++k) dst[n][k] = *(const PG8_LAS bf16x8*)(lds + PG8_SB(b, h) + boff + n * 2048 + k * 1024); } while (0)
#define PG8_MMA(ai, bj, At, Bt) do { __builtin_amdgcn_s_setprio(1); _Pragma("unroll") for (int m = 0; m < 4; ++m) _Pragma("unroll") for (int n = 0; n < 2; ++n) _Pragma("unroll") for (int k = 0; k < 2; ++k) \
        acc[ai][bj][m][n] = __builtin_amdgcn_mfma_f32_16x16x32_bf16(Bt[n][k], At[m][k], acc[ai][bj][m][n], 0, 0, 0); __builtin_amdgcn_s_setprio(0); } while (0)
#define PG8_WAIT_V(n) asm volatile("s_waitcnt vmcnt(" #n ")" ::: "memory")
#define PG8_WAIT_L(n) asm volatile("s_waitcnt lgkmcnt(" #n ")" ::: "memory")
#define PG8_BAR __builtin_amdgcn_s_barrier()
#define PG8_SCHED __builtin_amdgcn_sched_barrier(0)
    Unit cur, nxt; int ui = 0;
    if (!S.next(0, cur)) return;
    f32x4 acc[2][2][4][2];
#pragma unroll
    for (int a = 0; a < 2; ++a)
#pragma unroll
        for (int b = 0; b < 2; ++b)
#pragma unroll
            for (int m = 0; m < 4; ++m)
#pragma unroll
                for (int n = 0; n < 2; ++n) acc[a][b][m][n] = (f32x4){0.f, 0.f, 0.f, 0.f};
    bf16x8 At[4][2], B0[2][2], B1[2][2];
    const char* cA = (const char*)g.A + (size_t)cur.pm * tstep; const char* cB = (const char*)g.Bt + (size_t)cur.pn * tstep;
    S.a_ready(cur);
    PG8_STAGE(PG8_SB(0, 0), cB, voffB); PG8_STAGE(PG8_SA(0, 0), cA, voffA); PG8_STAGE(PG8_SB(0, 1), cB + hstep, voffB); PG8_STAGE(PG8_SA(0, 1), cA + hstep, voffA);
    if (wr == 1) PG8_BAR;
    PG8_WAIT_V(4); PG8_BAR;
    PG8_STAGE(PG8_SB(1, 0), cB + kstep, voffB); PG8_STAGE(PG8_SA(1, 0), cA + kstep, voffA); PG8_STAGE(PG8_SB(1, 1), cB + hstep + kstep, voffB);
    PG8_WAIT_V(6); PG8_BAR;
    PG8_STAMP();
    for (;;) {
        const bool has_next = S.next(ui + 1, nxt);
        const char* nA = has_next ? (const char*)g.A + (size_t)nxt.pm * tstep : cA; const char* nB = has_next ? (const char*)g.Bt + (size_t)nxt.pn * tstep : cB;
        for (int t = 0; t < nt; t += 2) {
            const bool last = (t == nt - 2);
            const char* a1 = cA + (size_t)(t + 1) * kstep;
            const char* a2 = last ? nA : cA + (size_t)(t + 2) * kstep; const char* b2 = last ? nB : cB + (size_t)(t + 2) * kstep;
            const char* a3 = a2 + kstep; const char* b3 = b2 + kstep;
            if (last && has_next) S.a_ready(nxt);
            PG8_LDB(B0, 0, 0); PG8_SCHED; PG8_LDA(At, 0, 0); PG8_STAGE(PG8_SA(1, 1), a1 + hstep, voffA);
            PG8_WAIT_L(8); PG8_BAR; PG8_WAIT_L(0); PG8_MMA(0, 0, At, B0); PG8_BAR; PG8_SCHED;
            PG8_LDB(B1, 0, 1); PG8_STAGE(PG8_SB(0, 0), b2, voffB);
            PG8_BAR; PG8_WAIT_L(0); PG8_MMA(0, 1, At, B1); PG8_BAR;
            PG8_LDA(At, 0, 1); PG8_STAGE(PG8_SA(0, 0), a2, voffA);
            PG8_BAR; PG8_WAIT_L(0); PG8_MMA(1, 0, At, B0); PG8_BAR; PG8_SCHED;
            PG8_STAGE(PG8_SB(0, 1), b2 + hstep, voffB);
            PG8_WAIT_V(6); PG8_BAR; PG8_MMA(1, 1, At, B1); PG8_BAR;
            PG8_LDB(B0, 1, 0); PG8_SCHED; PG8_LDA(At, 1, 0); PG8_STAGE(PG8_SA(0, 1), a2 + hstep, voffA);
            PG8_WAIT_L(8); PG8_BAR; PG8_WAIT_L(0); PG8_MMA(0, 0, At, B0); PG8_BAR; PG8_SCHED;
            PG8_LDB(B1, 1, 1); PG8_STAGE(PG8_SB(1, 0), b3, voffB);
            PG8_BAR; PG8_WAIT_L(0); PG8_MMA(0, 1, At, B1); PG8_BAR;
            PG8_LDA(At, 1, 1); PG8_STAGE(PG8_SA(1, 0), a3, voffA);
            PG8_BAR; PG8_WAIT_L(0); PG8_MMA(1, 0, At, B0); PG8_BAR; PG8_SCHED;
            PG8_STAGE(PG8_SB(1, 1), b3 + hstep, voffB);
            PG8_WAIT_V(6); PG8_BAR; PG8_MMA(1, 1, At, B1); PG8_BAR;
        }
        PG8_STAMP();
        if constexpr (!Epi::AFTER_DRAIN) { E(acc, cur, wr, wc, fr, fq); S.done(cur); }
        PG8_STAMP();
        if (!has_next) break;
#pragma unroll
        for (int a = 0; a < 2; ++a)
#pragma unroll
            for (int b = 0; b < 2; ++b)
#pragma unroll
                for (int m = 0; m < 4; ++m)
#pragma unroll
                    for (int n = 0; n < 2; ++n) acc[a][b][m][n] = (f32x4){0.f, 0.f, 0.f, 0.f};
        cur = nxt; cA = nA; cB = nB; ++ui;
    }
    PG8_WAIT_V(0);
    if (wr == 0) PG8_BAR;
    PG8_BAR;
    if constexpr (Epi::AFTER_DRAIN) { E.fused(acc, cur, wr, wc, fr, fq, lds, wid, lane); S.done(cur); }
    PG8_STAMP();
    if (STAMP && wid == 0) { stamps[lane] = lane < nts ? (((unsigned long long)(unsigned)ts_hi << 32) | (unsigned)ts_lo) : 0ull;
        if (lane == 62) stamps[62] = rt_entry; if (lane == 63) stamps[63] = (unsigned long long)wall_clock64(); }
#undef PG8_STAMP
#undef PG8_SA
#undef PG8_SB
#undef PG8_STAGE
#undef PG8_LDA
#undef PG8_LDB
#undef PG8_MMA
#undef PG8_WAIT_V
#undef PG8_WAIT_L
#undef PG8_BAR
#undef PG8_SCHED
}
}
using pg8::bf16_t; using pg8::bf16x8; using pg8::f32x4; using pg8::u32x4;
typedef short s16x4 __attribute__((ext_vector_type(4)));
typedef float f32x16 __attribute__((ext_vector_type(16)));
typedef float f32x2 __attribute__((ext_vector_type(2)));
typedef unsigned u32x2 __attribute__((ext_vector_type(2)));
typedef int i32x4 __attribute__((ext_vector_type(4)));
typedef __bf16 bfv2 __attribute__((ext_vector_type(2)));

constexpr int T_ = 8192, D_ = 2048;
constexpr size_t OFF_CTL = 0;
constexpr size_t OFF_MOD = 16384;
constexpr size_t OFF_ROPE = OFF_MOD + 262144;
constexpr size_t OFF_WG = OFF_ROPE + 524288;
constexpr size_t OFF_GATES = OFF_WG + 65536;
constexpr size_t OFF_IDX = OFF_GATES + 262144;
constexpr size_t OFF_GW = OFF_IDX + 4194304;
constexpr size_t OFF_NST = OFF_GW + 4194304;
constexpr size_t OFF_DEC = OFF_NST + 262144;
constexpr size_t OFF_SU = OFF_DEC + 4096;
constexpr size_t OFF_SV = OFF_SU + 65536;
constexpr size_t OFF_AACC = OFF_SV + 65536;
constexpr size_t OFF_SKB = OFF_AACC + 4194304;
constexpr size_t OFF_WINT = OFF_SKB + 524288;
constexpr size_t OFF_WOUTT = OFF_WINT + 25165824;
constexpr size_t OFF_WPQT = OFF_WOUTT + 8388608;
constexpr size_t OFF_PU = OFF_WPQT + 8388608;
constexpr size_t OFF_PV = OFF_PU + 67108864;
constexpr size_t OFF_HB = OFF_PV + 67108864;
constexpr size_t OFF_PB = OFF_HB + 33554432;
constexpr size_t OFF_X1 = OFF_PB;
constexpr size_t OFF_QP = OFF_PB + 67108864;
constexpr size_t OFF_MIX = OFF_PB + 100663296;
constexpr size_t OFF_CST = OFF_MIX + 33554432;
constexpr size_t OFF_PA = OFF_QP;
constexpr size_t OFF_Y = OFF_CST;
constexpr size_t WS_TOTAL = OFF_CST + 67108864;
constexpr int LDS_BYTES = 147456;

struct Params {
  const float *x, *c, *w_ada, *b_ada, *g_mix, *w_in, *conv_w, *conv_b, *b_igate, *b_fgate,
              *lq1, *lk1, *lq2, *lk2, *da_norm, *ml_norm, *w_out, *g_ffn, *w_pq, *sub_keys,
              *peer_u, *peer_v, *w_ada_final, *b_ada_final, *g_final;
  float* out;
  unsigned char* ws;
};

DI unsigned pk2(float lo, float hi) { f32x2 v = {lo, hi}; bfv2 r = __builtin_convertvector(v, bfv2); return __builtin_bit_cast(unsigned, r); }
DI float bflo(unsigned u) { return __uint_as_float(u << 16); }
DI float bfhi(unsigned u) { return __uint_as_float(u & 0xffff0000u); }
DI float bf2f(bf16_t b) { return __uint_as_float(((unsigned)b) << 16); }
DI float wave_sum(float v) {
#pragma unroll
  for (int o = 1; o < 64; o <<= 1) v += __shfl_xor(v, o);
  return v;
}
DI f32x16 mfma32(bf16x8 a, bf16x8 b, f32x16 c) { return __builtin_amdgcn_mfma_f32_32x32x16_bf16(a, b, c, 0, 0, 0); }
DI int crow(int i, int h) { return (i & 3) + 8 * (i >> 2) + 4 * h; }
template <int S> DI bf16x8 pack8(const f32x16& x) {
  u32x4 p; p[0] = pk2(x[8 * S], x[8 * S + 1]); p[1] = pk2(x[8 * S + 2], x[8 * S + 3]); p[2] = pk2(x[8 * S + 4], x[8 * S + 5]); p[3] = pk2(x[8 * S + 6], x[8 * S + 7]);
  return __builtin_bit_cast(bf16x8, p);
}
DI bf16x8 cat4(s16x4 lo, s16x4 hi) { return __builtin_shufflevector(lo, hi, 0, 1, 2, 3, 4, 5, 6, 7); }
DI f32x16 zero16() { f32x16 z; for (int i = 0; i < 16; ++i) z[i] = 0.f; return z; }
#define LDS_WAIT() asm volatile("s_waitcnt lgkmcnt(0)" ::: "memory")
DI int newpos_in(int o) { if (o >= 2048) return o; const int hd = o >> 6, j = o & 63; return hd * 64 + (j < 32 ? 2 * j : 2 * (j - 32) + 1); }
DI void transpose_item(const float* W, int ldw, int nblk, bf16_t* WT, int K, float* scr, int item, int lane, bool perm) {
  const int kb = item / nblk, nb = item % nblk, k0 = 64 * kb, n0 = 32 * nb;
#pragma unroll 8
  for (int i = 0; i < 32; ++i) { const int kk = 2 * i + (lane >> 5); scr[kk * 33 + (lane & 31)] = W[(size_t)(k0 + kk) * ldw + n0 + (lane & 31)]; }
  LDS_WAIT();
  const int c = lane & 7;
#pragma unroll
  for (int j = 0; j < 4; ++j) { const int n = (lane >> 3) + 8 * j; const float* s = scr + (8 * c) * 33 + n;
    u32x4 o; o[0] = pk2(s[0 * 33], s[1 * 33]); o[1] = pk2(s[2 * 33], s[3 * 33]); o[2] = pk2(s[4 * 33], s[5 * 33]); o[3] = pk2(s[6 * 33], s[7 * 33]);
    const int orow = perm ? newpos_in(n0 + n) : (n0 + n);
    *(u32x4*)(WT + (size_t)orow * K + k0 + 8 * c) = o; }
  LDS_WAIT();
}
#define CPR_LOAD(dst, rowx) { const int r_ = (rowx); const float* src_ = (r_ < 16384 ? p.peer_u + (size_t)r_ * 2048 : p.peer_v + (size_t)(r_ - 16384) * 2048); \
    _Pragma("unroll") for (int j_ = 0; j_ < 8; ++j_) dst[j_] = *(const f32x4*)(src_ + (j_ >> 2) * 1024 + lane * 16 + (j_ & 3) * 4); }
DI void convert_peer_rows(const Params& p, int gw, int NGW, int lane) {
  unsigned char* PU8 = (unsigned char*)(p.ws + OFF_PU); unsigned char* PV8 = (unsigned char*)(p.ws + OFF_PV);
  float* SU = (float*)(p.ws + OFF_SU); float* SV = (float*)(p.ws + OFF_SV);
  if (gw >= 32768) return;
  f32x4 va[8], vb[8];
  CPR_LOAD(va, gw);
  CPR_LOAD(vb, (gw + NGW < 32768) ? gw + NGW : gw);
  for (int row = gw; row < 32768; row += NGW) {
    const bool isu = row < 16384; const int rr = isu ? row : row - 16384;
    f32x4 v[8]; float am = 0.f;
#pragma unroll
    for (int j = 0; j < 8; ++j) { v[j] = va[j]; va[j] = vb[j]; am = fmaxf(am, fmaxf(fmaxf(fabsf(v[j][0]), fabsf(v[j][1])), fmaxf(fabsf(v[j][2]), fabsf(v[j][3])))); }
    CPR_LOAD(vb, (row + 2 * NGW < 32768) ? row + 2 * NGW : row);
#pragma unroll
    for (int o = 1; o < 64; o <<= 1) am = fmaxf(am, __shfl_xor(am, o));
    const float sc = am > 0.f ? 448.0f / am : 1.0f, inv = am > 0.f ? am * (1.0f / 448.0f) : 1.0f;
#pragma unroll
    for (int q = 0; q < 2; ++q) { u32x4 o4;
#pragma unroll
      for (int k = 0; k < 4; ++k) { const f32x4 a = v[q * 4 + k] * sc; int r = __builtin_amdgcn_cvt_pk_fp8_f32(a[0], a[1], 0, false); r = __builtin_amdgcn_cvt_pk_fp8_f32(a[2], a[3], r, true); o4[k] = (unsigned)r; }
      *(u32x4*)((isu ? PU8 : PV8) + ((size_t)(q * 4 + (lane >> 4)) * 16384 + rr) * 256 + (lane & 15) * 16) = o4; }
    if (lane == 0) SU[2 * rr + (isu ? 0 : 1)] = inv;
  }
}
#undef CPR_LOAD
DI void phase0(const Params& p, unsigned char* lds, int bid, int nblk, int tid) {
  const int lane = tid & 63, wave = tid >> 6;
  float* MOD = (float*)(p.ws + OFF_MOD);
  float* cs = (float*)lds;
  float* red = (float*)(lds + 32768);
  for (int item = bid; item < 256; item += nblk) {
    const int col0 = item * 64;
    __syncthreads();
    for (int i = tid; i < 8192; i += 512) { const float v = p.c[i]; cs[i] = v / (1.f + expf(-v)); }
    __syncthreads();
    const int cg = tid & 15, dg = tid >> 4;
    const int col = col0 + cg * 4;
    const float* W; int ldw, wc; const float* bb;
    if (col < 12288) { W = p.w_ada; ldw = 12288; wc = col; bb = p.b_ada + col0; } else { W = p.w_ada_final; ldw = 4096; wc = col - 12288; bb = p.b_ada_final + (col0 - 12288); }
    f32x4 acc[4];
#pragma unroll
    for (int b = 0; b < 4; ++b) acc[b] = (f32x4){0.f, 0.f, 0.f, 0.f};
#pragma unroll 8
    for (int i = 0; i < 64; ++i) {
      const int d = dg * 64 + i;
      const f32x4 w = *(const f32x4*)(W + (size_t)d * ldw + wc);
#pragma unroll
      for (int b = 0; b < 4; ++b) acc[b] += cs[b * 2048 + d] * w;
    }
#pragma unroll
    for (int b = 0; b < 4; ++b) *(f32x4*)(red + (dg * 4 + b) * 64 + cg * 4) = acc[b];
    __syncthreads();
    if (tid < 256) { const int b = tid >> 6, cc = tid & 63; float sm = bb[cc];
      for (int g = 0; g < 32; ++g) sm += red[(g * 4 + b) * 64 + cc];
      MOD[b * 16384 + col0 + cc] = sm; }
  }
  __syncthreads();
  float* scr = (float*)(lds + 65536 + wave * 8448);
  const int gw = bid * 8 + wave, NGW = nblk * 8;
  constexpr int I_IN = 32 * 192, I_O = 32 * 64;
  bf16_t* WINT = (bf16_t*)(p.ws + OFF_WINT); bf16_t* WOUTT = (bf16_t*)(p.ws + OFF_WOUTT); bf16_t* WPQT = (bf16_t*)(p.ws + OFF_WPQT);
  for (int it = gw; it < I_IN + 2 * I_O; it += NGW) {
    if (it < I_IN) transpose_item(p.w_in, 6152, 192, WINT, 2048, scr, it, lane, true);
    else if (it < I_IN + I_O) transpose_item(p.w_out, 2048, 64, WOUTT, 2048, scr, it - I_IN, lane, false);
    else transpose_item(p.w_pq, 2048, 64, WPQT, 2048, scr, it - I_IN - I_O, lane, false);
  }
  {
    bf16_t* SKB = (bf16_t*)(p.ws + OFF_SKB);
    for (int i = bid * 512 + tid; i < 32768; i += nblk * 512) { const f32x4 a0 = *(const f32x4*)(p.sub_keys + (size_t)i * 8), a1 = *(const f32x4*)(p.sub_keys + (size_t)i * 8 + 4);
      u32x4 ap; ap[0] = pk2(a0[0], a0[1]); ap[1] = pk2(a0[2], a0[3]); ap[2] = pk2(a1[0], a1[1]); ap[3] = pk2(a1[2], a1[3]); *(u32x4*)(SKB + (size_t)i * 8) = ap; }
    float* WG = (float*)(p.ws + OFF_WG);
    for (int i = bid * 512 + tid; i < 16384; i += nblk * 512) { const int j = i >> 11, k = i & 2047; WG[i] = p.w_in[(size_t)k * 6152 + 6144 + j]; }
  }
}
template <bool GATES> DI void phase_norm(const Params& p, const float* src, const float* gvec, int sh_idx, int sc_idx, int bid, int nblk, int tid, unsigned char* lds) {
  const int lane = tid & 63, wave = tid >> 6;
  float* WGs = (float*)lds;
  if (GATES) {
    const float* WGg = (const float*)(p.ws + OFF_WG);
#pragma unroll
    for (int i = 0; i < 8; ++i) { const int e4 = (tid + 512 * i) * 4, j = e4 >> 11, e = e4 & 2047, r = e >> 9, ln = (e & 511) >> 3, q = (e >> 2) & 1;
      *(f32x4*)(WGs + j * 2048 + r * 512 + q * 256 + ln * 4) = *(const f32x4*)(WGg + e4); }
    __syncthreads();
  }
  float* G1s = (float*)(lds + 65536); float* SHs = (float*)(lds + 98304);
  { const float* MODg = (const float*)(p.ws + OFF_MOD);
#pragma unroll 1
    for (int i = 0; i < 4; ++i) { const int e4 = (tid + 512 * i) * 4, b = e4 >> 11, e = e4 & 2047, r = e >> 9, ln = (e & 511) >> 3, q = (e >> 2) & 1;
      const f32x4 g4 = *(const f32x4*)(gvec + e), sc4 = *(const f32x4*)(MODg + b * 16384 + sc_idx * 2048 + e), sh4 = *(const f32x4*)(MODg + b * 16384 + sh_idx * 2048 + e);
      *(f32x4*)(G1s + b * 2048 + r * 512 + q * 256 + ln * 4) = g4 * (1.f + sc4); *(f32x4*)(SHs + b * 2048 + r * 512 + q * 256 + ln * 4) = sh4; }
    __syncthreads(); }
  const float* MOD = (const float*)(p.ws + OFF_MOD);
  bf16_t* HB = (bf16_t*)(p.ws + OFF_HB);
  const float* WG = (const float*)(p.ws + OFF_WG);
  float* GT = (float*)(p.ws + OFF_GATES);
  for (int t = bid * 8 + wave; t < T_; t += nblk * 8) {
    const int b = t >> 11;
    const float* xr = src + (size_t)t * 2048;
    f32x4 v[8];
    float ss = 0.f;
#pragma unroll
    for (int r = 0; r < 4; ++r) {
      v[2 * r] = *(const f32x4*)(xr + r * 512 + lane * 8); v[2 * r + 1] = *(const f32x4*)(xr + r * 512 + lane * 8 + 4);
#pragma unroll
      for (int q = 0; q < 2; ++q) ss += v[2 * r + q][0] * v[2 * r + q][0] + v[2 * r + q][1] * v[2 * r + q][1] + v[2 * r + q][2] * v[2 * r + q][2] + v[2 * r + q][3] * v[2 * r + q][3];
    }
    ss = wave_sum(ss);
    const float rstd = 1.0f / sqrtf(ss * (1.f / 2048.f) + 1e-6f);
    const float* sh = MOD + b * 16384 + sh_idx * 2048; const float* sc = MOD + b * 16384 + sc_idx * 2048;
#pragma unroll
    for (int r = 0; r < 4; ++r) {
#pragma unroll
      for (int q = 0; q < 2; ++q) {
        const f32x4 g4 = *(const f32x4*)(G1s + b * 2048 + r * 512 + q * 256 + lane * 4), sh4 = *(const f32x4*)(SHs + b * 2048 + r * 512 + q * 256 + lane * 4);
        v[2 * r + q] = v[2 * r + q] * rstd * g4 + sh4;
      }
    }
#pragma unroll
    for (int r = 0; r < 4; ++r) {
      u32x4 o; o[0] = pk2(v[2 * r][0], v[2 * r][1]); o[1] = pk2(v[2 * r][2], v[2 * r][3]); o[2] = pk2(v[2 * r + 1][0], v[2 * r + 1][1]); o[3] = pk2(v[2 * r + 1][2], v[2 * r + 1][3]);
      *(u32x4*)(HB + (size_t)t * 2048 + r * 512 + lane * 8) = o;
    }
    if (GATES) {
      float mine = 0.f;
#pragma unroll 1
      for (int j = 0; j < 8; ++j) {
        float d = 0.f;
#pragma unroll
        for (int r = 0; r < 4; ++r)
#pragma unroll
          for (int q = 0; q < 2; ++q) { const f32x4 w = *(const f32x4*)(WGs + j * 2048 + r * 512 + q * 256 + lane * 4); const f32x4 a = v[2 * r + q]; d += a[0] * w[0] + a[1] * w[1] + a[2] * w[2] + a[3] * w[3]; }
        d = wave_sum(d);
        if (lane == j) mine = d;
      }
      if (lane < 8) GT[t * 8 + lane] = mine;
    }
  }
}
struct EpiProj {
  static constexpr bool PERM = true, AFTER_DRAIN = false;
  bf16_t* PB;
  DI void operator()(const f32x4 (&acc)[2][2][4][2], const pg8::Unit& u, int wr, int wc, int fr, int fq) const {
    const int row0 = u.pm * 256 + wr * 64 + fr, col0 = u.pn * 256 + wc * 32 + 8 * fq;
    const bool rope = u.pn < 8; const float qs = u.pn < 4 ? 0.125f * 1.4426950408889634f : 1.0f;
    float ir[2][4];
#pragma unroll
    for (int bj = 0; bj < 2; ++bj) { const int i0 = ((col0 + bj * 128) & 63) >> 1;
#pragma unroll
      for (int k = 0; k < 4; ++k) ir[bj][k] = exp2f(-(float)(i0 + k) * 0.41524101186092029f) * 0.15915494309189535f; }
#pragma unroll
    for (int ai = 0; ai < 2; ++ai)
#pragma unroll
      for (int m = 0; m < 4; ++m) {
        const int row = row0 + ai * 128 + m * 16; const float fpos = (float)(row & 2047);
#pragma unroll
        for (int bj = 0; bj < 2; ++bj) {
          float v[8];
#pragma unroll
          for (int n = 0; n < 2; ++n)
#pragma unroll
            for (int k = 0; k < 4; ++k) v[4 * n + k] = acc[ai][bj][m][n][k];
          if (rope) {
#pragma unroll
            for (int k = 0; k < 4; ++k) { const float rr = __builtin_amdgcn_fractf(fpos * ir[bj][k]); const float cc = __builtin_amdgcn_cosf(rr), sn = __builtin_amdgcn_sinf(rr);
              const float a0 = v[2 * k] * cc - v[2 * k + 1] * sn, a1 = v[2 * k + 1] * cc + v[2 * k] * sn; v[2 * k] = a0 * qs; v[2 * k + 1] = a1 * qs; }
          }
          u32x4 o; o[0] = pk2(v[0], v[1]); o[1] = pk2(v[2], v[3]); o[2] = pk2(v[4], v[5]); o[3] = pk2(v[6], v[7]);
          *(u32x4*)(PB + (size_t)row * 6144 + col0 + bj * 128) = o;
        }
      }
  }
};
struct EpiRes {
  static constexpr bool PERM = false, AFTER_DRAIN = false;
  float* X1; const float* x; const float* MOD;
  DI void operator()(const f32x4 (&acc)[2][2][4][2], const pg8::Unit& u, int wr, int wc, int fr, int fq) const {
    const int row0 = u.pm * 256 + wr * 64 + fr, col0 = u.pn * 256 + wc * 32 + 4 * fq;
    const int b = (u.pm * 256) >> 11;
    f32x4 gt[2][2];
#pragma unroll
    for (int bj = 0; bj < 2; ++bj)
#pragma unroll
      for (int n = 0; n < 2; ++n) gt[bj][n] = *(const f32x4*)(MOD + b * 16384 + 2 * 2048 + col0 + bj * 128 + n * 16);
#pragma unroll
    for (int ai = 0; ai < 2; ++ai) {
      f32x4 xv[4][2][2];
#pragma unroll
      for (int m = 0; m < 4; ++m)
#pragma unroll
        for (int bj = 0; bj < 2; ++bj)
#pragma unroll
          for (int n = 0; n < 2; ++n) xv[m][bj][n] = *(const f32x4*)(x + (size_t)(row0 + ai * 128 + m * 16) * 2048 + col0 + bj * 128 + n * 16);
#pragma unroll
      for (int m = 0; m < 4; ++m)
#pragma unroll
        for (int bj = 0; bj < 2; ++bj)
#pragma unroll
          for (int n = 0; n < 2; ++n) *(f32x4*)(X1 + (size_t)(row0 + ai * 128 + m * 16) * 2048 + col0 + bj * 128 + n * 16) = xv[m][bj][n] + gt[bj][n] * acc[ai][bj][m][n];
    }
  }
};
struct EpiBf {
  static constexpr bool PERM = true, AFTER_DRAIN = false;
  bf16_t* O;
  DI void operator()(const f32x4 (&acc)[2][2][4][2], const pg8::Unit& u, int wr, int wc, int fr, int fq) const {
    const int row0 = u.pm * 256 + wr * 64 + fr, col0 = u.pn * 256 + wc * 32 + 8 * fq;
#pragma unroll
    for (int ai = 0; ai < 2; ++ai)
#pragma unroll
      for (int m = 0; m < 4; ++m) {
        const size_t ro = (size_t)(row0 + ai * 128 + m * 16) * 2048;
#pragma unroll
        for (int bj = 0; bj < 2; ++bj) { const f32x4 v0 = acc[ai][bj][m][0], v1 = acc[ai][bj][m][1]; u32x4 o; o[0] = pk2(v0[0], v0[1]); o[1] = pk2(v0[2], v0[3]); o[2] = pk2(v1[0], v1[1]); o[3] = pk2(v1[2], v1[3]); *(u32x4*)(O + ro + col0 + bj * 128) = o; }
      }
  }
};
DI bf16_t f2bf1(float x) { return (bf16_t)(pk2(x, 0.f) & 0xffffu); }
DI void phase_attn(const Params& p, unsigned char* lds, int bid, int nblk, int tid_in) {
  const bf16_t* PB = (const bf16_t*)(p.ws + OFF_PB); bf16_t* MIX = (bf16_t*)(p.ws + OFF_MIX);
  float* XE = (float*)(lds + 71680);
  float d1 = 0.f, d2 = 0.f;
  for (int i = 0; i < 64; ++i) { d1 += p.lq1[i] * p.lk1[i]; d2 += p.lq2[i] * p.lk2[i]; }
  const float lam = expf(d1) - expf(d2) + 0.2f;
  for (int u0 = bid; u0 < 256; u0 += nblk) {
    const int u = (nblk == 256) ? ((u0 & 7) * 32 + (u0 >> 3)) : u0;
    const int bh = u >> 3, pi = u & 7, b = bh >> 3, hd = bh & 7;
    u32x4 kreg[2], vreg[2];
    for (int half = 0; half < 2; ++half) {
      int tid = tid_in; asm volatile("" : "+v"(tid));
      const int lane = tid & 63, wave = tid >> 6, r = lane & 31, h = lane >> 5;
      const int map = wave & 1, qs = wave >> 1;
      const int qb = half ? 15 - pi : pi;
      const int qg = qb * 128 + qs * 32 + r;
      const size_t tq = (size_t)b * 2048 + qg;
      bf16x8 bq[4];
#pragma unroll
      for (int s = 0; s < 4; ++s) bq[s] = *(const bf16x8*)(PB + tq * 6144 + (2 * hd + map) * 64 + 16 * s + 8 * h);
      f32x16 o[4];
#pragma unroll
      for (int et = 0; et < 4; ++et) o[et] = zero16();
      float m_run = -INFINITY, l_run = 0.f;
      const int nkt = 2 * qb + 2;
      const int vc16 = tid & 15, vrp = tid >> 4;
      const bf16_t* kbase = PB + (size_t)b * 2048 * 6144 + 1024 + hd * 128;
      const bf16_t* vbase = PB + (size_t)b * 2048 * 6144 + 2048 + hd * 128 + vc16 * 8;
#define AT_GK(kt) _Pragma("unroll") for (int i_ = 0; i_ < 2; ++i_) { const int q_ = tid + 512 * i_; kreg[i_] = *(const u32x4*)(kbase + (size_t)((kt) * 64 + (q_ >> 4)) * 6144 + (q_ & 15) * 8); }
#define AT_GV(kt) _Pragma("unroll") for (int i_ = 0; i_ < 2; ++i_) vreg[i_] = *(const u32x4*)(vbase + (size_t)((kt) * 64 + 2 * vrp + i_) * 6144);
#define AT_WK(buf) _Pragma("unroll") for (int i_ = 0; i_ < 2; ++i_) { const int q_ = tid + 512 * i_; *(u32x4*)((bf16_t*)(lds + (buf) * 17408) + (q_ >> 4) * 136 + (q_ & 15) * 8) = kreg[i_]; }
#define AT_WV(buf) { bf16_t* VT_ = (bf16_t*)(lds + 34816 + (buf) * 18432); const int pk_ = (2 * vrp + 4 * vc16) & 63; _Pragma("unroll") for (int d_ = 0; d_ < 4; ++d_) { const unsigned a_ = vreg[0][d_], b_ = vreg[1][d_]; \
          *(unsigned*)(VT_ + (vc16 * 8 + 2 * d_) * 72 + pk_) = (a_ & 0xffffu) | (b_ << 16); *(unsigned*)(VT_ + (vc16 * 8 + 2 * d_ + 1) * 72 + pk_) = (a_ >> 16) | (b_ & 0xffff0000u); } }
#define AT_QK(dst, buf) { const bf16_t* Ks_ = (const bf16_t*)(lds + (buf) * 17408); _Pragma("unroll") for (int kk = 0; kk < 2; ++kk) { dst[kk] = zero16(); \
          _Pragma("unroll") for (int s = 0; s < 4; ++s) { const bf16x8 a_ = *(const bf16x8*)(Ks_ + (kk * 32 + r) * 136 + map * 64 + 16 * s + 8 * h); dst[kk] = mfma32(a_, bq[s], dst[kk]); } } }
      if (half == 0) { AT_GK(0); AT_GV(0); }
      __syncthreads();
      AT_WK(0); AT_WV(0);
      AT_GK(1);
      AT_WK(1);
      __syncthreads();
      if (nkt > 2) { AT_GK(2); }
      AT_GV(1);
      f32x16 st[2], sn[2];
      AT_QK(st, 0);
      __syncthreads();
      for (int kt = 0; kt < nkt; ++kt) {
        if (kt + 2 < nkt) { AT_WK(kt & 1); }
        if (kt + 1 < nkt) { AT_WV((kt + 1) & 1); }
        if (kt + 3 < nkt) { AT_GK(kt + 3); }
        if (kt + 2 < nkt) { AT_GV(kt + 2); }
        AT_QK(sn, (kt + 1) & 1);
        const bool diag = (kt >= 2 * qb);
        if (diag) {
#pragma unroll
          for (int kk = 0; kk < 2; ++kk)
#pragma unroll
            for (int i = 0; i < 16; ++i) { const int kg = kt * 64 + kk * 32 + crow(i, h); if (kg > qg) st[kk][i] = -INFINITY; }
        }
        float mx = -INFINITY;
#pragma unroll
        for (int kk = 0; kk < 2; ++kk)
#pragma unroll
          for (int i = 0; i < 16; ++i) mx = fmaxf(mx, st[kk][i]);
        mx = fmaxf(mx, __shfl_xor(mx, 32));
        const float m_new = fmaxf(m_run, mx);
        const bool need = (m_new - m_run) > 8.0f;
        if (__any(need)) {
          const float m_use = need ? m_new : m_run;
          const float corr = __builtin_amdgcn_exp2f(m_run - m_use);
          l_run *= corr;
#pragma unroll
          for (int et = 0; et < 4; ++et) o[et] *= corr;
          m_run = m_use;
        }
        float ps = 0.f;
#pragma unroll
        for (int kk = 0; kk < 2; ++kk)
#pragma unroll
          for (int i = 0; i < 16; ++i) { const float pv = __builtin_amdgcn_exp2f(st[kk][i] - m_run); st[kk][i] = pv; ps += pv; }
        l_run += ps;
        const bf16_t* VT = (const bf16_t*)(lds + 34816 + (kt & 1) * 18432);
#pragma unroll
        for (int kk = 0; kk < 2; ++kk) {
          const bf16x8 pf0 = pack8<0>(st[kk]), pf1 = pack8<1>(st[kk]);
#pragma unroll
          for (int et = 0; et < 4; ++et) {
            const int ev = et * 32 + r, rot = 4 * ((ev >> 3) & 15) + kk * 32 + 4 * h;
            const bf16_t* vrow = VT + ev * 72;
            const bf16x8 a0 = cat4(*(const s16x4*)(vrow + (rot & 63)), *(const s16x4*)(vrow + ((rot + 8) & 63))), a1 = cat4(*(const s16x4*)(vrow + ((rot + 16) & 63)), *(const s16x4*)(vrow + ((rot + 24) & 63)));
            o[et] = mfma32(a0, pf0, o[et]); o[et] = mfma32(a1, pf1, o[et]);
          }
        }
        st[0] = sn[0]; st[1] = sn[1];
        __syncthreads();
      }
      if (half == 0) { AT_GK(0); AT_GV(0); }
#undef AT_GK
#undef AT_GV
#undef AT_WK
#undef AT_WV
#undef AT_QK
      const float inv = 1.0f / (l_run + __shfl_xor(l_run, 32));
      if (map == 1) {
#pragma unroll
        for (int et = 0; et < 4; ++et)
#pragma unroll
          for (int i = 0; i < 16; ++i) XE[(qs * 128 + et * 32 + crow(i, h)) * 32 + r] = lam * o[et][i] * inv;
      }
      __syncthreads();
      if (map == 0) {
        float ss = 0.f;
#pragma unroll
        for (int et = 0; et < 4; ++et)
#pragma unroll
          for (int i = 0; i < 16; ++i) { const float v = o[et][i] * inv - XE[(qs * 128 + et * 32 + crow(i, h)) * 32 + r]; o[et][i] = v; ss += v * v; }
        ss += __shfl_xor(ss, 32);
        const float rstd = 0.8f / sqrtf(ss * (1.f / 128.f) + 1e-6f);
        f32x4 dnv[4][4];
#pragma unroll
        for (int et = 0; et < 4; ++et)
#pragma unroll
          for (int g = 0; g < 4; ++g) dnv[et][g] = *(const f32x4*)(p.da_norm + et * 32 + 8 * g + 4 * h);
#pragma unroll
        for (int et = 0; et < 4; ++et)
#pragma unroll
          for (int g = 0; g < 4; ++g) { const int e0 = et * 32 + 8 * g + 4 * h; const f32x4 dn = dnv[et][g];
            u32x2 ov; ov[0] = pk2(o[et][4 * g] * rstd * dn[0], o[et][4 * g + 1] * rstd * dn[1]); ov[1] = pk2(o[et][4 * g + 2] * rstd * dn[2], o[et][4 * g + 3] * rstd * dn[3]);
            *(u32x2*)(MIX + tq * 2048 + hd * 128 + e0) = ov; }
      }
    }
  }
  __syncthreads();
}
DI void conv8(const Params& p, const bf16_t* PB, int b, int spos, int pbcol, int cch, float (&out)[8]) {
  const f32x4 b0 = *(const f32x4*)(p.conv_b + cch), b1 = *(const f32x4*)(p.conv_b + cch + 4);
#pragma unroll
  for (int j = 0; j < 4; ++j) { out[j] = b0[j]; out[4 + j] = b1[j]; }
#pragma unroll
  for (int kw = 0; kw < 4; ++kw) {
    const int sp = spos - 3 + kw;
    if (sp >= 0) {
      const u32x4 xv = *(const u32x4*)(PB + ((size_t)b * 2048 + sp) * 6144 + pbcol);
      const f32x4 w0 = *(const f32x4*)(p.conv_w + kw * 1024 + cch), w1 = *(const f32x4*)(p.conv_w + kw * 1024 + cch + 4);
      out[0] += w0[0] * bflo(xv[0]); out[1] += w0[1] * bfhi(xv[0]); out[2] += w0[2] * bflo(xv[1]); out[3] += w0[3] * bfhi(xv[1]);
      out[4] += w1[0] * bflo(xv[2]); out[5] += w1[1] * bfhi(xv[2]); out[6] += w1[2] * bflo(xv[3]); out[7] += w1[3] * bfhi(xv[3]);
    }
  }
#pragma unroll
  for (int j = 0; j < 8; ++j) out[j] = out[j] / (1.f + __expf(-out[j]));
}
DI void gates64(const Params& p, int t0, int hh, int lane, float& li, float& bc) {
  const float* GT = (const float*)(p.ws + OFF_GATES);
  const float gi = GT[(t0 + lane) * 8 + hh] + p.b_igate[hh], gf = GT[(t0 + lane) * 8 + 4 + hh] + p.b_fgate[hh];
  li = 15.f * tanhf(gi * (1.f / 15.f));
  const float z = 15.f * tanhf(gf * (1.f / 15.f));
  const float lf = fminf(z, 0.f) - log1pf(expf(-fabsf(z)));
  bc = lf;
#pragma unroll
  for (int o = 1; o < 64; o <<= 1) { const float n = __shfl_up(bc, o); if (lane >= o) bc += n; }
}
DI void stage_vt256(const bf16_t* PB, bf16_t* VT, int t0, int hh, int tid) {
  const int c32 = tid & 31, rp = tid >> 5;
#pragma unroll
  for (int i = 0; i < 2; ++i) { const int r2 = 2 * (rp + 16 * i);
    const u32x4 va = *(const u32x4*)(PB + (size_t)(t0 + r2) * 6144 + 4096 + hh * 256 + c32 * 8), vb = *(const u32x4*)(PB + (size_t)(t0 + r2 + 1) * 6144 + 4096 + hh * 256 + c32 * 8);
    const int pk = (r2 + 4 * (c32 & 15)) & 63;
#pragma unroll
    for (int d = 0; d < 4; ++d) { *(unsigned*)(VT + (c32 * 8 + 2 * d) * 72 + pk) = (va[d] & 0xffffu) | (vb[d] << 16); *(unsigned*)(VT + (c32 * 8 + 2 * d + 1) * 72 + pk) = (va[d] >> 16) | (vb[d] & 0xffff0000u); } }
}
DI void phase_mlA(const Params& p, unsigned char* lds, int bid, int nblk, int tid_in) {
  const bf16_t* PB = (const bf16_t*)(p.ws + OFF_PB);
  bf16_t* CST = (bf16_t*)(p.ws + OFF_CST); float* NST = (float*)(p.ws + OFF_NST); float* DEC = (float*)(p.ws + OFF_DEC);
  bf16_t* KwT = (bf16_t*)lds;
  bf16_t* VT = (bf16_t*)(lds + 18432);
  float* wsv = (float*)(lds + 55296);
  for (int u = bid; u < 512; u += nblk) {
    int tid = tid_in; asm volatile("" : "+v"(tid));
    const int lane = tid & 63, wave = tid >> 6, r = lane & 31, h = lane >> 5;
    const int bh = u >> 5, c = u & 31, b = bh >> 2, hh = bh & 3;
    const int t0 = b * 2048 + c * 64;
    __syncthreads();
    if (wave == 0) {
      float li, bc; gates64(p, t0, hh, lane, li, bc);
      const float bL = __shfl(bc, 63);
      wsv[lane] = expf(bL - bc + li);
      if (lane == 0) DEC[u] = expf(bL);
    }
    __syncthreads();
    { const int c8 = tid & 15, rp = tid >> 4; float oa[8], ob[8];
      conv8(p, PB, b, c * 64 + 2 * rp, 3584 + hh * 128 + c8 * 8, 512 + hh * 128 + c8 * 8, oa);
      conv8(p, PB, b, c * 64 + 2 * rp + 1, 3584 + hh * 128 + c8 * 8, 512 + hh * 128 + c8 * 8, ob);
      const float wa = wsv[2 * rp] * 0.08838834764831845f, wb = wsv[2 * rp + 1] * 0.08838834764831845f;
      const int pk = (2 * rp + 4 * c8) & 63;
#pragma unroll
      for (int j = 0; j < 8; ++j) *(unsigned*)(KwT + (c8 * 8 + j) * 72 + pk) = pk2(oa[j] * wa, ob[j] * wb); }
    stage_vt256(PB, VT, t0, hh, tid);
    __syncthreads();
    f32x16 acc[4];
#pragma unroll
    for (int d = 0; d < 4; ++d) acc[d] = zero16();
#pragma unroll
    for (int ks = 0; ks < 4; ++ks) { const int ev = wave * 32 + r, rv = 4 * ((ev >> 3) & 15) + 16 * ks + 4 * h;
      const bf16x8 a = cat4(*(const s16x4*)(VT + ev * 72 + (rv & 63)), *(const s16x4*)(VT + ev * 72 + ((rv + 8) & 63)));
#pragma unroll
      for (int d = 0; d < 4; ++d) { const int dk = d * 32 + r, rk = 4 * ((dk >> 3) & 15) + 16 * ks + 4 * h;
        const bf16x8 bb = cat4(*(const s16x4*)(KwT + dk * 72 + (rk & 63)), *(const s16x4*)(KwT + dk * 72 + ((rk + 8) & 63))); acc[d] = mfma32(a, bb, acc[d]); } }
    bf16_t* C = CST + (size_t)u * 32768;
#pragma unroll
    for (int d = 0; d < 4; ++d)
#pragma unroll
      for (int i = 0; i < 16; ++i) C[(wave * 32 + crow(i, h)) * 128 + d * 32 + r] = f2bf1(acc[d][i]);
    if (tid < 128) { float s = 0.f; for (int ss = 0; ss < 64; ++ss) s += bf2f(KwT[tid * 72 + ss]); NST[u * 128 + tid] = s; }
  }
}
DI void phase_scan(const Params& p, int bid, int nblk, int tid) {
  u32x2* CST = (u32x2*)(p.ws + OFF_CST); float* NST = (float*)(p.ws + OFF_NST); const float* DEC = (const float*)(p.ws + OFF_DEC);
  for (int e = bid * 512 + tid; e < 16 * 8192 + 16 * 128; e += nblk * 512) {
    if (e < 131072) {
      const int bh = e >> 13; u32x2* base = CST + (size_t)bh * 32 * 8192 + (e & 8191);
      u32x2 v[32];
#pragma unroll
      for (int c = 0; c < 32; ++c) v[c] = base[(size_t)c * 8192];
      float c0 = 0.f, c1 = 0.f, c2 = 0.f, c3 = 0.f;
#pragma unroll
      for (int c = 0; c < 32; ++c) { const float d = DEC[bh * 32 + c]; u32x2 o; o[0] = pk2(c0, c1); o[1] = pk2(c2, c3); base[(size_t)c * 8192] = o;
        c0 = d * c0 + bflo(v[c][0]); c1 = d * c1 + bfhi(v[c][0]); c2 = d * c2 + bflo(v[c][1]); c3 = d * c3 + bfhi(v[c][1]); }
    } else {
      const int e2 = e - 131072, bh = e2 >> 7; float* base = NST + (size_t)bh * 32 * 128 + (e2 & 127);
      float v[32];
#pragma unroll
      for (int c = 0; c < 32; ++c) v[c] = base[c * 128];
      float carry = 0.f;
#pragma unroll
      for (int c = 0; c < 32; ++c) { const float d = DEC[bh * 32 + c]; base[c * 128] = carry; carry = d * carry + v[c]; }
    }
  }
}
DI void phase_mlC(const Params& p, unsigned char* lds, int bid, int nblk, int tid_in) {
  const bf16_t* PB = (const bf16_t*)(p.ws + OFF_PB); bf16_t* MIX = (bf16_t*)(p.ws + OFF_MIX);
  const bf16_t* CST = (const bf16_t*)(p.ws + OFF_CST); const float* NST = (const float*)(p.ws + OFF_NST);
  bf16_t* Qs = (bf16_t*)lds;
  bf16_t* Ks = (bf16_t*)(lds + 17408);
  bf16_t* VT = (bf16_t*)(lds + 34816);
  bf16_t* CT = (bf16_t*)(lds + 71680);
  float* bvec = (float*)(lds + 141312);
  float* liv = bvec + 64; float* nvec = liv + 64; float* qn = nvec + 128;
  float* Hout = (float*)lds;
  for (int u = bid; u < 512; u += nblk) {
    int tid = tid_in; asm volatile("" : "+v"(tid));
    const int lane = tid & 63, wave = tid >> 6, r = lane & 31, h = lane >> 5;
    const int bh = u >> 5, c = u & 31, b = bh >> 2, hh = bh & 3;
    const int t0 = b * 2048 + c * 64;
    __syncthreads();
    if (wave == 0) { float li, bc; gates64(p, t0, hh, lane, li, bc); bvec[lane] = bc; liv[lane] = li; }
    if (tid >= 64 && tid < 192) nvec[tid - 64] = NST[u * 128 + tid - 64];
#pragma unroll 1
    for (int i = 0; i < 2; ++i) { const int q = tid + 512 * i, s = q >> 4, c8 = q & 15; float o8[8];
      conv8(p, PB, b, c * 64 + s, 3072 + hh * 128 + c8 * 8, hh * 128 + c8 * 8, o8);
      u32x4 ov; ov[0] = pk2(o8[0], o8[1]); ov[1] = pk2(o8[2], o8[3]); ov[2] = pk2(o8[4], o8[5]); ov[3] = pk2(o8[6], o8[7]);
      *(u32x4*)(Qs + s * 136 + c8 * 8) = ov;
      conv8(p, PB, b, c * 64 + s, 3584 + hh * 128 + c8 * 8, 512 + hh * 128 + c8 * 8, o8);
      const float w = 0.08838834764831845f;
      ov[0] = pk2(o8[0] * w, o8[1] * w); ov[1] = pk2(o8[2] * w, o8[3] * w); ov[2] = pk2(o8[4] * w, o8[5] * w); ov[3] = pk2(o8[6] * w, o8[7] * w);
      *(u32x4*)(Ks + s * 136 + c8 * 8) = ov; }
    stage_vt256(PB, VT, t0, hh, tid);
#pragma unroll
    for (int i = 0; i < 8; ++i) { const int q = tid + 512 * i, dv = q >> 4, c8 = q & 15;
      *(u32x4*)(CT + dv * 136 + c8 * 8) = *(const u32x4*)(CST + (size_t)u * 32768 + dv * 128 + c8 * 8); }
    __syncthreads();
    { const int j = tid >> 3, seg = tid & 7; float s = 0.f;
#pragma unroll
      for (int d = 0; d < 16; ++d) s += bf2f(Qs[j * 136 + seg * 16 + d]) * nvec[seg * 16 + d];
      s += __shfl_xor(s, 1); s += __shfl_xor(s, 2); s += __shfl_xor(s, 4);
      if (seg == 0) qn[j] = s; }
    __syncthreads();
    f32x16 hv[2];
#pragma unroll
    for (int jt = 0; jt < 2; ++jt) {
      f32x16 st[2]; st[0] = zero16(); st[1] = zero16();
#pragma unroll 2
      for (int ks = 0; ks < 8; ++ks) { const bf16x8 bqf = *(const bf16x8*)(Qs + (jt * 32 + r) * 136 + 16 * ks + 8 * h);
#pragma unroll
        for (int s2 = 0; s2 < 2; ++s2) { const bf16x8 a = *(const bf16x8*)(Ks + (s2 * 32 + r) * 136 + 16 * ks + 8 * h); st[s2] = mfma32(a, bqf, st[s2]); } }
      const int jj = jt * 32 + r; const float bj = bvec[jj]; float rs = 0.f;
#pragma unroll
      for (int s2 = 0; s2 < 2; ++s2)
#pragma unroll
        for (int i = 0; i < 16; ++i) { const int s = s2 * 32 + crow(i, h); const float w = (s <= jj) ? __expf(bj - bvec[s] + liv[s]) : 0.f; const float v = st[s2][i] * w; st[s2][i] = v; rs += v; }
      rs += __shfl_xor(rs, 32);
      const float den = __expf(bj) * qn[jj] + rs;
      const float dinv = 1.0f / fmaxf(fabsf(den), 1.0f);
      f32x16 z = zero16();
#pragma unroll
      for (int s2 = 0; s2 < 2; ++s2) { const bf16x8 pf0 = pack8<0>(st[s2]), pf1 = pack8<1>(st[s2]);
        const int ev = wave * 32 + r, rot = 4 * ((ev >> 3) & 15) + s2 * 32 + 4 * h;
        const bf16_t* vrow = VT + ev * 72;
        const bf16x8 b0 = cat4(*(const s16x4*)(vrow + (rot & 63)), *(const s16x4*)(vrow + ((rot + 8) & 63))), b1 = cat4(*(const s16x4*)(vrow + ((rot + 16) & 63)), *(const s16x4*)(vrow + ((rot + 24) & 63)));
        z = mfma32(pf0, b0, z); z = mfma32(pf1, b1, z); }
      f32x16 z2 = zero16();
#pragma unroll 2
      for (int ks = 0; ks < 8; ++ks) { const bf16x8 a = *(const bf16x8*)(Qs + (jt * 32 + r) * 136 + 16 * ks + 8 * h); const bf16x8 bb = *(const bf16x8*)(CT + (wave * 32 + r) * 136 + 16 * ks + 8 * h); z2 = mfma32(a, bb, z2); }
#pragma unroll
      for (int i = 0; i < 16; ++i) { const int jr = jt * 32 + crow(i, h); const float eb = __expf(bvec[jr]); const float di = __shfl(dinv, crow(i, h)); hv[jt][i] = (eb * z2[i] + z[i]) * di; }
    }
    __syncthreads();
#pragma unroll
    for (int jt = 0; jt < 2; ++jt)
#pragma unroll
      for (int i = 0; i < 16; ++i) Hout[(jt * 32 + crow(i, h)) * 256 + wave * 32 + r] = hv[jt][i];
    __syncthreads();
    { const int j = tid >> 3, seg = tid & 7; const size_t t = (size_t)t0 + j; float vals[32]; float ss = 0.f;
#pragma unroll
      for (int d = 0; d < 32; ++d) { vals[d] = Hout[j * 256 + seg * 32 + d]; ss += vals[d] * vals[d]; }
      ss += __shfl_xor(ss, 1); ss += __shfl_xor(ss, 2); ss += __shfl_xor(ss, 4);
      const float rstd = 1.0f / sqrtf(ss * (1.f / 256.f) + 1e-6f);
      u32x4 ogv[4];
#pragma unroll
      for (int d8 = 0; d8 < 4; ++d8) ogv[d8] = *(const u32x4*)(PB + t * 6144 + 5120 + hh * 256 + seg * 32 + d8 * 8);
#pragma unroll
      for (int d8 = 0; d8 < 4; ++d8) {
        const int dv = seg * 32 + d8 * 8;
        const u32x4 og = ogv[d8];
        const f32x4 n0 = *(const f32x4*)(p.ml_norm + dv), n1 = *(const f32x4*)(p.ml_norm + dv + 4);
        float ov[8];
#pragma unroll
        for (int k = 0; k < 4; ++k) { const float g0 = bflo(og[k]), g1 = bfhi(og[k]);
          const float nn0 = (2 * k < 4) ? n0[(2 * k) & 3] : n1[(2 * k) & 3], nn1 = (2 * k + 1 < 4) ? n0[(2 * k + 1) & 3] : n1[(2 * k + 1) & 3];
          ov[2 * k] = vals[d8 * 8 + 2 * k] * rstd * nn0 / (1.f + __expf(-g0)); ov[2 * k + 1] = vals[d8 * 8 + 2 * k + 1] * rstd * nn1 / (1.f + __expf(-g1)); }
        u32x4 o4; o4[0] = pk2(ov[0], ov[1]); o4[1] = pk2(ov[2], ov[3]); o4[2] = pk2(ov[4], ov[5]); o4[3] = pk2(ov[6], ov[7]);
        *(u32x4*)(MIX + t * 2048 + 1024 + hh * 256 + dv) = o4;
      }
    }
  }
}
DI int f2key(float x) { const int b = __float_as_int(x); return b ^ ((b >> 31) & 0x7fffffff); }
DI float key2f(int k) { return __int_as_float(k ^ ((k >> 31) & 0x7fffffff)); }
template <int N> DI void bitonic_sort_desc(int (&a)[N]) {
#pragma unroll
  for (int k = 2; k <= N; k <<= 1)
#pragma unroll
    for (int j = k >> 1; j > 0; j >>= 1)
#pragma unroll
      for (int i = 0; i < N; ++i) { const int l = i ^ j; if (l > i) { const bool desc = ((i & k) == 0); const int hi = max(a[i], a[l]), lo = min(a[i], a[l]); a[i] = desc ? hi : lo; a[l] = desc ? lo : hi; } }
}
template <int N> DI void bitonic_merge_desc(int (&a)[N]) {
#pragma unroll
  for (int j = N >> 1; j > 0; j >>= 1)
#pragma unroll
    for (int i = 0; i < N; ++i) { const int l = i ^ j; if (l > i) { const int hi = max(a[i], a[l]), lo = min(a[i], a[l]); a[i] = hi; a[l] = lo; } }
}
DI void top16_merge(int (&a)[16], const int (&b)[16]) {
#pragma unroll
  for (int i = 0; i < 16; ++i) a[i] = max(a[i], b[15 - i]);
  bitonic_merge_desc<16>(a);
}
DI void top16_xlane(int (&a)[16]) {
  int b[16];
#pragma unroll
  for (int i = 0; i < 16; ++i) b[i] = __shfl_xor(a[i], 32);
  top16_merge(a, b);
}
DI void topk_unit(const Params& p, const bf16_t* q0, const bf16_t* q1, size_t t, int hd, int r, int h) {
  int* IDX = (int*)(p.ws + OFF_IDX); float* GW = (float*)(p.ws + OFF_GW); float* AACC = (float*)(p.ws + OFF_AACC);
    int top[2][16];
#pragma unroll
    for (int c = 0; c < 2; ++c) {
      f32x16 acc[4];
#pragma unroll
      for (int nt = 0; nt < 4; ++nt) acc[nt] = zero16();
      const bf16_t* sk = (const bf16_t*)(p.ws + OFF_SKB) + (size_t)((hd * 2 + c) * 128) * 128;
      const bf16_t* qrow = c ? q1 : q0;
#pragma unroll 4
      for (int ks = 0; ks < 8; ++ks) {
        const bf16x8 bq = *(const bf16x8*)(qrow + 16 * ks + 8 * h);
#pragma unroll
        for (int nt = 0; nt < 4; ++nt) { const bf16x8 a = *(const bf16x8*)(sk + (nt * 32 + r) * 128 + 16 * ks + 8 * h); acc[nt] = mfma32(a, bq, acc[nt]); }
      }
      int l0[16], l1[16], l2[16], l3[16];
#pragma unroll
      for (int i = 0; i < 16; ++i) { l0[i] = (f2key(acc[0][i]) & ~127) | (crow(i, h)); l1[i] = (f2key(acc[1][i]) & ~127) | (32 + crow(i, h)); l2[i] = (f2key(acc[2][i]) & ~127) | (64 + crow(i, h)); l3[i] = (f2key(acc[3][i]) & ~127) | (96 + crow(i, h)); }
      bitonic_sort_desc<16>(l0); bitonic_sort_desc<16>(l1); bitonic_sort_desc<16>(l2); bitonic_sort_desc<16>(l3);
      top16_merge(l0, l1); top16_merge(l2, l3); top16_merge(l0, l2);
      top16_xlane(l0);
#pragma unroll
      for (int k = 0; k < 16; ++k) top[c][k] = l0[k];
    }
    float sa[16], sb[16]; int ia[16], ib[16];
#pragma unroll
    for (int k = 0; k < 16; ++k) { sa[k] = key2f(top[0][k] & ~127); ia[k] = top[0][k] & 127; sb[k] = key2f(top[1][k] & ~127); ib[k] = top[1][k] & 127; }
    constexpr int A0[25] = {0,0,0,0,0,0,0,0,0,0,0,0,0,0,0,0, 4,4,4, 6,6, 8,10,12,14};
    constexpr int B0[25] = {0,1,2,3,4,5,6,7,8,9,10,11,12,13,14,15, 0,1,2, 0,1, 0,0,0,0};
    constexpr int A1[25] = {1,1,1,1,1,1,1,1, 2,2,2,2,2, 3,3,3,3, 5,5, 7,7, 9,11,13,15};
    constexpr int B1[25] = {0,1,2,3,4,5,6,7, 0,1,2,3,4, 0,1,2,3, 0,1, 0,1, 0,0,0,0};
    int c0[16], c1[16];
#pragma unroll
    for (int k = 0; k < 32; ++k) {
      int key = (int)0x80000000;
      if (k < 25) { const float x0 = sa[A0[k]] + sb[B0[k]], x1 = sa[A1[k]] + sb[B1[k]];
        const int e0 = ia[A0[k]] * 128 + ib[B0[k]], e1 = ia[A1[k]] * 128 + ib[B1[k]];
        key = (f2key(h ? x1 : x0) & ~16383) | (h ? e1 : e0); }
      if (k < 16) c0[k] = key; else c1[k - 16] = key;
    }
    bitonic_sort_desc<16>(c0); bitonic_sort_desc<16>(c1);
    top16_merge(c0, c1);
    top16_xlane(c0);
    float fv[16]; int fe[16];
#pragma unroll
    for (int k = 0; k < 16; ++k) { fv[k] = key2f(c0[k] & ~16383); fe[k] = c0[k] & 16383; }
    const float mxv = fv[0];
    float sum = 0.f;
#pragma unroll
    for (int k = 0; k < 16; ++k) { fv[k] = expf(fv[k] - mxv); sum += fv[k]; }
    const float isum = 1.0f / sum;
#pragma unroll
    for (int m = 0; m < 4; ++m) { if (h == 0) {
        i32x4 e4; e4[0] = fe[4 * m]; e4[1] = fe[4 * m + 1]; e4[2] = fe[4 * m + 2]; e4[3] = fe[4 * m + 3];
        f32x4 g4; g4[0] = fv[4 * m] * isum; g4[1] = fv[4 * m + 1] * isum; g4[2] = fv[4 * m + 2] * isum; g4[3] = fv[4 * m + 3] * isum;
        *(i32x4*)(IDX + t * 128 + hd * 16 + 4 * m) = e4; *(f32x4*)(GW + t * 128 + hd * 16 + 4 * m) = g4; *(f32x4*)(AACC + t * 128 + hd * 16 + 4 * m) = (f32x4){0.f, 0.f, 0.f, 0.f}; } }
}
DI void phase_topk(const Params& p, int bid, int nblk, int tid) {
  asm volatile("" : "+v"(tid));
  const int lane = tid & 63, wave = tid >> 6, r = lane & 31, h = lane >> 5;
  const bf16_t* QP = (const bf16_t*)(p.ws + OFF_QP);
  if (!(wave & 4)) convert_peer_rows(p, bid * 8 + wave, nblk * 8, lane);
  for (int unit = bid * 8 + wave; unit < 2048; unit += nblk * 8) {
    const int tt = unit >> 3, hd = unit & 7;
    const size_t t = (size_t)tt * 32 + r;
    topk_unit(p, QP + t * 2048 + hd * 256, QP + t * 2048 + hd * 256 + 128, t, hd, r, h);
  }
  if (wave & 4) convert_peer_rows(p, bid * 8 + wave, nblk * 8, lane);
}
struct EpiTopk {
  static constexpr bool PERM = true, AFTER_DRAIN = true;
  const Params* pp; int bid, nblk;
  DI void fused(const f32x4 (&acc)[2][2][4][2], const pg8::Unit& u, int wr, int wc, int fr, int fq, PG8_LAS unsigned char* ldsp, int wid, int lane) const {
    bf16_t* Qt = (bf16_t*)(unsigned char*)ldsp;
#pragma unroll
    for (int ai = 0; ai < 2; ++ai)
#pragma unroll
      for (int m = 0; m < 4; ++m) {
        const int row = ai * 128 + wr * 64 + m * 16 + fr;
#pragma unroll
        for (int bj = 0; bj < 2; ++bj) { const f32x4 v0 = acc[ai][bj][m][0], v1 = acc[ai][bj][m][1]; u32x4 o; o[0] = pk2(v0[0], v0[1]); o[1] = pk2(v0[2], v0[3]); o[2] = pk2(v1[0], v1[1]); o[3] = pk2(v1[2], v1[3]);
          *(u32x4*)(Qt + row * 264 + bj * 128 + wc * 32 + 8 * fq) = o; }
      }
    __syncthreads();
    const Params& p = *pp;
    const int r = lane & 31, h = lane >> 5;
    if (!(wid & 4)) convert_peer_rows(p, bid * 8 + wid, nblk * 8, lane);
    const bf16_t* q0 = Qt + (32 * wid + r) * 264;
    topk_unit(p, q0, q0 + 128, (size_t)u.pm * 256 + 32 * wid + r, u.pn, r, h);
    if (wid & 4) convert_peer_rows(p, bid * 8 + wid, nblk * 8, lane);
  }
};
DI float gelu_exact(float x) { return 0.5f * x * (1.0f + erff(x * 0.70710678118654752f)); }
DI float reduce16(const float (&v)[16], int c) {
  float a8[8], a4[4], a2[2];
  const bool b8 = (c & 8) != 0, b4 = (c & 4) != 0, b2 = (c & 2) != 0, b1 = (c & 1) != 0;
#pragma unroll
  for (int j = 0; j < 8; ++j) { const float send = b8 ? v[j] : v[j + 8], keep = b8 ? v[j + 8] : v[j]; a8[j] = keep + __shfl_xor(send, 8); }
#pragma unroll
  for (int j = 0; j < 4; ++j) { const float send = b4 ? a8[j] : a8[j + 4], keep = b4 ? a8[j + 4] : a8[j]; a4[j] = keep + __shfl_xor(send, 4); }
#pragma unroll
  for (int j = 0; j < 2; ++j) { const float send = b2 ? a4[j] : a4[j + 2], keep = b2 ? a4[j + 2] : a4[j]; a2[j] = keep + __shfl_xor(send, 2); }
  const float send = b1 ? a2[0] : a2[1], keep = b1 ? a2[1] : a2[0];
  return keep + __shfl_xor(send, 1);
}
DI void phase_gA(const Params& p, int gi, int nblk, int tid) {
  const int lane = tid & 63, wave = tid >> 6, c = lane & 15, es = lane >> 4;
  const int NG = nblk >> 3, sl = gi & 7, tr = gi >> 3;
  const bf16_t* HB = (const bf16_t*)(p.ws + OFF_HB); const unsigned char* PU8 = (const unsigned char*)(p.ws + OFF_PU);
  const int* IDX = (const int*)(p.ws + OFF_IDX); float* AACC = (float*)(p.ws + OFF_AACC);
  const unsigned char* PUs = PU8 + (size_t)sl * 16384 * 256;
  const int tstep = NG * 8;
  int tcur = tr * 8 + wave;
  if (tcur >= T_) return;
  int ex[32]; u32x4 hraw[2];
#pragma unroll
  for (int m = 0; m < 8; ++m) { const i32x4 q4 = *(const i32x4*)(IDX + (unsigned)(tcur * 128 + 32 * es + 4 * m)); ex[4 * m] = q4[0]; ex[4 * m + 1] = q4[1]; ex[4 * m + 2] = q4[2]; ex[4 * m + 3] = q4[3]; }
  hraw[0] = *(const u32x4*)(HB + (size_t)tcur * 2048 + sl * 256 + c * 16); hraw[1] = *(const u32x4*)(HB + (size_t)tcur * 2048 + sl * 256 + c * 16 + 8);
  for (int t = tcur; t < T_; t += tstep) {
    const int tn = (t + tstep < T_) ? t + tstep : t;
    f32x2 hs[8];
#pragma unroll
    for (int q = 0; q < 2; ++q)
#pragma unroll
      for (int k = 0; k < 4; ++k) { hs[q * 4 + k][0] = bflo(hraw[q][k]); hs[q * 4 + k][1] = bfhi(hraw[q][k]); }
    int exn[32];
#pragma unroll
    for (int bt = 0; bt < 2; ++bt) {
      float v[16];
      u32x4 sg[16];
#pragma unroll
      for (int i = 0; i < 16; ++i) sg[i] = *(const u32x4*)(PUs + (unsigned)(ex[16 * bt + i] * 256 + c * 16));
      if (bt == 0) {
#pragma unroll
        for (int m = 0; m < 8; ++m) { const i32x4 q4 = *(const i32x4*)(IDX + (unsigned)(tn * 128 + 32 * es + 4 * m)); exn[4 * m] = q4[0]; exn[4 * m + 1] = q4[1]; exn[4 * m + 2] = q4[2]; exn[4 * m + 3] = q4[3]; }
        hraw[0] = *(const u32x4*)(HB + (size_t)tn * 2048 + sl * 256 + c * 16); hraw[1] = *(const u32x4*)(HB + (size_t)tn * 2048 + sl * 256 + c * 16 + 8);
      }
#pragma unroll
      for (int i = 0; i < 16; ++i) {
        f32x2 d2 = {0.f, 0.f};
#pragma unroll
        for (int dw = 0; dw < 4; ++dw) { const f32x2 lo = __builtin_amdgcn_cvt_pk_f32_fp8((int)sg[i][dw], false), hi = __builtin_amdgcn_cvt_pk_f32_fp8((int)sg[i][dw], true);
          d2 = __builtin_elementwise_fma(lo, hs[dw * 2], d2); d2 = __builtin_elementwise_fma(hi, hs[dw * 2 + 1], d2); }
        v[i] = d2[0] + d2[1];
      }
      const float tot = reduce16(v, c);
      __hip_atomic_fetch_add(AACC + (size_t)t * 128 + 32 * es + 16 * bt + c, tot, __ATOMIC_RELAXED, __HIP_MEMORY_SCOPE_AGENT);
    }
#pragma unroll
    for (int i = 0; i < 32; ++i) ex[i] = exn[i];
  }
}
DI void phase_gB(const Params& p, unsigned char* lds, int gi, int nblk, int tid) {
  const int lane = tid & 63, wave = tid >> 6, c = lane & 15, es = lane >> 4;
  const int NG = nblk >> 3, sl = gi & 7, tr = gi >> 3;
  const unsigned char* PV8 = (const unsigned char*)(p.ws + OFF_PV);
  const float* SU = (const float*)(p.ws + OFF_SU); const float* SV = (const float*)(p.ws + OFF_SV);
  const int* IDX = (const int*)(p.ws + OFF_IDX); const float* GW = (const float*)(p.ws + OFF_GW);
  const float* AACC = (const float*)(p.ws + OFF_AACC); bf16_t* Y = (bf16_t*)(p.ws + OFF_Y);
  float* wl = (float*)(lds + wave * 1024); int* el = (int*)(lds + wave * 1024 + 512);
  const unsigned char* PVs = PV8 + (size_t)sl * 16384 * 256;
  const int tstep = NG * 8;
  int t0 = tr * 8 + wave;
  if (t0 >= T_) return;
  float pa[2], pg[2], psu[2], psv[2]; int pe[2];
#pragma unroll
  for (int hf = 0; hf < 2; ++hf) { const unsigned k = (unsigned)(t0 * 128 + lane + 64 * hf); pa[hf] = AACC[k]; pe[hf] = IDX[k]; pg[hf] = GW[k]; }
#pragma unroll
  for (int hf = 0; hf < 2; ++hf) { const f32x2 sc2 = *(const f32x2*)(SU + 2 * pe[hf]); psu[hf] = sc2[0]; psv[hf] = sc2[1]; }
  for (int t = t0; t < T_; t += tstep) {
    const int tn = (t + tstep < T_) ? t + tstep : t;
#pragma unroll
    for (int hf = 0; hf < 2; ++hf) { const int k = lane + 64 * hf; wl[k] = pg[hf] * gelu_exact(pa[hf] * psu[hf]) * psv[hf]; el[k] = pe[hf]; }
    LDS_WAIT();
#pragma unroll
    for (int hf = 0; hf < 2; ++hf) { const unsigned k = (unsigned)(tn * 128 + lane + 64 * hf); pa[hf] = AACC[k]; pe[hf] = IDX[k]; pg[hf] = GW[k]; }
    f32x2 y2[8];
#pragma unroll
    for (int j = 0; j < 8; ++j) y2[j] = (f32x2){0.f, 0.f};
#pragma unroll
    for (int bt = 0; bt < 2; ++bt) {
      u32x4 sg[16]; float wv[16];
#pragma unroll
      for (int i = 0; i < 16; ++i) { const int k = 64 * bt + 4 * i + es; const int e = el[k]; wv[i] = wl[k]; sg[i] = *(const u32x4*)(PVs + (unsigned)(e * 256 + c * 16)); }
#pragma unroll
      for (int i = 0; i < 16; ++i) { const f32x2 w2 = {wv[i], wv[i]};
#pragma unroll
        for (int dw = 0; dw < 4; ++dw) { const f32x2 lo = __builtin_amdgcn_cvt_pk_f32_fp8((int)sg[i][dw], false), hi = __builtin_amdgcn_cvt_pk_f32_fp8((int)sg[i][dw], true);
          y2[dw * 2] = __builtin_elementwise_fma(w2, lo, y2[dw * 2]); y2[dw * 2 + 1] = __builtin_elementwise_fma(w2, hi, y2[dw * 2 + 1]); } }
      if (bt == 0) {
#pragma unroll
        for (int hf = 0; hf < 2; ++hf) { const f32x2 sc2 = *(const f32x2*)(SU + 2 * pe[hf]); psu[hf] = sc2[0]; psv[hf] = sc2[1]; }
      }
    }
    float ys[16];
#pragma unroll
    for (int j = 0; j < 8; ++j) { ys[2 * j] = y2[j][0]; ys[2 * j + 1] = y2[j][1]; }
#pragma unroll
    for (int j = 0; j < 16; ++j) { ys[j] += __shfl_xor(ys[j], 16); ys[j] += __shfl_xor(ys[j], 32); }
    if (es == 0) { bf16_t* yo = Y + (size_t)t * 2048 + sl * 256 + c * 16;
#pragma unroll
      for (int q = 0; q < 2; ++q) { u32x4 o; o[0] = pk2(ys[q * 8], ys[q * 8 + 1]); o[1] = pk2(ys[q * 8 + 2], ys[q * 8 + 3]); o[2] = pk2(ys[q * 8 + 4], ys[q * 8 + 5]); o[3] = pk2(ys[q * 8 + 6], ys[q * 8 + 7]); *(u32x4*)(yo + q * 8) = o; } }
    LDS_WAIT();
  }
}
DI void phase_final(const Params& p, int bid, int nblk, int tid) {
  const int lane = tid & 63, wave = tid >> 6;
  const float* X1 = (const float*)(p.ws + OFF_X1); const float* MOD = (const float*)(p.ws + OFF_MOD); const bf16_t* Y = (const bf16_t*)(p.ws + OFF_Y);
  for (int t = bid * 8 + wave; t < T_; t += nblk * 8) {
    const int b = t >> 11;
    const float* gt = MOD + b * 16384 + 5 * 2048; const float* sho = MOD + b * 16384 + 12288; const float* sco = sho + 2048;
    f32x4 v[8]; float ss = 0.f;
#pragma unroll
    for (int j = 0; j < 8; ++j) { const int e = j * 256 + lane * 4; const f32x4 xv = *(const f32x4*)(X1 + (size_t)t * 2048 + e), g4 = *(const f32x4*)(gt + e); const u32x2 yb = *(const u32x2*)(Y + (size_t)t * 2048 + e); f32x4 yv; yv[0] = bflo(yb[0]); yv[1] = bfhi(yb[0]); yv[2] = bflo(yb[1]); yv[3] = bfhi(yb[1]);
      v[j] = xv + g4 * yv; ss += v[j][0] * v[j][0] + v[j][1] * v[j][1] + v[j][2] * v[j][2] + v[j][3] * v[j][3]; }
    ss = wave_sum(ss);
    const float rstd = 1.0f / sqrtf(ss * (1.f / 2048.f) + 1e-6f);
#pragma unroll
    for (int j = 0; j < 8; ++j) { const int e = j * 256 + lane * 4; const f32x4 gf = *(const f32x4*)(p.g_final + e), s4 = *(const f32x4*)(sco + e), h4 = *(const f32x4*)(sho + e);
      v[j] = v[j] * rstd * gf * (1.f + s4) + h4; }
#pragma unroll
    for (int j = 0; j < 8; ++j) *(f32x4*)(p.out + (size_t)t * 2048 + j * 256 + lane * 4) = v[j];
  }
}
#define XB_TMO      128
#define XB_XCNT(j)  (256  + 64 * (j))
#define XB_XSUB(j)  (1280 + 64 * (j))
#define XB_XGEN(j)  (2304 + 64 * (j))
#define XB_TOP      3328
#define XB_TOPGEN   3392
#define XB_SPIN_CAP (1u << 20)
#define XB_LAS __attribute__((address_space(3)))
DI unsigned xb_ld(unsigned* p)              { return __hip_atomic_load(p, __ATOMIC_RELAXED, __HIP_MEMORY_SCOPE_AGENT); }
DI unsigned xb_add(unsigned* p, unsigned v) { return __hip_atomic_fetch_add(p, v, __ATOMIC_RELAXED, __HIP_MEMORY_SCOPE_AGENT); }
DI unsigned xb_xcc_id() { return (unsigned)__builtin_amdgcn_s_getreg((3 << 11) | 20) & 0xFu; }
#define XB_SPIN(cond, bar) do { unsigned _sp = 0; while (cond) { __builtin_amdgcn_s_sleep(1); \
    if ((++_sp & 255u) == 0u) { if (xb_ld(&(bar)[XB_TMO])) break; if (_sp > XB_SPIN_CAP) { atomicAdd(&(bar)[XB_TMO], 1u); break; } } } } while (0)
struct XcdBarrier { unsigned* bar; unsigned x; volatile XB_LAS unsigned* st; };
DI XcdBarrier xcd_barrier_post(unsigned* bar, volatile XB_LAS unsigned* st) {
    XcdBarrier b; b.bar = bar; b.x = xb_xcc_id(); b.st = st;
    if (threadIdx.x == 0) st[2] = xb_add(&bar[XB_XCNT(b.x)], 1u);
    return b;
}
DI void xcd_barrier_complete(unsigned* bar, unsigned x, unsigned& nloc, unsigned& nx) {
    const unsigned G = gridDim.x * gridDim.y * gridDim.z;
    unsigned sum, cnt, mine, sp = 0u;
    for (;;) {
        sum = 0u; cnt = 0u; mine = 0u;
#pragma unroll
        for (unsigned j = 0; j < 16; ++j) { const unsigned c = xb_ld(&bar[XB_XCNT(j)]); sum += c; cnt += (c > 0u) ? 1u : 0u; mine = (j == x) ? c : mine; }
        if (sum == G) break;
        __builtin_amdgcn_s_sleep(1);
        if ((++sp & 255u) == 0u) { if (xb_ld(&bar[XB_TMO])) break; if (sp > XB_SPIN_CAP) { atomicAdd(&bar[XB_TMO], 1u); break; } }
    }
    nloc = mine > 0u ? mine : 1u; nx = cnt > 0u ? cnt : 1u;
}
DI void xcd_barrier(const XcdBarrier& b) {
    asm volatile("s_waitcnt vmcnt(0)" ::: "memory");
    __syncthreads();
    if (threadIdx.x == 0) {
        unsigned* bar = b.bar;
        __builtin_amdgcn_s_waitcnt(0);
        unsigned nloc = b.st[0], nx = b.st[1];
        if (nloc == 0u) { xcd_barrier_complete(bar, b.x, nloc, nx); b.st[0] = nloc; b.st[1] = nx; }
        const unsigned old = xb_add(&bar[XB_XSUB(b.x)], 1u);
        const unsigned gen = old / nloc;
        if (old + 1u == (gen + 1u) * nloc) {
            __builtin_amdgcn_fence(__ATOMIC_RELEASE, "agent");
            asm volatile("s_waitcnt vmcnt(0)" ::: "memory");
            const unsigned og = xb_add(&bar[XB_TOP], 1u);
            const unsigned tg = og / nx;
            if (og + 1u == (tg + 1u) * nx) xb_add(&bar[XB_TOPGEN], 1u);
            else XB_SPIN(xb_ld(&bar[XB_TOPGEN]) == tg, bar);
            __builtin_amdgcn_fence(__ATOMIC_ACQUIRE, "agent");
            xb_add(&bar[XB_XGEN(b.x)], 1u);
            asm volatile("s_waitcnt vmcnt(0)" ::: "memory");
        } else {
            XB_SPIN(xb_ld(&bar[XB_XGEN(b.x)]) == gen, bar);
            __builtin_amdgcn_fence(__ATOMIC_ACQUIRE, "agent");
            asm volatile("s_waitcnt vmcnt(0)" ::: "memory");
        }
    }
    __syncthreads();
}
#ifndef ONLY
#define ONLY -1
#endif
#define PH(k) ((ONLY < 0 || ONLY == (k)) && ph == (k))
__global__ void __launch_bounds__(512) mega(Params p, int ph_lo, int ph_hi) {
  extern __shared__ __attribute__((aligned(16))) unsigned char shm[];
  cg::grid_group grid = cg::this_grid();
  const int bid = blockIdx.x, nblk = gridDim.x, tid = threadIdx.x;
  volatile XB_LAS unsigned* xst = (volatile XB_LAS unsigned*)((PG8_LAS unsigned char*)shm + (LDS_BYTES - 16));
  if (tid < 4) xst[tid] = 0u;
  __syncthreads();
  const XcdBarrier xb = xcd_barrier_post((unsigned*)(p.ws + OFF_CTL), xst);
  if (ph_lo > 100) grid.sync();
#ifndef REPMASK
#define REPMASK 0
#endif
#define RUNPH(k, ...) if ((ONLY < 0 || ONLY == (k)) && ph_lo <= (k) && (k) <= ph_hi) { __VA_ARGS__ } if (((REPMASK >> (k)) & 1) && ph_lo <= (k) && (k) <= ph_hi) { __syncthreads(); __VA_ARGS__ } if (ph_lo <= (k) && (k) < ph_hi) xcd_barrier(xb);
  RUNPH(0, phase0(p, shm, bid, nblk, tid);)
  RUNPH(1, phase_norm<true>(p, p.x, p.g_mix, 0, 1, bid, nblk, tid, shm);)
  RUNPH(2, pg8::Gemm g{(const bf16_t*)(p.ws + OFF_HB), (const bf16_t*)(p.ws + OFF_WINT), 8192, 6144, 2048}; pg8::StaticOrder S; S.init(8192, 6144, nblk, bid);
      EpiProj E{(bf16_t*)(p.ws + OFF_PB)};
      pg8::gemm_phase<EpiProj, pg8::StaticOrder, false>((PG8_LAS unsigned char*)shm, g, S, E, nullptr);)
  RUNPH(3, phase_attn(p, shm, bid, nblk, tid); if ((REPMASK >> 13) & 1) { __syncthreads(); phase_attn(p, shm, bid, nblk, tid); } phase_mlA(p, shm, bid, nblk, tid); if ((REPMASK >> 14) & 1) { __syncthreads(); phase_mlA(p, shm, bid, nblk, tid); })
  RUNPH(4, phase_scan(p, bid, nblk, tid);)
  RUNPH(5, phase_mlC(p, shm, bid, nblk, tid);)
  RUNPH(6, pg8::Gemm g{(const bf16_t*)(p.ws + OFF_MIX), (const bf16_t*)(p.ws + OFF_WOUTT), 8192, 2048, 2048}; pg8::StaticOrder S; S.init(8192, 2048, nblk, bid);
      EpiRes E{(float*)(p.ws + OFF_X1), p.x, (const float*)(p.ws + OFF_MOD)};
      pg8::gemm_phase<EpiRes, pg8::StaticOrder, false>((PG8_LAS unsigned char*)shm, g, S, E, nullptr);)
  RUNPH(7, phase_norm<false>(p, (const float*)(p.ws + OFF_X1), p.g_ffn, 3, 4, bid, nblk, tid, shm);)
  if (nblk == 256) {
    RUNPH(8, pg8::Gemm g{(const bf16_t*)(p.ws + OFF_HB), (const bf16_t*)(p.ws + OFF_WPQT), 8192, 2048, 2048}; pg8::StaticOrder S; S.init(8192, 2048, nblk, bid);
        EpiTopk E{&p, bid, nblk};
        pg8::gemm_phase<EpiTopk, pg8::StaticOrder, false>((PG8_LAS unsigned char*)shm, g, S, E, nullptr);)
  } else {
    RUNPH(8, pg8::Gemm g{(const bf16_t*)(p.ws + OFF_HB), (const bf16_t*)(p.ws + OFF_WPQT), 8192, 2048, 2048}; pg8::StaticOrder S; S.init(8192, 2048, nblk, bid);
        EpiBf E{(bf16_t*)(p.ws + OFF_QP)};
        pg8::gemm_phase<EpiBf, pg8::StaticOrder, false>((PG8_LAS unsigned char*)shm, g, S, E, nullptr);)
    RUNPH(9, phase_topk(p, bid, nblk, tid);)
  }
  RUNPH(10, phase_gA(p, bid, nblk, tid);)
  RUNPH(11, phase_gB(p, shm, bid, nblk, tid);)
  RUNPH(12, phase_final(p, bid, nblk, tid);)

}
extern "C" void kernel_launch(void* const* d_in, const int* in_sizes, int n_in, void* d_out, int out_size, void* d_ws, size_t ws_size, hipStream_t stream) {
  (void)in_sizes; (void)n_in; (void)out_size;
  if (ws_size < WS_TOTAL) { fprintf(stderr, "kernel_launch: workspace too small (%zu < %zu)\n", ws_size, (size_t)WS_TOTAL); return; }
  Params p{};
  const float** f = (const float**)&p;
  for (int i = 0; i < 25; ++i) f[i] = (const float*)d_in[i];
  p.out = (float*)d_out; p.ws = (unsigned char*)d_ws;
  static bool attr_set = false;
  if (!attr_set) { if (hipFuncSetAttribute((const void*)mega, hipFuncAttributeMaxDynamicSharedMemorySize, LDS_BYTES) != hipSuccess) { fprintf(stderr, "kernel_launch: hipFuncSetAttribute failed\n"); return; } attr_set = true; }
  (void)hipMemsetAsync((unsigned char*)d_ws + OFF_CTL, 0, 16384, stream);
    int lo = 0, hi = 12;
  void* args[] = {&p, &lo, &hi};
  static int grid_blocks = 0;
  if (!grid_blocks) { int dev = 0, cus = 0, per_cu = 0; (void)hipGetDevice(&dev); (void)hipDeviceGetAttribute(&cus, hipDeviceAttributeMultiprocessorCount, dev);
    (void)hipOccupancyMaxActiveBlocksPerMultiprocessor(&per_cu, (const void*)mega, 512, LDS_BYTES);
    int g = cus * (per_cu > 0 ? per_cu : 1); if (g > 256) g = 256; g &= ~7; if (g < 8) g = 8; grid_blocks = g; }
  hipError_t e = hipLaunchCooperativeKernel((const void*)mega, dim3(grid_blocks), dim3(512), args, LDS_BYTES, stream);
  if (e != hipSuccess) fprintf(stderr, "cooperative launch failed: %s\n", hipGetErrorString(e));
}
```

```cpp
#include <hip/hip_runtime.h>
#include <hip/hip_cooperative_groups.h>
#include <cstdio>
#include <cstdint>
namespace cg = cooperative_groups;
#define DI __device__ __forceinline__
namespace pg8 {
#define PG8_LAS __attribute__((address_space(3)))
typedef unsigned short bf16_t;
typedef short bf16x8 __attribute__((ext_vector_type(8)));
typedef float f32x4 __attribute__((ext_vector_type(4)));
typedef unsigned u32x4 __attribute__((ext_vector_type(4)));
constexpr int BM = 256, BK = 64, HALF = 128, HTB = HALF * BK * 2  , STAGE_BYTES = 8 * HTB, NXCD = 8, WGM = 8;

__host__ __device__ __forceinline__ int lds_byte(int r, int c) { const int st = (r >> 4) * 2 + (c >> 5), rr = r & 15, cc = c & 31, ob = rr * 64 + cc * 2; return st * 1024 + (ob ^ (((ob >> 9) & 1) << 5)); }
__host__ __device__ __forceinline__ void stage_rc(int b, int& R, int& C) { const int st = b / 1024, sb = b % 1024, swz = sb ^ (((sb >> 9) & 1) << 5); R = (st >> 1) * 16 + swz / 64; C = (st & 1) * 32 + (swz % 64) / 2; }
__host__ __device__ __forceinline__ int perm32(int rho) { const int n = rho >> 4, i = rho & 15; return 8 * (i >> 2) + 4 * n + (i & 3); }

struct Unit { int pm, pn; };
struct Gemm { const bf16_t* A; const bf16_t* Bt; int M, N, K; };

struct StaticOrder {
    int nM, nN, nwg, G, c;
    __host__ __device__ void init(int M, int N, int G_, int c_) { nM = M / BM; nN = N / BM; nwg = nM * nN; G = G_; c = c_; }
    __host__ __device__ bool next(int i, Unit& u) const {
        const long L = (long)i * G + c; if (L >= nwg) return false;
        int wgid = (int)L; { const int q = nwg / NXCD, r = nwg % NXCD, xcd = wgid % NXCD, off = wgid / NXCD; wgid = (xcd < r ? xcd * (q + 1) : r * (q + 1) + (xcd - r) * q) + off; }
        const int nig = WGM * nN, gid = wgid / nig, fm = gid * WGM, gsz = (nM - fm) < WGM ? (nM - fm) : WGM;
        u.pm = fm + ((wgid % nig) % gsz); u.pn = (wgid % nig) / gsz; return true;
    }
    __device__ __forceinline__ void a_ready(const Unit&) const {}
    __device__ __forceinline__ void done(const Unit&) const {}
};
template <class Epi, class Sched, bool STAMP = false>
__device__ __forceinline__ void gemm_phase(PG8_LAS unsigned char* lds, const Gemm g, const Sched& S, const Epi& E, unsigned long long* stamps) {
    const int tid = threadIdx.x, wid = __builtin_amdgcn_readfirstlane(tid >> 6), lane = tid & 63, wr = wid >> 2, wc = wid & 3, fr = lane & 15, fq = lane >> 4;
    const int K = g.K, nt = K / BK;
    int ts_lo = 0, ts_hi = 0, nts = 0; const unsigned long long rt_entry = STAMP ? (unsigned long long)wall_clock64() : 0ull;
#define PG8_STAMP() do { if (STAMP && wid == 0 && nts < 64) { const unsigned long long _c = (unsigned long long)clock64(); \
        ts_lo = (lane == nts) ? (int)(unsigned)_c : ts_lo; ts_hi = (lane == nts) ? (int)(unsigned)(_c >> 32) : ts_hi; ++nts; } } while (0)
    PG8_STAMP();
    unsigned voffA[2], voffB[2];
#pragma unroll
    for (int i = 0; i < 2; ++i) { int R, C; stage_rc(tid * 16 + i * 8192, R, C); const int Rb = Epi::PERM ? ((R & ~31) + perm32(R & 31)) : R;
        voffA[i] = (unsigned)(R * K + C) * 2u; voffB[i] = (unsigned)(Rb * K + C) * 2u; }
    const size_t kstep = (size_t)(BK * 2);
    const size_t hstep = (size_t)HALF * K * 2;
    const size_t tstep = 2 * hstep;
    const unsigned ldsw = (unsigned)wid * 1024u;
    const int aoff = lds_byte(wr * 64 + fr, fq * 8), boff = lds_byte(wc * 32 + fr, fq * 8);
#define PG8_SA(b, h) (((b) * 2 + (h)) * HTB)
#define PG8_SB(b, h) ((4 + (b) * 2 + (h)) * HTB)
#define PG8_STAGE(bufoff, gbase, voff) do { _Pragma("unroll") for (int _i = 0; _i < 2; ++_i) \
        __builtin_amdgcn_global_load_lds((const unsigned*)((const char*)(gbase) + (voff)[_i]), (PG8_LAS unsigned*)(lds + (bufoff) + ldsw + _i * 8192), 16, 0, 0); } while (0)
#define PG8_LDA(dst, b, h) do { _Pragma("unroll") for (int m = 0; m < 4; ++m) _Pragma("unroll") for (int k = 0; k < 2; ++k) dst[m][k] = *(const PG8_LAS bf16x8*)(lds + PG8_SA(b, h) + aoff + m * 2048 + k * 1024); } while (0)
#define PG8_LDB(dst, b, h) do { _Pragma("unroll") for (int n = 0; n < 2; ++n) _Pragma("unroll") for (int k = 0; k < 2; ++k) dst[n][k] = *(const PG8_LAS bf16x8*)(lds + PG8_SB(b, h) + boff + n * 2048 + k * 1024); } while (0)
#define PG8_MMA(ai, bj, At, Bt) do { __builtin_amdgcn_s_setprio(1); _Pragma("unroll") for (int m = 0; m < 4; ++m) _Pragma("unroll") for (int n = 0; n < 2; ++n) _Pragma("unroll") for (int k = 0; k < 2; ++k) \
        acc[ai][bj][m][n] = __builtin_amdgcn_mfma_f32_16x16x32_bf16(Bt[n][k], At[m][k], acc[ai][bj][m][n], 0, 0, 0); __builtin_amdgcn_s_setprio(0); } while (0)
#define PG8_WAIT_V(n) asm volatile("s_waitcnt vmcnt(" #n ")" ::: "memory")
#define PG8_WAIT_L(n) asm volatile("s_waitcnt lgkmcnt(" #n ")" ::: "memory")
#define PG8_BAR __builtin_amdgcn_s_barrier()
#define PG8_SCHED __builtin_amdgcn_sched_barrier(0)
    Unit cur, nxt; int ui = 0;
    if (!S.next(0, cur)) return;
    f32x4 acc[2][2][4][2];
#pragma unroll
    for (int a = 0; a < 2; ++a)
#pragma unroll
        for (int b = 0; b < 2; ++b)
#pragma unroll
            for (int m = 0; m < 4; ++m)
#pragma unroll
                for (int n = 0; n < 2; ++n) acc[a][b][m][n] = (f32x4){0.f, 0.f, 0.f, 0.f};
    bf16x8 At[4][2], B0[2][2], B1[2][2];
    const char* cA = (const char*)g.A + (size_t)cur.pm * tstep; const char* cB = (const char*)g.Bt + (size_t)cur.pn * tstep;
    S.a_ready(cur);
    PG8_STAGE(PG8_SB(0, 0), cB, voffB); PG8_STAGE(PG8_SA(0, 0), cA, voffA); PG8_STAGE(PG8_SB(0, 1), cB + hstep, voffB); PG8_STAGE(PG8_SA(0, 1), cA + hstep, voffA);
    if (wr == 1) PG8_BAR;
    PG8_WAIT_V(4); PG8_BAR;
    PG8_STAGE(PG8_SB(1, 0), cB + kstep, voffB); PG8_STAGE(PG8_SA(1, 0), cA + kstep, voffA); PG8_STAGE(PG8_SB(1, 1), cB + hstep + kstep, voffB);
    PG8_WAIT_V(6); PG8_BAR;
    PG8_STAMP();
    for (;;) {
        const bool has_next = S.next(ui + 1, nxt);
        const char* nA = has_next ? (const char*)g.A + (size_t)nxt.pm * tstep : cA; const char* nB = has_next ? (const char*)g.Bt + (size_t)nxt.pn * tstep : cB;
        for (int t = 0; t < nt; t += 2) {
            const bool last = (t == nt - 2);
            const char* a1 = cA + (size_t)(t + 1) * kstep;
            const char* a2 = last ? nA : cA + (size_t)(t + 2) * kstep; const char* b2 = last ? nB : cB + (size_t)(t + 2) * kstep;
            const char* a3 = a2 + kstep; const char* b3 = b2 + kstep;
            if (last && has_next) S.a_ready(nxt);
            PG8_LDB(B0, 0, 0); PG8_SCHED; PG8_LDA(At, 0, 0); PG8_STAGE(PG8_SA(1, 1), a1 + hstep, voffA);
            PG8_WAIT_L(8); PG8_BAR; PG8_WAIT_L(0); PG8_MMA(0, 0, At, B0); PG8_BAR; PG8_SCHED;
            PG8_LDB(B1, 0, 1); PG8_STAGE(PG8_SB(0, 0), b2, voffB);
            PG8_BAR; PG8_WAIT_L(0); PG8_MMA(0, 1, At, B1); PG8_BAR;
            PG8_LDA(At, 0, 1); PG8_STAGE(PG8_SA(0, 0), a2, voffA);
            PG8_BAR; PG8_WAIT_L(0); PG8_MMA(1, 0, At, B0); PG8_BAR; PG8_SCHED;
            PG8_STAGE(PG8_SB(0, 1), b2 + hstep, voffB);
            PG8_WAIT_V(6); PG8_BAR; PG8_MMA(1, 1, At, B1); PG8_BAR;
            PG8_LDB(B0, 1, 0); PG8_SCHED; PG8_LDA(At, 1, 0); PG8_STAGE(PG8_SA(0, 1), a2 + hstep, voffA);
            PG8_WAIT_L(8); PG8_BAR; PG8_WAIT_L(0); PG8_MMA(0, 0, At, B0); PG8_BAR; PG8_SCHED;
            PG8_LDB(B1, 1, 1); PG8_STAGE(PG8_SB(1, 0), b3, voffB);
            PG8_BAR; PG8_WAIT_L(0); PG8_MMA(0, 1, At, B1); PG8_BAR;
            PG8_LDA(At, 1, 1); PG8_STAGE(PG8_SA(1, 0), a3, voffA);
            PG8_BAR; PG8_WAIT_L(0); PG8_MMA(1, 0, At, B0); PG8_BAR; PG8_SCHED;
            PG8_STAGE(PG8_SB(1, 1), b3 + hstep, voffB);
            PG8_WAIT_V(6); PG8_BAR; PG8_MMA(1, 1, At, B1); PG8_BAR;
        }
        PG8_STAMP();
        if constexpr (!Epi::AFTER_DRAIN) { E(acc, cur, wr, wc, fr, fq); S.done(cur); }
        PG8_STAMP();
        if (!has_next) break;
#pragma unroll
        for (int a = 0; a < 2; ++a)
#pragma unroll
            for (int b = 0; b < 2; ++b)
#pragma unroll
                for (int m = 0; m < 4; ++m)
#pragma unroll
                    for (int n = 0; n < 2; ++n) acc[a][b][m][n] = (f32x4){0.f, 0.f, 0.f, 0.f};
        cur = nxt; cA = nA; cB = nB; ++ui;
    }
    PG8_WAIT_V(0);
    if (wr == 0) PG8_BAR;
    PG8_BAR;
    if constexpr (Epi::AFTER_DRAIN) { E.fused(acc, cur, wr, wc, fr, fq, lds, wid, lane); S.done(cur); }
    PG8_STAMP();
    if (STAMP && wid == 0) { stamps[lane] = lane < nts ? (((unsigned long long)(unsigned)ts_hi << 32) | (unsigned)ts_lo) : 0ull;
        if (lane == 62) stamps[62] = rt_entry; if (lane == 63) stamps[63] = (unsigned long long)wall_clock64(); }
#undef PG8_STAMP
#undef PG8_SA
#undef PG8_SB
#undef PG8_STAGE
#undef PG8_LDA
#undef PG8_LDB
#undef PG8_MMA
#undef PG8_WAIT_V
#undef PG8_WAIT_L
#undef PG8_BAR
#undef PG8_SCHED
}
}
using pg8::bf16_t; using pg8::bf16x8; using pg8::f32x4; using pg8::u32x4;
typedef short s16x4 __attribute__((ext_vector_type(4)));
typedef float f32x16 __attribute__((ext_vector_type(16)));
typedef float f32x2 __attribute__((ext_vector_type(2)));
typedef unsigned u32x2 __attribute__((ext_vector_type(2)));
typedef int i32x4 __attribute__((ext_vector_type(4)));
typedef __bf16 bfv2 __attribute__((ext_vector_type(2)));

constexpr int T_ = 8192, D_ = 2048;
constexpr size_t OFF_CTL = 0;
constexpr size_t OFF_MOD = 16384;
constexpr size_t OFF_ROPE = OFF_MOD + 262144;
constexpr size_t OFF_WG = OFF_ROPE + 524288;
constexpr size_t OFF_GATES = OFF_WG + 65536;
constexpr size_t OFF_IDX = OFF_GATES + 262144;
constexpr size_t OFF_GW = OFF_IDX + 4194304;
constexpr size_t OFF_NST = OFF_GW + 4194304;
constexpr size_t OFF_DEC = OFF_NST + 262144;
constexpr size_t OFF_SU = OFF_DEC + 4096;
constexpr size_t OFF_SV = OFF_SU + 65536;
constexpr size_t OFF_AACC = OFF_SV + 65536;
constexpr size_t OFF_SKB = OFF_AACC + 4194304;
constexpr size_t OFF_WINT = OFF_SKB + 524288;
constexpr size_t OFF_WOUTT = OFF_WINT + 25165824;
constexpr size_t OFF_WPQT = OFF_WOUTT + 8388608;
constexpr size_t OFF_PU = OFF_WPQT + 8388608;
constexpr size_t OFF_PV = OFF_PU + 67108864;
constexpr size_t OFF_HB = OFF_PV + 67108864;
constexpr size_t OFF_PB = OFF_HB + 33554432;
constexpr size_t OFF_X1 = OFF_PB;
constexpr size_t OFF_QP = OFF_PB + 67108864;
constexpr size_t OFF_MIX = OFF_PB + 100663296;
constexpr size_t OFF_CST = OFF_MIX + 33554432;
constexpr size_t OFF_PA = OFF_QP;
constexpr size_t OFF_Y = OFF_CST;
constexpr size_t WS_TOTAL = OFF_CST + 67108864;
constexpr int LDS_BYTES = 147456;

struct Params {
  const float *x, *c, *w_ada, *b_ada, *g_mix, *w_in, *conv_w, *conv_b, *b_igate, *b_fgate,
              *lq1, *lk1, *lq2, *lk2, *da_norm, *ml_norm, *w_out, *g_ffn, *w_pq, *sub_keys,
              *peer_u, *peer_v, *w_ada_final, *b_ada_final, *g_final;
  float* out;
  unsigned char* ws;
};

DI unsigned pk2(float lo, float hi) { f32x2 v = {lo, hi}; bfv2 r = __builtin_convertvector(v, bfv2); return __builtin_bit_cast(unsigned, r); }
DI float bflo(unsigned u) { return __uint_as_float(u << 16); }
DI float bfhi(unsigned u) { return __uint_as_float(u & 0xffff0000u); }
DI float bf2f(bf16_t b) { return __uint_as_float(((unsigned)b) << 16); }
DI float wave_sum(float v) {
#pragma unroll
  for (int o = 1; o < 64; o <<= 1) v += __shfl_xor(v, o);
  return v;
}
DI f32x16 mfma32(bf16x8 a, bf16x8 b, f32x16 c) { return __builtin_amdgcn_mfma_f32_32x32x16_bf16(a, b, c, 0, 0, 0); }
DI int crow(int i, int h) { return (i & 3) + 8 * (i >> 2) + 4 * h; }
template <int S> DI bf16x8 pack8(const f32x16& x) {
  u32x4 p; p[0] = pk2(x[8 * S], x[8 * S + 1]); p[1] = pk2(x[8 * S + 2], x[8 * S + 3]); p[2] = pk2(x[8 * S + 4], x[8 * S + 5]); p[3] = pk2(x[8 * S + 6], x[8 * S + 7]);
  return __builtin_bit_cast(bf16x8, p);
}
DI bf16x8 cat4(s16x4 lo, s16x4 hi) { return __builtin_shufflevector(lo, hi, 0, 1, 2, 3, 4, 5, 6, 7); }
DI f32x16 zero16() { f32x16 z; for (int i = 0; i < 16; ++i) z[i] = 0.f; return z; }
#define LDS_WAIT() asm volatile("s_waitcnt lgkmcnt(0)" ::: "memory")
DI int newpos_in(int o) { if (o >= 2048) return o; const int hd = o >> 6, j = o & 63; return hd * 64 + (j < 32 ? 2 * j : 2 * (j - 32) + 1); }
DI void transpose_item(const float* W, int ldw, int nblk, bf16_t* WT, int K, float* scr, int item, int lane, bool perm) {
  const int kb = item / nblk, nb = item % nblk, k0 = 64 * kb, n0 = 32 * nb;
#pragma unroll 8
  for (int i = 0; i < 32; ++i) { const int kk = 2 * i + (lane >> 5); scr[kk * 33 + (lane & 31)] = W[(size_t)(k0 + kk) * ldw + n0 + (lane & 31)]; }
  LDS_WAIT();
  const int c = lane & 7;
#pragma unroll
  for (int j = 0; j < 4; ++j) { const int n = (lane >> 3) + 8 * j; const float* s = scr + (8 * c) * 33 + n;
    u32x4 o; o[0] = pk2(s[0 * 33], s[1 * 33]); o[1] = pk2(s[2 * 33], s[3 * 33]); o[2] = pk2(s[4 * 33], s[5 * 33]); o[3] = pk2(s[6 * 33], s[7 * 33]);
    const int orow = perm ? newpos_in(n0 + n) : (n0 + n);
    *(u32x4*)(WT + (size_t)orow * K + k0 + 8 * c) = o; }
  LDS_WAIT();
}
#define CPR_LOAD(dst, rowx) { const int r_ = (rowx); const float* src_ = (r_ < 16384 ? p.peer_u + (size_t)r_ * 2048 : p.peer_v + (size_t)(r_ - 16384) * 2048); \
    _Pragma("unroll") for (int j_ = 0; j_ < 8; ++j_) dst[j_] = *(const f32x4*)(src_ + (j_ >> 2) * 1024 + lane * 16 + (j_ & 3) * 4); }
DI void convert_peer_rows(const Params& p, int gw, int NGW, int lane) {
  unsigned char* PU8 = (unsigned char*)(p.ws + OFF_PU); unsigned char* PV8 = (unsigned char*)(p.ws + OFF_PV);
  float* SU = (float*)(p.ws + OFF_SU); float* SV = (float*)(p.ws + OFF_SV);
  if (gw >= 32768) return;
  f32x4 va[8], vb[8];
  CPR_LOAD(va, gw);
  CPR_LOAD(vb, (gw + NGW < 32768) ? gw + NGW : gw);
  for (int row = gw; row < 32768; row += NGW) {
    const bool isu = row < 16384; const int rr = isu ? row : row - 16384;
    f32x4 v[8]; float am = 0.f;
#pragma unroll
    for (int j = 0; j < 8; ++j) { v[j] = va[j]; va[j] = vb[j]; am = fmaxf(am, fmaxf(fmaxf(fabsf(v[j][0]), fabsf(v[j][1])), fmaxf(fabsf(v[j][2]), fabsf(v[j][3])))); }
    CPR_LOAD(vb, (row + 2 * NGW < 32768) ? row + 2 * NGW : row);
#pragma unroll
    for (int o = 1; o < 64; o <<= 1) am = fmaxf(am, __shfl_xor(am, o));
    const float sc = am > 0.f ? 448.0f / am : 1.0f, inv = am > 0.f ? am * (1.0f / 448.0f) : 1.0f;
#pragma unroll
    for (int q = 0; q < 2; ++q) { u32x4 o4;
#pragma unroll
      for (int k = 0; k < 4; ++k) { const f32x4 a = v[q * 4 + k] * sc; int r = __builtin_amdgcn_cvt_pk_fp8_f32(a[0], a[1], 0, false); r = __builtin_amdgcn_cvt_pk_fp8_f32(a[2], a[3], r, true); o4[k] = (unsigned)r; }
      *(u32x4*)((isu ? PU8 : PV8) + ((size_t)(q * 4 + (lane >> 4)) * 16384 + rr) * 256 + (lane & 15) * 16) = o4; }
    if (lane == 0) SU[2 * rr + (isu ? 0 : 1)] = inv;
  }
}
#undef CPR_LOAD
DI void phase0(const Params& p, unsigned char* lds, int bid, int nblk, int tid) {
  const int lane = tid & 63, wave = tid >> 6;
  float* MOD = (float*)(p.ws + OFF_MOD);
  float* cs = (float*)lds;
  float* red = (float*)(lds + 32768);
  for (int item = bid; item < 256; item += nblk) {
    const int col0 = item * 64;
    __syncthreads();
    for (int i = tid; i < 8192; i += 512) { const float v = p.c[i]; cs[i] = v / (1.f + expf(-v)); }
    __syncthreads();
    const int cg = tid & 15, dg = tid >> 4;
    const int col = col0 + cg * 4;
    const float* W; int ldw, wc; const float* bb;
    if (col < 12288) { W = p.w_ada; ldw = 12288; wc = col; bb = p.b_ada + col0; } else { W = p.w_ada_final; ldw = 4096; wc = col - 12288; bb = p.b_ada_final + (col0 - 12288); }
    f32x4 acc[4];
#pragma unroll
    for (int b = 0; b < 4; ++b) acc[b] = (f32x4){0.f, 0.f, 0.f, 0.f};
#pragma unroll 8
    for (int i = 0; i < 64; ++i) {
      const int d = dg * 64 + i;
      const f32x4 w = *(const f32x4*)(W + (size_t)d * ldw + wc);
#pragma unroll
      for (int b = 0; b < 4; ++b) acc[b] += cs[b * 2048 + d] * w;
    }
#pragma unroll
    for (int b = 0; b < 4; ++b) *(f32x4*)(red + (dg * 4 + b) * 64 + cg * 4) = acc[b];
    __syncthreads();
    if (tid < 256) { const int b = tid >> 6, cc = tid & 63; float sm = bb[cc];
      for (int g = 0; g < 32; ++g) sm += red[(g * 4 + b) * 64 + cc];
      MOD[b * 16384 + col0 + cc] = sm; }
  }
  __syncthreads();
  float* scr = (float*)(lds + 65536 + wave * 8448);
  const int gw = bid * 8 + wave, NGW = nblk * 8;
  constexpr int I_IN = 32 * 192, I_O = 32 * 64;
  bf16_t* WINT = (bf16_t*)(p.ws + OFF_WINT); bf16_t* WOUTT = (bf16_t*)(p.ws + OFF_WOUTT); bf16_t* WPQT = (bf16_t*)(p.ws + OFF_WPQT);
  for (int it = gw; it < I_IN + 2 * I_O; it += NGW) {
    if (it < I_IN) transpose_item(p.w_in, 6152, 192, WINT, 2048, scr, it, lane, true);
    else if (it < I_IN + I_O) transpose_item(p.w_out, 2048, 64, WOUTT, 2048, scr, it - I_IN, lane, false);
    else transpose_item(p.w_pq, 2048, 64, WPQT, 2048, scr, it - I_IN - I_O, lane, false);
  }
  {
    bf16_t* SKB = (bf16_t*)(p.ws + OFF_SKB);
    for (int i = bid * 512 + tid; i < 32768; i += nblk * 512) { const f32x4 a0 = *(const f32x4*)(p.sub_keys + (size_t)i * 8), a1 = *(const f32x4*)(p.sub_keys + (size_t)i * 8 + 4);
      u32x4 ap; ap[0] = pk2(a0[0], a0[1]); ap[1] = pk2(a0[2], a0[3]); ap[2] = pk2(a1[0], a1[1]); ap[3] = pk2(a1[2], a1[3]); *(u32x4*)(SKB + (size_t)i * 8) = ap; }
    float* WG = (float*)(p.ws + OFF_WG);
    for (int i = bid * 512 + tid; i < 16384; i += nblk * 512) { const int j = i >> 11, k = i & 2047; WG[i] = p.w_in[(size_t)k * 6152 + 6144 + j]; }
  }
}
template <bool GATES> DI void phase_norm(const Params& p, const float* src, const float* gvec, int sh_idx, int sc_idx, int bid, int nblk, int tid, unsigned char* lds) {
  const int lane = tid & 63, wave = tid >> 6;
  float* WGs = (float*)lds;
  if (GATES) {
    const float* WGg = (const float*)(p.ws + OFF_WG);
#pragma unroll
    for (int i = 0; i < 8; ++i) { const int e4 = (tid + 512 * i) * 4, j = e4 >> 11, e = e4 & 2047, r = e >> 9, ln = (e & 511) >> 3, q = (e >> 2) & 1;
      *(f32x4*)(WGs + j * 2048 + r * 512 + q * 256 + ln * 4) = *(const f32x4*)(WGg + e4); }
    __syncthreads();
  }
  float* G1s = (float*)(lds + 65536); float* SHs = (float*)(lds + 98304);
  { const float* MODg = (const float*)(p.ws + OFF_MOD);
#pragma unroll 1
    for (int i = 0; i < 4; ++i) { const int e4 = (tid + 512 * i) * 4, b = e4 >> 11, e = e4 & 2047, r = e >> 9, ln = (e & 511) >> 3, q = (e >> 2) & 1;
      const f32x4 g4 = *(const f32x4*)(gvec + e), sc4 = *(const f32x4*)(MODg + b * 16384 + sc_idx * 2048 + e), sh4 = *(const f32x4*)(MODg + b * 16384 + sh_idx * 2048 + e);
      *(f32x4*)(G1s + b * 2048 + r * 512 + q * 256 + ln * 4) = g4 * (1.f + sc4); *(f32x4*)(SHs + b * 2048 + r * 512 + q * 256 + ln * 4) = sh4; }
    __syncthreads(); }
  const float* MOD = (const float*)(p.ws + OFF_MOD);
  bf16_t* HB = (bf16_t*)(p.ws + OFF_HB);
  const float* WG = (const float*)(p.ws + OFF_WG);
  float* GT = (float*)(p.ws + OFF_GATES);
  for (int t = bid * 8 + wave; t < T_; t += nblk * 8) {
    const int b = t >> 11;
    const float* xr = src + (size_t)t * 2048;
    f32x4 v[8];
    float ss = 0.f;
#pragma unroll
    for (int r = 0; r < 4; ++r) {
      v[2 * r] = *(const f32x4*)(xr + r * 512 + lane * 8); v[2 * r + 1] = *(const f32x4*)(xr + r * 512 + lane * 8 + 4);
#pragma unroll
      for (int q = 0; q < 2; ++q) ss += v[2 * r + q][0] * v[2 * r + q][0] + v[2 * r + q][1] * v[2 * r + q][1] + v[2 * r + q][2] * v[2 * r + q][2] + v[2 * r + q][3] * v[2 * r + q][3];
    }
    ss = wave_sum(ss);
    const float rstd = 1.0f / sqrtf(ss * (1.f / 2048.f) + 1e-6f);
    const float* sh = MOD + b * 16384 + sh_idx * 2048; const float* sc = MOD + b * 16384 + sc_idx * 2048;
#pragma unroll
    for (int r = 0; r < 4; ++r) {
#pragma unroll
      for (int q = 0; q < 2; ++q) {
        const f32x4 g4 = *(const f32x4*)(G1s + b * 2048 + r * 512 + q * 256 + lane * 4), sh4 = *(const f32x4*)(SHs + b * 2048 + r * 512 + q * 256 + lane * 4);
        v[2 * r + q] = v[2 * r + q] * rstd * g4 + sh4;
      }
    }
#pragma unroll
    for (int r = 0; r < 4; ++r) {
      u32x4 o; o[0] = pk2(v[2 * r][0], v[2 * r][1]); o[1] = pk2(v[2 * r][2], v[2 * r][3]); o[2] = pk2(v[2 * r + 1][0], v[2 * r + 1][1]); o[3] = pk2(v[2 * r + 1][2], v[2 * r + 1][3]);
      *(u32x4*)(HB + (size_t)t * 2048 + r * 512 + lane * 8) = o;
    }
    if (GATES) {
      float mine = 0.f;
#pragma unroll 1
      for (int j = 0; j < 8; ++j) {
        float d = 0.f;
#pragma unroll
        for (int r = 0; r < 4; ++r)
#pragma unroll
          for (int q = 0; q < 2; ++q) { const f32x4 w = *(const f32x4*)(WGs + j * 2048 + r * 512 + q * 256 + lane * 4); const f32x4 a = v[2 * r + q]; d += a[0] * w[0] + a[1] * w[1] + a[2] * w[2] + a[3] * w[3]; }
        d = wave_sum(d);
        if (lane == j) mine = d;
      }
      if (lane < 8) GT[t * 8 + lane] = mine;
    }
  }
}
struct EpiProj {
  static constexpr bool PERM = true, AFTER_DRAIN = false;
  bf16_t* PB;
  DI void operator()(const f32x4 (&acc)[2][2][4][2], const pg8::Unit& u, int wr, int wc, int fr, int fq) const {
    const int row0 = u.pm * 256 + wr * 64 + fr, col0 = u.pn * 256 + wc * 32 + 8 * fq;
    const bool rope = u.pn < 8; const float qs = u.pn < 4 ? 0.125f * 1.4426950408889634f : 1.0f;
    float ir[2][4];
#pragma unroll
    for (int bj = 0; bj < 2; ++bj) { const int i0 = ((col0 + bj * 128) & 63) >> 1;
#pragma unroll
      for (int k = 0; k < 4; ++k) ir[bj][k] = exp2f(-(float)(i0 + k) * 0.41524101186092029f) * 0.15915494309189535f; }
#pragma unroll
    for (int ai = 0; ai < 2; ++ai)
#pragma unroll
      for (int m = 0; m < 4; ++m) {
        const int row = row0 + ai * 128 + m * 16; const float fpos = (float)(row & 2047);
#pragma unroll
        for (int bj = 0; bj < 2; ++bj) {
          float v[8];
#pragma unroll
          for (int n = 0; n < 2; ++n)
#pragma unroll
            for (int k = 0; k < 4; ++k) v[4 * n + k] = acc[ai][bj][m][n][k];
          if (rope) {
#pragma unroll
            for (int k = 0; k < 4; ++k) { const float rr = __builtin_amdgcn_fractf(fpos * ir[bj][k]); const float cc = __builtin_amdgcn_cosf(rr), sn = __builtin_amdgcn_sinf(rr);
              const float a0 = v[2 * k] * cc - v[2 * k + 1] * sn, a1 = v[2 * k + 1] * cc + v[2 * k] * sn; v[2 * k] = a0 * qs; v[2 * k + 1] = a1 * qs; }
          }
          u32x4 o; o[0] = pk2(v[0], v[1]); o[1] = pk2(v[2], v[3]); o[2] = pk2(v[4], v[5]); o[3] = pk2(v[6], v[7]);
          *(u32x4*)(PB + (size_t)row * 6144 + col0 + bj * 128) = o;
        }
      }
  }
};
struct EpiRes {
  static constexpr bool PERM = false, AFTER_DRAIN = false;
  float* X1; const float* x; const float* MOD;
  DI void operator()(const f32x4 (&acc)[2][2][4][2], const pg8::Unit& u, int wr, int wc, int fr, int fq) const {
    const int row0 = u.pm * 256 + wr * 64 + fr, col0 = u.pn * 256 + wc * 32 + 4 * fq;
    const int b = (u.pm * 256) >> 11;
    f32x4 gt[2][2];
#pragma unroll
    for (int bj = 0; bj < 2; ++bj)
#pragma unroll
      for (int n = 0; n < 2; ++n) gt[bj][n] = *(const f32x4*)(MOD + b * 16384 + 2 * 2048 + col0 + bj * 128 + n * 16);
#pragma unroll
    for (int ai = 0; ai < 2; ++ai) {
      f32x4 xv[4][2][2];
#pragma unroll
      for (int m = 0; m < 4; ++m)
#pragma unroll
        for (int bj = 0; bj < 2; ++bj)
#pragma unroll
          for (int n = 0; n < 2; ++n) xv[m][bj][n] = *(const f32x4*)(x + (size_t)(row0 + ai * 128 + m * 16) * 2048 + col0 + bj * 128 + n * 16);
#pragma unroll
      for (int m = 0; m < 4; ++m)
#pragma unroll
        for (int bj = 0; bj < 2; ++bj)
#pragma unroll
          for (int n = 0; n < 2; ++n) *(f32x4*)(X1 + (size_t)(row0 + ai * 128 + m * 16) * 2048 + col0 + bj * 128 + n * 16) = xv[m][bj][n] + gt[bj][n] * acc[ai][bj][m][n];
    }
  }
};
struct EpiBf {
  static constexpr bool PERM = true, AFTER_DRAIN = false;
  bf16_t* O;
  DI void operator()(const f32x4 (&acc)[2][2][4][2], const pg8::Unit& u, int wr, int wc, int fr, int fq) const {
    const int row0 = u.pm * 256 + wr * 64 + fr, col0 = u.pn * 256 + wc * 32 + 8 * fq;
#pragma unroll
    for (int ai = 0; ai < 2; ++ai)
#pragma unroll
      for (int m = 0; m < 4; ++m) {
        const size_t ro = (size_t)(row0 + ai * 128 + m * 16) * 2048;
#pragma unroll
        for (int bj = 0; bj < 2; ++bj) { const f32x4 v0 = acc[ai][bj][m][0], v1 = acc[ai][bj][m][1]; u32x4 o; o[0] = pk2(v0[0], v0[1]); o[1] = pk2(v0[2], v0[3]); o[2] = pk2(v1[0], v1[1]); o[3] = pk2(v1[2], v1[3]); *(u32x4*)(O + ro + col0 + bj * 128) = o; }
      }
  }
};
DI bf16_t f2bf1(float x) { return (bf16_t)(pk2(x, 0.f) & 0xffffu); }
DI void phase_attn(const Params& p, unsigned char* lds, int bid, int nblk, int tid_in) {
  const bf16_t* PB = (const bf16_t*)(p.ws + OFF_PB); bf16_t* MIX = (bf16_t*)(p.ws + OFF_MIX);
  float* XE = (float*)(lds + 71680);
  float d1 = 0.f, d2 = 0.f;
  for (int i = 0; i < 64; ++i) { d1 += p.lq1[i] * p.lk1[i]; d2 += p.lq2[i] * p.lk2[i]; }
  const float lam = expf(d1) - expf(d2) + 0.2f;
  for (int u0 = bid; u0 < 256; u0 += nblk) {
    const int u = (nblk == 256) ? ((u0 & 7) * 32 + (u0 >> 3)) : u0;
    const int bh = u >> 3, pi = u & 7, b = bh >> 3, hd = bh & 7;
    u32x4 kreg[2], vreg[2];
    for (int half = 0; half < 2; ++half) {
      int tid = tid_in; asm volatile("" : "+v"(tid));
      const int lane = tid & 63, wave = tid >> 6, r = lane & 31, h = lane >> 5;
      const int map = wave & 1, qs = wave >> 1;
      const int qb = half ? 15 - pi : pi;
      const int qg = qb * 128 + qs * 32 + r;
      const size_t tq = (size_t)b * 2048 + qg;
      bf16x8 bq[4];
#pragma unroll
      for (int s = 0; s < 4; ++s) bq[s] = *(const bf16x8*)(PB + tq * 6144 + (2 * hd + map) * 64 + 16 * s + 8 * h);
      f32x16 o[4];
#pragma unroll
      for (int et = 0; et < 4; ++et) o[et] = zero16();
      float m_run = -INFINITY, l_run = 0.f;
      const int nkt = 2 * qb + 2;
      const int vc16 = tid & 15, vrp = tid >> 4;
      const bf16_t* kbase = PB + (size_t)b * 2048 * 6144 + 1024 + hd * 128;
      const bf16_t* vbase = PB + (size_t)b * 2048 * 6144 + 2048 + hd * 128 + vc16 * 8;
#define AT_GK(kt) _Pragma("unroll") for (int i_ = 0; i_ < 2; ++i_) { const int q_ = tid + 512 * i_; kreg[i_] = *(const u32x4*)(kbase + (size_t)((kt) * 64 + (q_ >> 4)) * 6144 + (q_ & 15) * 8); }
#define AT_GV(kt) _Pragma("unroll") for (int i_ = 0; i_ < 2; ++i_) vreg[i_] = *(const u32x4*)(vbase + (size_t)((kt) * 64 + 2 * vrp + i_) * 6144);
#define AT_WK(buf) _Pragma("unroll") for (int i_ = 0; i_ < 2; ++i_) { const int q_ = tid + 512 * i_; *(u32x4*)((bf16_t*)(lds + (buf) * 17408) + (q_ >> 4) * 136 + (q_ & 15) * 8) = kreg[i_]; }
#define AT_WV(buf) { bf16_t* VT_ = (bf16_t*)(lds + 34816 + (buf) * 18432); const int pk_ = (2 * vrp + 4 * vc16) & 63; _Pragma("unroll") for (int d_ = 0; d_ < 4; ++d_) { const unsigned a_ = vreg[0][d_], b_ = vreg[1][d_]; \
          *(unsigned*)(VT_ + (vc16 * 8 + 2 * d_) * 72 + pk_) = (a_ & 0xffffu) | (b_ << 16); *(unsigned*)(VT_ + (vc16 * 8 + 2 * d_ + 1) * 72 + pk_) = (a_ >> 16) | (b_ & 0xffff0000u); } }
#define AT_QK(dst, buf) { const bf16_t* Ks_ = (const bf16_t*)(lds + (buf) * 17408); _Pragma("unroll") for (int kk = 0; kk < 2; ++kk) { dst[kk] = zero16(); \
          _Pragma("unroll") for (int s = 0; s < 4; ++s) { const bf16x8 a_ = *(const bf16x8*)(Ks_ + (kk * 32 + r) * 136 + map * 64 + 16 * s + 8 * h); dst[kk] = mfma32(a_, bq[s], dst[kk]); } } }
      if (half == 0) { AT_GK(0); AT_GV(0); }
      __syncthreads();
      AT_WK(0); AT_WV(0);
      AT_GK(1);
      AT_WK(1);
      __syncthreads();
      if (nkt > 2) { AT_GK(2); }
      AT_GV(1);
      f32x16 st[2], sn[2];
      AT_QK(st, 0);
      __syncthreads();
      for (int kt = 0; kt < nkt; ++kt) {
        if (kt + 2 < nkt) { AT_WK(kt & 1); }
        if (kt + 1 < nkt) { AT_WV((kt + 1) & 1); }
        if (kt + 3 < nkt) { AT_GK(kt + 3); }
        if (kt + 2 < nkt) { AT_GV(kt + 2); }
        AT_QK(sn, (kt + 1) & 1);
        const bool diag = (kt >= 2 * qb);
        if (diag) {
#pragma unroll
          for (int kk = 0; kk < 2; ++kk)
#pragma unroll
            for (int i = 0; i < 16; ++i) { const int kg = kt * 64 + kk * 32 + crow(i, h); if (kg > qg) st[kk][i] = -INFINITY; }
        }
        float mx = -INFINITY;
#pragma unroll
        for (int kk = 0; kk < 2; ++kk)
#pragma unroll
          for (int i = 0; i < 16; ++i) mx = fmaxf(mx, st[kk][i]);
        mx = fmaxf(mx, __shfl_xor(mx, 32));
        const float m_new = fmaxf(m_run, mx);
        const bool need = (m_new - m_run) > 8.0f;
        if (__any(need)) {
          const float m_use = need ? m_new : m_run;
          const float corr = __builtin_amdgcn_exp2f(m_run - m_use);
          l_run *= corr;
#pragma unroll
          for (int et = 0; et < 4; ++et) o[et] *= corr;
          m_run = m_use;
        }
        float ps = 0.f;
#pragma unroll
        for (int kk = 0; kk < 2; ++kk)
#pragma unroll
          for (int i = 0; i < 16; ++i) { const float pv = __builtin_amdgcn_exp2f(st[kk][i] - m_run); st[kk][i] = pv; ps += pv; }
        l_run += ps;
        const bf16_t* VT = (const bf16_t*)(lds + 34816 + (kt & 1) * 18432);
#pragma unroll
        for (int kk = 0; kk < 2; ++kk) {
          const bf16x8 pf0 = pack8<0>(st[kk]), pf1 = pack8<1>(st[kk]);
#pragma unroll
          for (int et = 0; et < 4; ++et) {
            const int ev = et * 32 + r, rot = 4 * ((ev >> 3) & 15) + kk * 32 + 4 * h;
            const bf16_t* vrow = VT + ev * 72;
            const bf16x8 a0 = cat4(*(const s16x4*)(vrow + (rot & 63)), *(const s16x4*)(vrow + ((rot + 8) & 63))), a1 = cat4(*(const s16x4*)(vrow + ((rot + 16) & 63)), *(const s16x4*)(vrow + ((rot + 24) & 63)));
            o[et] = mfma32(a0, pf0, o[et]); o[et] = mfma32(a1, pf1, o[et]);
          }
        }
        st[0] = sn[0]; st[1] = sn[1];
        __syncthreads();
      }
      if (half == 0) { AT_GK(0); AT_GV(0); }
#undef AT_GK
#undef AT_GV
#undef AT_WK
#undef AT_WV
#undef AT_QK
      const float inv = 1.0f / (l_run + __shfl_xor(l_run, 32));
      if (map == 1) {
#pragma unroll
        for (int et = 0; et < 4; ++et)
#pragma unroll
          for (int i = 0; i < 16; ++i) XE[(qs * 128 + et * 32 + crow(i, h)) * 32 + r] = lam * o[et][i] * inv;
      }
      __syncthreads();
      if (map == 0) {
        float ss = 0.f;
#pragma unroll
        for (int et = 0; et < 4; ++et)
#pragma unroll
          for (int i = 0; i < 16; ++i) { const float v = o[et][i] * inv - XE[(qs * 128 + et * 32 + crow(i, h)) * 32 + r]; o[et][i] = v; ss += v * v; }
        ss += __shfl_xor(ss, 32);
        const float rstd = 0.8f / sqrtf(ss * (1.f / 128.f) + 1e-6f);
        f32x4 dnv[4][4];
#pragma unroll
        for (int et = 0; et < 4; ++et)
#pragma unroll
          for (int g = 0; g < 4; ++g) dnv[et][g] = *(const f32x4*)(p.da_norm + et * 32 + 8 * g + 4 * h);
#pragma unroll
        for (int et = 0; et < 4; ++et)
#pragma unroll
          for (int g = 0; g < 4; ++g) { const int e0 = et * 32 + 8 * g + 4 * h; const f32x4 dn = dnv[et][g];
            u32x2 ov; ov[0] = pk2(o[et][4 * g] * rstd * dn[0], o[et][4 * g + 1] * rstd * dn[1]); ov[1] = pk2(o[et][4 * g + 2] * rstd * dn[2], o[et][4 * g + 3] * rstd * dn[3]);
            *(u32x2*)(MIX + tq * 2048 + hd * 128 + e0) = ov; }
      }
    }
  }
  __syncthreads();
}
DI void conv8(const Params& p, const bf16_t* PB, int b, int spos, int pbcol, int cch, float (&out)[8]) {
  const f32x4 b0 = *(const f32x4*)(p.conv_b + cch), b1 = *(const f32x4*)(p.conv_b + cch + 4);
#pragma unroll
  for (int j = 0; j < 4; ++j) { out[j] = b0[j]; out[4 + j] = b1[j]; }
#pragma unroll
  for (int kw = 0; kw < 4; ++kw) {
    const int sp = spos - 3 + kw;
    if (sp >= 0) {
      const u32x4 xv = *(const u32x4*)(PB + ((size_t)b * 2048 + sp) * 6144 + pbcol);
      const f32x4 w0 = *(const f32x4*)(p.conv_w + kw * 1024 + cch), w1 = *(const f32x4*)(p.conv_w + kw * 1024 + cch + 4);
      out[0] += w0[0] * bflo(xv[0]); out[1] += w0[1] * bfhi(xv[0]); out[2] += w0[2] * bflo(xv[1]); out[3] += w0[3] * bfhi(xv[1]);
      out[4] += w1[0] * bflo(xv[2]); out[5] += w1[1] * bfhi(xv[2]); out[6] += w1[2] * bflo(xv[3]); out[7] += w1[3] * bfhi(xv[3]);
    }
  }
#pragma unroll
  for (int j = 0; j < 8; ++j) out[j] = out[j] / (1.f + __expf(-out[j]));
}
DI void gates64(const Params& p, int t0, int hh, int lane, float& li, float& bc) {
  const float* GT = (const float*)(p.ws + OFF_GATES);
  const float gi = GT[(t0 + lane) * 8 + hh] + p.b_igate[hh], gf = GT[(t0 + lane) * 8 + 4 + hh] + p.b_fgate[hh];
  li = 15.f * tanhf(gi * (1.f / 15.f));
  const float z = 15.f * tanhf(gf * (1.f / 15.f));
  const float lf = fminf(z, 0.f) - log1pf(expf(-fabsf(z)));
  bc = lf;
#pragma unroll
  for (int o = 1; o < 64; o <<= 1) { const float n = __shfl_up(bc, o); if (lane >= o) bc += n; }
}
DI void stage_vt256(const bf16_t* PB, bf16_t* VT, int t0, int hh, int tid) {
  const int c32 = tid & 31, rp = tid >> 5;
#pragma unroll
  for (int i = 0; i < 2; ++i) { const int r2 = 2 * (rp + 16 * i);
    const u32x4 va = *(const u32x4*)(PB + (size_t)(t0 + r2) * 6144 + 4096 + hh * 256 + c32 * 8), vb = *(const u32x4*)(PB + (size_t)(t0 + r2 + 1) * 6144 + 4096 + hh * 256 + c32 * 8);
    const int pk = (r2 + 4 * (c32 & 15)) & 63;
#pragma unroll
    for (int d = 0; d < 4; ++d) { *(unsigned*)(VT + (c32 * 8 + 2 * d) * 72 + pk) = (va[d] & 0xffffu) | (vb[d] << 16); *(unsigned*)(VT + (c32 * 8 + 2 * d + 1) * 72 + pk) = (va[d] >> 16) | (vb[d] & 0xffff0000u); } }
}
DI void phase_mlA(const Params& p, unsigned char* lds, int bid, int nblk, int tid_in) {
  const bf16_t* PB = (const bf16_t*)(p.ws + OFF_PB);
  bf16_t* CST = (bf16_t*)(p.ws + OFF_CST); float* NST = (float*)(p.ws + OFF_NST); float* DEC = (float*)(p.ws + OFF_DEC);
  bf16_t* KwT = (bf16_t*)lds;
  bf16_t* VT = (bf16_t*)(lds + 18432);
  float* wsv = (float*)(lds + 55296);
  for (int u = bid; u < 512; u += nblk) {
    int tid = tid_in; asm volatile("" : "+v"(tid));
    const int lane = tid & 63, wave = tid >> 6, r = lane & 31, h = lane >> 5;
    const int bh = u >> 5, c = u & 31, b = bh >> 2, hh = bh & 3;
    const int t0 = b * 2048 + c * 64;
    __syncthreads();
    if (wave == 0) {
      float li, bc; gates64(p, t0, hh, lane, li, bc);
      const float bL = __shfl(bc, 63);
      wsv[lane] = expf(bL - bc + li);
      if (lane == 0) DEC[u] = expf(bL);
    }
    __syncthreads();
    { const int c8 = tid & 15, rp = tid >> 4; float oa[8], ob[8];
      conv8(p, PB, b, c * 64 + 2 * rp, 3584 + hh * 128 + c8 * 8, 512 + hh * 128 + c8 * 8, oa);
      conv8(p, PB, b, c * 64 + 2 * rp + 1, 3584 + hh * 128 + c8 * 8, 512 + hh * 128 + c8 * 8, ob);
      const float wa = wsv[2 * rp] * 0.08838834764831845f, wb = wsv[2 * rp + 1] * 0.08838834764831845f;
      const int pk = (2 * rp + 4 * c8) & 63;
#pragma unroll
      for (int j = 0; j < 8; ++j) *(unsigned*)(KwT + (c8 * 8 + j) * 72 + pk) = pk2(oa[j] * wa, ob[j] * wb); }
    stage_vt256(PB, VT, t0, hh, tid);
    __syncthreads();
    f32x16 acc[4];
#pragma unroll
    for (int d = 0; d < 4; ++d) acc[d] = zero16();
#pragma unroll
    for (int ks = 0; ks < 4; ++ks) { const int ev = wave * 32 + r, rv = 4 * ((ev >> 3) & 15) + 16 * ks + 4 * h;
      const bf16x8 a = cat4(*(const s16x4*)(VT + ev * 72 + (rv & 63)), *(const s16x4*)(VT + ev * 72 + ((rv + 8) & 63)));
#pragma unroll
      for (int d = 0; d < 4; ++d) { const int dk = d * 32 + r, rk = 4 * ((dk >> 3) & 15) + 16 * ks + 4 * h;
        const bf16x8 bb = cat4(*(const s16x4*)(KwT + dk * 72 + (rk & 63)), *(const s16x4*)(KwT + dk * 72 + ((rk + 8) & 63))); acc[d] = mfma32(a, bb, acc[d]); } }
    bf16_t* C = CST + (size_t)u * 32768;
#pragma unroll
    for (int d = 0; d < 4; ++d)
#pragma unroll
      for (int i = 0; i < 16; ++i) C[(wave * 32 + crow(i, h)) * 128 + d * 32 + r] = f2bf1(acc[d][i]);
    if (tid < 128) { float s = 0.f; for (int ss = 0; ss < 64; ++ss) s += bf2f(KwT[tid * 72 + ss]); NST[u * 128 + tid] = s; }
  }
}
DI void phase_scan(const Params& p, int bid, int nblk, int tid) {
  u32x2* CST = (u32x2*)(p.ws + OFF_CST); float* NST = (float*)(p.ws + OFF_NST); const float* DEC = (const float*)(p.ws + OFF_DEC);
  for (int e = bid * 512 + tid; e < 16 * 8192 + 16 * 128; e += nblk * 512) {
    if (e < 131072) {
      const int bh = e >> 13; u32x2* base = CST + (size_t)bh * 32 * 8192 + (e & 8191);
      u32x2 v[32];
#pragma unroll
      for (int c = 0; c < 32; ++c) v[c] = base[(size_t)c * 8192];
      float c0 = 0.f, c1 = 0.f, c2 = 0.f, c3 = 0.f;
#pragma unroll
      for (int c = 0; c < 32; ++c) { const float d = DEC[bh * 32 + c]; u32x2 o; o[0] = pk2(c0, c1); o[1] = pk2(c2, c3); base[(size_t)c * 8192] = o;
        c0 = d * c0 + bflo(v[c][0]); c1 = d * c1 + bfhi(v[c][0]); c2 = d * c2 + bflo(v[c][1]); c3 = d * c3 + bfhi(v[c][1]); }
    } else {
      const int e2 = e - 131072, bh = e2 >> 7; float* base = NST + (size_t)bh * 32 * 128 + (e2 & 127);
      float v[32];
#pragma unroll
      for (int c = 0; c < 32; ++c) v[c] = base[c * 128];
      float carry = 0.f;
#pragma unroll
      for (int c = 0; c < 32; ++c) { const float d = DEC[bh * 32 + c]; base[c * 128] = carry; carry = d * carry + v[c]; }
    }
  }
}
DI void phase_mlC(const Params& p, unsigned char* lds, int bid, int nblk, int tid_in) {
  const bf16_t* PB = (const bf16_t*)(p.ws + OFF_PB); bf16_t* MIX = (bf16_t*)(p.ws + OFF_MIX);
  const bf16_t* CST = (const bf16_t*)(p.ws + OFF_CST); const float* NST = (const float*)(p.ws + OFF_NST);
  bf16_t* Qs = (bf16_t*)lds;
  bf16_t* Ks = (bf16_t*)(lds + 17408);
  bf16_t* VT = (bf16_t*)(lds + 34816);
  bf16_t* CT = (bf16_t*)(lds + 71680);
  float* bvec = (float*)(lds + 141312);
  float* liv = bvec + 64; float* nvec = liv + 64; float* qn = nvec + 128;
  float* Hout = (float*)lds;
  for (int u = bid; u < 512; u += nblk) {
    int tid = tid_in; asm volatile("" : "+v"(tid));
    const int lane = tid & 63, wave = tid >> 6, r = lane & 31, h = lane >> 5;
    const int bh = u >> 5, c = u & 31, b = bh >> 2, hh = bh & 3;
    const int t0 = b * 2048 + c * 64;
    __syncthreads();
    if (wave == 0) { float li, bc; gates64(p, t0, hh, lane, li, bc); bvec[lane] = bc; liv[lane] = li; }
    if (tid >= 64 && tid < 192) nvec[tid - 64] = NST[u * 128 + tid - 64];
#pragma unroll 1
    for (int i = 0; i < 2; ++i) { const int q = tid + 512 * i, s = q >> 4, c8 = q & 15; float o8[8];
      conv8(p, PB, b, c * 64 + s, 3072 + hh * 128 + c8 * 8, hh * 128 + c8 * 8, o8);
      u32x4 ov; ov[0] = pk2(o8[0], o8[1]); ov[1] = pk2(o8[2], o8[3]); ov[2] = pk2(o8[4], o8[5]); ov[3] = pk2(o8[6], o8[7]);
      *(u32x4*)(Qs + s * 136 + c8 * 8) = ov;
      conv8(p, PB, b, c * 64 + s, 3584 + hh * 128 + c8 * 8, 512 + hh * 128 + c8 * 8, o8);
      const float w = 0.08838834764831845f;
      ov[0] = pk2(o8[0] * w, o8[1] * w); ov[1] = pk2(o8[2] * w, o8[3] * w); ov[2] = pk2(o8[4] * w, o8[5] * w); ov[3] = pk2(o8[6] * w, o8[7] * w);
      *(u32x4*)(Ks + s * 136 + c8 * 8) = ov; }
    stage_vt256(PB, VT, t0, hh, tid);
#pragma unroll
    for (int i = 0; i < 8; ++i) { const int q = tid + 512 * i, dv = q >> 4, c8 = q & 15;
      *(u32x4*)(CT + dv * 136 + c8 * 8) = *(const u32x4*)(CST + (size_t)u * 32768 + dv * 128 + c8 * 8); }
    __syncthreads();
    { const int j = tid >> 3, seg = tid & 7; float s = 0.f;
#pragma unroll
      for (int d = 0; d < 16; ++d) s += bf2f(Qs[j * 136 + seg * 16 + d]) * nvec[seg * 16 + d];
      s += __shfl_xor(s, 1); s += __shfl_xor(s, 2); s += __shfl_xor(s, 4);
      if (seg == 0) qn[j] = s; }
    __syncthreads();
    f32x16 hv[2];
#pragma unroll
    for (int jt = 0; jt < 2; ++jt) {
      f32x16 st[2]; st[0] = zero16(); st[1] = zero16();
#pragma unroll 2
      for (int ks = 0; ks < 8; ++ks) { const bf16x8 bqf = *(const bf16x8*)(Qs + (jt * 32 + r) * 136 + 16 * ks + 8 * h);
#pragma unroll
        for (int s2 = 0; s2 < 2; ++s2) { const bf16x8 a = *(const bf16x8*)(Ks + (s2 * 32 + r) * 136 + 16 * ks + 8 * h); st[s2] = mfma32(a, bqf, st[s2]); } }
      const int jj = jt * 32 + r; const float bj = bvec[jj]; float rs = 0.f;
#pragma unroll
      for (int s2 = 0; s2 < 2; ++s2)
#pragma unroll
        for (int i = 0; i < 16; ++i) { const int s = s2 * 32 + crow(i, h); const float w = (s <= jj) ? __expf(bj - bvec[s] + liv[s]) : 0.f; const float v = st[s2][i] * w; st[s2][i] = v; rs += v; }
      rs += __shfl_xor(rs, 32);
      const float den = __expf(bj) * qn[jj] + rs;
      const float dinv = 1.0f / fmaxf(fabsf(den), 1.0f);
      f32x16 z = zero16();
#pragma unroll
      for (int s2 = 0; s2 < 2; ++s2) { const bf16x8 pf0 = pack8<0>(st[s2]), pf1 = pack8<1>(st[s2]);
        const int ev = wave * 32 + r, rot = 4 * ((ev >> 3) & 15) + s2 * 32 + 4 * h;
        const bf16_t* vrow = VT + ev * 72;
        const bf16x8 b0 = cat4(*(const s16x4*)(vrow + (rot & 63)), *(const s16x4*)(vrow + ((rot + 8) & 63))), b1 = cat4(*(const s16x4*)(vrow + ((rot + 16) & 63)), *(const s16x4*)(vrow + ((rot + 24) & 63)));
        z = mfma32(pf0, b0, z); z = mfma32(pf1, b1, z); }
      f32x16 z2 = zero16();
#pragma unroll 2
      for (int ks = 0; ks < 8; ++ks) { const bf16x8 a = *(const bf16x8*)(Qs + (jt * 32 + r) * 136 + 16 * ks + 8 * h); const bf16x8 bb = *(const bf16x8*)(CT + (wave * 32 + r) * 136 + 16 * ks + 8 * h); z2 = mfma32(a, bb, z2); }
#pragma unroll
      for (int i = 0; i < 16; ++i) { const int jr = jt * 32 + crow(i, h); const float eb = __expf(bvec[jr]); const float di = __shfl(dinv, crow(i, h)); hv[jt][i] = (eb * z2[i] + z[i]) * di; }
    }
    __syncthreads();
#pragma unroll
    for (int jt = 0; jt < 2; ++jt)
#pragma unroll
      for (int i = 0; i < 16; ++i) Hout[(jt * 32 + crow(i, h)) * 256 + wave * 32 + r] = hv[jt][i];
    __syncthreads();
    { const int j = tid >> 3, seg = tid & 7; const size_t t = (size_t)t0 + j; float vals[32]; float ss = 0.f;
#pragma unroll
      for (int d = 0; d < 32; ++d) { vals[d] = Hout[j * 256 + seg * 32 + d]; ss += vals[d] * vals[d]; }
      ss += __shfl_xor(ss, 1); ss += __shfl_xor(ss, 2); ss += __shfl_xor(ss, 4);
      const float rstd = 1.0f / sqrtf(ss * (1.f / 256.f) + 1e-6f);
      u32x4 ogv[4];
#pragma unroll
      for (int d8 = 0; d8 < 4; ++d8) ogv[d8] = *(const u32x4*)(PB + t * 6144 + 5120 + hh * 256 + seg * 32 + d8 * 8);
#pragma unroll
      for (int d8 = 0; d8 < 4; ++d8) {
        const int dv = seg * 32 + d8 * 8;
        const u32x4 og = ogv[d8];
        const f32x4 n0 = *(const f32x4*)(p.ml_norm + dv), n1 = *(const f32x4*)(p.ml_norm + dv + 4);
        float ov[8];
#pragma unroll
        for (int k = 0; k < 4; ++k) { const float g0 = bflo(og[k]), g1 = bfhi(og[k]);
          const float nn0 = (2 * k < 4) ? n0[(2 * k) & 3] : n1[(2 * k) & 3], nn1 = (2 * k + 1 < 4) ? n0[(2 * k + 1) & 3] : n1[(2 * k + 1) & 3];
          ov[2 * k] = vals[d8 * 8 + 2 * k] * rstd * nn0 / (1.f + __expf(-g0)); ov[2 * k + 1] = vals[d8 * 8 + 2 * k + 1] * rstd * nn1 / (1.f + __expf(-g1)); }
        u32x4 o4; o4[0] = pk2(ov[0], ov[1]); o4[1] = pk2(ov[2], ov[3]); o4[2] = pk2(ov[4], ov[5]); o4[3] = pk2(ov[6], ov[7]);
        *(u32x4*)(MIX + t * 2048 + 1024 + hh * 256 + dv) = o4;
      }
    }
  }
}
DI int f2key(float x) { const int b = __float_as_int(x); return b ^ ((b >> 31) & 0x7fffffff); }
DI float key2f(int k) { return __int_as_float(k ^ ((k >> 31) & 0x7fffffff)); }
template <int N> DI void bitonic_sort_desc(int (&a)[N]) {
#pragma unroll
  for (int k = 2; k <= N; k <<= 1)
#pragma unroll
    for (int j = k >> 1; j > 0; j >>= 1)
#pragma unroll
      for (int i = 0; i < N; ++i) { const int l = i ^ j; if (l > i) { const bool desc = ((i & k) == 0); const int hi = max(a[i], a[l]), lo = min(a[i], a[l]); a[i] = desc ? hi : lo; a[l] = desc ? lo : hi; } }
}
template <int N> DI void bitonic_merge_desc(int (&a)[N]) {
#pragma unroll
  for (int j = N >> 1; j > 0; j >>= 1)
#pragma unroll
    for (int i = 0; i < N; ++i) { const int l = i ^ j; if (l > i) { const int hi = max(a[i], a[l]), lo = min(a[i], a[l]); a[i] = hi; a[l] = lo; } }
}
DI void top16_merge(int (&a)[16], const int (&b)[16]) {
#pragma unroll
  for (int i = 0; i < 16; ++i) a[i] = max(a[i], b[15 - i]);
  bitonic_merge_desc<16>(a);
}
DI void top16_xlane(int (&a)[16]) {
  int b[16];
#pragma unroll
  for (int i = 0; i < 16; ++i) b[i] = __shfl_xor(a[i], 32);
  top16_merge(a, b);
}
DI void topk_unit(const Params& p, const bf16_t* q0, const bf16_t* q1, size_t t, int hd, int r, int h) {
  int* IDX = (int*)(p.ws + OFF_IDX); float* GW = (float*)(p.ws + OFF_GW); float* AACC = (float*)(p.ws + OFF_AACC);
    int top[2][16];
#pragma unroll
    for (int c = 0; c < 2; ++c) {
      f32x16 acc[4];
#pragma unroll
      for (int nt = 0; nt < 4; ++nt) acc[nt] = zero16();
      const bf16_t* sk = (const bf16_t*)(p.ws + OFF_SKB) + (size_t)((hd * 2 + c) * 128) * 128;
      const bf16_t* qrow = c ? q1 : q0;
#pragma unroll 4
      for (int ks = 0; ks < 8; ++ks) {
        const bf16x8 bq = *(const bf16x8*)(qrow + 16 * ks + 8 * h);
#pragma unroll
        for (int nt = 0; nt < 4; ++nt) { const bf16x8 a = *(const bf16x8*)(sk + (nt * 32 + r) * 128 + 16 * ks + 8 * h); acc[nt] = mfma32(a, bq, acc[nt]); }
      }
      int l0[16], l1[16], l2[16], l3[16];
#pragma unroll
      for (int i = 0; i < 16; ++i) { l0[i] = (f2key(acc[0][i]) & ~127) | (crow(i, h)); l1[i] = (f2key(acc[1][i]) & ~127) | (32 + crow(i, h)); l2[i] = (f2key(acc[2][i]) & ~127) | (64 + crow(i, h)); l3[i] = (f2key(acc[3][i]) & ~127) | (96 + crow(i, h)); }
      bitonic_sort_desc<16>(l0); bitonic_sort_desc<16>(l1); bitonic_sort_desc<16>(l2); bitonic_sort_desc<16>(l3);
      top16_merge(l0, l1); top16_merge(l2, l3); top16_merge(l0, l2);
      top16_xlane(l0);
#pragma unroll
      for (int k = 0; k < 16; ++k) top[c][k] = l0[k];
    }
    float sa[16], sb[16]; int ia[16], ib[16];
#pragma unroll
    for (int k = 0; k < 16; ++k) { sa[k] = key2f(top[0][k] & ~127); ia[k] = top[0][k] & 127; sb[k] = key2f(top[1][k] & ~127); ib[k] = top[1][k] & 127; }
    constexpr int A0[25] = {0,0,0,0,0,0,0,0,0,0,0,0,0,0,0,0, 4,4,4, 6,6, 8,10,12,14};
    constexpr int B0[25] = {0,1,2,3,4,5,6,7,8,9,10,11,12,13,14,15, 0,1,2, 0,1, 0,0,0,0};
    constexpr int A1[25] = {1,1,1,1,1,1,1,1, 2,2,2,2,2, 3,3,3,3, 5,5, 7,7, 9,11,13,15};
    constexpr int B1[25] = {0,1,2,3,4,5,6,7, 0,1,2,3,4, 0,1,2,3, 0,1, 0,1, 0,0,0,0};
    int c0[16], c1[16];
#pragma unroll
    for (int k = 0; k < 32; ++k) {
      int key = (int)0x80000000;
      if (k < 25) { const float x0 = sa[A0[k]] + sb[B0[k]], x1 = sa[A1[k]] + sb[B1[k]];
        const int e0 = ia[A0[k]] * 128 + ib[B0[k]], e1 = ia[A1[k]] * 128 + ib[B1[k]];
        key = (f2key(h ? x1 : x0) & ~16383) | (h ? e1 : e0); }
      if (k < 16) c0[k] = key; else c1[k - 16] = key;
    }
    bitonic_sort_desc<16>(c0); bitonic_sort_desc<16>(c1);
    top16_merge(c0, c1);
    top16_xlane(c0);
    float fv[16]; int fe[16];
#pragma unroll
    for (int k = 0; k < 16; ++k) { fv[k] = key2f(c0[k] & ~16383); fe[k] = c0[k] & 16383; }
    const float mxv = fv[0];
    float sum = 0.f;
#pragma unroll
    for (int k = 0; k < 16; ++k) { fv[k] = expf(fv[k] - mxv); sum += fv[k]; }
    const float isum = 1.0f / sum;
#pragma unroll
    for (int m = 0; m < 4; ++m) { if (h == 0) {
        i32x4 e4; e4[0] = fe[4 * m]; e4[1] = fe[4 * m + 1]; e4[2] = fe[4 * m + 2]; e4[3] = fe[4 * m + 3];
        f32x4 g4; g4[0] = fv[4 * m] * isum; g4[1] = fv[4 * m + 1] * isum; g4[2] = fv[4 * m + 2] * isum; g4[3] = fv[4 * m + 3] * isum;
        *(i32x4*)(IDX + t * 128 + hd * 16 + 4 * m) = e4; *(f32x4*)(GW + t * 128 + hd * 16 + 4 * m) = g4; *(f32x4*)(AACC + t * 128 + hd * 16 + 4 * m) = (f32x4){0.f, 0.f, 0.f, 0.f}; } }
}
DI void phase_topk(const Params& p, int bid, int nblk, int tid) {
  asm volatile("" : "+v"(tid));
  const int lane = tid & 63, wave = tid >> 6, r = lane & 31, h = lane >> 5;
  const bf16_t* QP = (const bf16_t*)(p.ws + OFF_QP);
  if (!(wave & 4)) convert_peer_rows(p, bid * 8 + wave, nblk * 8, lane);
  for (int unit = bid * 8 + wave; unit < 2048; unit += nblk * 8) {
    const int tt = unit >> 3, hd = unit & 7;
    const size_t t = (size_t)tt * 32 + r;
    topk_unit(p, QP + t * 2048 + hd * 256, QP + t * 2048 + hd * 256 + 128, t, hd, r, h);
  }
  if (wave & 4) convert_peer_rows(p, bid * 8 + wave, nblk * 8, lane);
}
struct EpiTopk {
  static constexpr bool PERM = true, AFTER_DRAIN = true;
  const Params* pp; int bid, nblk;
  DI void fused(const f32x4 (&acc)[2][2][4][2], const pg8::Unit& u, int wr, int wc, int fr, int fq, PG8_LAS unsigned char* ldsp, int wid, int lane) const {
    bf16_t* Qt = (bf16_t*)(unsigned char*)ldsp;
#pragma unroll
    for (int ai = 0; ai < 2; ++ai)
#pragma unroll
      for (int m = 0; m < 4; ++m) {
        const int row = ai * 128 + wr * 64 + m * 16 + fr;
#pragma unroll
        for (int bj = 0; bj < 2; ++bj) { const f32x4 v0 = acc[ai][bj][m][0], v1 = acc[ai][bj][m][1]; u32x4 o; o[0] = pk2(v0[0], v0[1]); o[1] = pk2(v0[2], v0[3]); o[2] = pk2(v1[0], v1[1]); o[3] = pk2(v1[2], v1[3]);
          *(u32x4*)(Qt + row * 264 + bj * 128 + wc * 32 + 8 * fq) = o; }
      }
    __syncthreads();
    const Params& p = *pp;
    const int r = lane & 31, h = lane >> 5;
    if (!(wid & 4)) convert_peer_rows(p, bid * 8 + wid, nblk * 8, lane);
    const bf16_t* q0 = Qt + (32 * wid + r) * 264;
    topk_unit(p, q0, q0 + 128, (size_t)u.pm * 256 + 32 * wid + r, u.pn, r, h);
    if (wid & 4) convert_peer_rows(p, bid * 8 + wid, nblk * 8, lane);
  }
};
DI float gelu_exact(float x) { return 0.5f * x * (1.0f + erff(x * 0.70710678118654752f)); }
DI float reduce16(const float (&v)[16], int c) {
  float a8[8], a4[4], a2[2];
  const bool b8 = (c & 8) != 0, b4 = (c & 4) != 0, b2 = (c & 2) != 0, b1 = (c & 1) != 0;
#pragma unroll
  for (int j = 0; j < 8; ++j) { const float send = b8 ? v[j] : v[j + 8], keep = b8 ? v[j + 8] : v[j]; a8[j] = keep + __shfl_xor(send, 8); }
#pragma unroll
  for (int j = 0; j < 4; ++j) { const float send = b4 ? a8[j] : a8[j + 4], keep = b4 ? a8[j + 4] : a8[j]; a4[j] = keep + __shfl_xor(send, 4); }
#pragma unroll
  for (int j = 0; j < 2; ++j) { const float send = b2 ? a4[j] : a4[j + 2], keep = b2 ? a4[j + 2] : a4[j]; a2[j] = keep + __shfl_xor(send, 2); }
  const float send = b1 ? a2[0] : a2[1], keep = b1 ? a2[1] : a2[0];
  return keep + __shfl_xor(send, 1);
}
DI void phase_gA(const Params& p, int gi, int nblk, int tid) {
  const int lane = tid & 63, wave = tid >> 6, c = lane & 15, es = lane >> 4;
  const int NG = nblk >> 3, sl = gi & 7, tr = gi >> 3;
  const bf16_t* HB = (const bf16_t*)(p.ws + OFF_HB); const unsigned char* PU8 = (const unsigned char*)(p.ws + OFF_PU);
  const int* IDX = (const int*)(p.ws + OFF_IDX); float* AACC = (float*)(p.ws + OFF_AACC);
  const unsigned char* PUs = PU8 + (size_t)sl * 16384 * 256;
  const int tstep = NG * 8;
  int tcur = tr * 8 + wave;
  if (tcur >= T_) return;
  int ex[32]; u32x4 hraw[2];
#pragma unroll
  for (int m = 0; m < 8; ++m) { const i32x4 q4 = *(const i32x4*)(IDX + (unsigned)(tcur * 128 + 32 * es + 4 * m)); ex[4 * m] = q4[0]; ex[4 * m + 1] = q4[1]; ex[4 * m + 2] = q4[2]; ex[4 * m + 3] = q4[3]; }
  hraw[0] = *(const u32x4*)(HB + (size_t)tcur * 2048 + sl * 256 + c * 16); hraw[1] = *(const u32x4*)(HB + (size_t)tcur * 2048 + sl * 256 + c * 16 + 8);
  for (int t = tcur; t < T_; t += tstep) {
    const int tn = (t + tstep < T_) ? t + tstep : t;
    f32x2 hs[8];
#pragma unroll
    for (int q = 0; q < 2; ++q)
#pragma unroll
      for (int k = 0; k < 4; ++k) { hs[q * 4 + k][0] = bflo(hraw[q][k]); hs[q * 4 + k][1] = bfhi(hraw[q][k]); }
    int exn[32];
#pragma unroll
    for (int bt = 0; bt < 2; ++bt) {
      float v[16];
      u32x4 sg[16];
#pragma unroll
      for (int i = 0; i < 16; ++i) sg[i] = *(const u32x4*)(PUs + (unsigned)(ex[16 * bt + i] * 256 + c * 16));
      if (bt == 0) {
#pragma unroll
        for (int m = 0; m < 8; ++m) { const i32x4 q4 = *(const i32x4*)(IDX + (unsigned)(tn * 128 + 32 * es + 4 * m)); exn[4 * m] = q4[0]; exn[4 * m + 1] = q4[1]; exn[4 * m + 2] = q4[2]; exn[4 * m + 3] = q4[3]; }
        hraw[0] = *(const u32x4*)(HB + (size_t)tn * 2048 + sl * 256 + c * 16); hraw[1] = *(const u32x4*)(HB + (size_t)tn * 2048 + sl * 256 + c * 16 + 8);
      }
#pragma unroll
      for (int i = 0; i < 16; ++i) {
        f32x2 d2 = {0.f, 0.f};
#pragma unroll
        for (int dw = 0; dw < 4; ++dw) { const f32x2 lo = __builtin_amdgcn_cvt_pk_f32_fp8((int)sg[i][dw], false), hi = __builtin_amdgcn_cvt_pk_f32_fp8((int)sg[i][dw], true);
          d2 = __builtin_elementwise_fma(lo, hs[dw * 2], d2); d2 = __builtin_elementwise_fma(hi, hs[dw * 2 + 1], d2); }
        v[i] = d2[0] + d2[1];
      }
      const float tot = reduce16(v, c);
      __hip_atomic_fetch_add(AACC + (size_t)t * 128 + 32 * es + 16 * bt + c, tot, __ATOMIC_RELAXED, __HIP_MEMORY_SCOPE_AGENT);
    }
#pragma unroll
    for (int i = 0; i < 32; ++i) ex[i] = exn[i];
  }
}
DI void phase_gB(const Params& p, unsigned char* lds, int gi, int nblk, int tid) {
  const int lane = tid & 63, wave = tid >> 6, c = lane & 15, es = lane >> 4;
  const int NG = nblk >> 3, sl = gi & 7, tr = gi >> 3;
  const unsigned char* PV8 = (const unsigned char*)(p.ws + OFF_PV);
  const float* SU = (const float*)(p.ws + OFF_SU); const float* SV = (const float*)(p.ws + OFF_SV);
  const int* IDX = (const int*)(p.ws + OFF_IDX); const float* GW = (const float*)(p.ws + OFF_GW);
  const float* AACC = (const float*)(p.ws + OFF_AACC); bf16_t* Y = (bf16_t*)(p.ws + OFF_Y);
  float* wl = (float*)(lds + wave * 1024); int* el = (int*)(lds + wave * 1024 + 512);
  const unsigned char* PVs = PV8 + (size_t)sl * 16384 * 256;
  const int tstep = NG * 8;
  int t0 = tr * 8 + wave;
  if (t0 >= T_) return;
  float pa[2], pg[2], psu[2], psv[2]; int pe[2];
#pragma unroll
  for (int hf = 0; hf < 2; ++hf) { const unsigned k = (unsigned)(t0 * 128 + 2 * lane + hf); pa[hf] = AACC[k]; pe[hf] = IDX[k]; pg[hf] = GW[k]; }
#pragma unroll
  for (int hf = 0; hf < 2; ++hf) { const f32x2 sc2 = *(const f32x2*)(SU + 2 * pe[hf]); psu[hf] = sc2[0]; psv[hf] = sc2[1]; }
  for (int t = t0; t < T_; t += tstep) {
    const int tn = (t + tstep < T_) ? t + tstep : t;
#pragma unroll
    for (int hf = 0; hf < 2; ++hf) { const int k = 2 * lane + hf; wl[k] = pg[hf] * gelu_exact(pa[hf] * psu[hf]) * psv[hf]; el[k] = pe[hf]; }
    LDS_WAIT();
#pragma unroll
    for (int hf = 0; hf < 2; ++hf) { const unsigned k = (unsigned)(tn * 128 + 2 * lane + hf); pa[hf] = AACC[k]; pe[hf] = IDX[k]; pg[hf] = GW[k]; }
    f32x2 y2[8];
#pragma unroll
    for (int j = 0; j < 8; ++j) y2[j] = (f32x2){0.f, 0.f};
#pragma unroll
    for (int bt = 0; bt < 2; ++bt) {
      u32x4 sg[16]; float wv[16];
#pragma unroll
      for (int i = 0; i < 16; ++i) { const int k = 64 * bt + 4 * i + es; const int e = el[k]; wv[i] = wl[k]; sg[i] = *(const u32x4*)(PVs + (unsigned)(e * 256 + c * 16)); }
#pragma unroll
      for (int i = 0; i < 16; ++i) { const f32x2 w2 = {wv[i], wv[i]};
#pragma unroll
        for (int dw = 0; dw < 4; ++dw) { const f32x2 lo = __builtin_amdgcn_cvt_pk_f32_fp8((int)sg[i][dw], false), hi = __builtin_amdgcn_cvt_pk_f32_fp8((int)sg[i][dw], true);
          y2[dw * 2] = __builtin_elementwise_fma(w2, lo, y2[dw * 2]); y2[dw * 2 + 1] = __builtin_elementwise_fma(w2, hi, y2[dw * 2 + 1]); } }
      if (bt == 0) {
#pragma unroll
        for (int hf = 0; hf < 2; ++hf) { const f32x2 sc2 = *(const f32x2*)(SU + 2 * pe[hf]); psu[hf] = sc2[0]; psv[hf] = sc2[1]; }
      }
    }
    float ys[16];
#pragma unroll
    for (int j = 0; j < 8; ++j) { ys[2 * j] = y2[j][0]; ys[2 * j + 1] = y2[j][1]; }
#pragma unroll
    for (int j = 0; j < 16; ++j) { ys[j] += __shfl_xor(ys[j], 16); ys[j] += __shfl_xor(ys[j], 32); }
    if (es == 0) { bf16_t* yo = Y + (size_t)t * 2048 + sl * 256 + c * 16;
#pragma unroll
      for (int q = 0; q < 2; ++q) { u32x4 o; o[0] = pk2(ys[q * 8], ys[q * 8 + 1]); o[1] = pk2(ys[q * 8 + 2], ys[q * 8 + 3]); o[2] = pk2(ys[q * 8 + 4], ys[q * 8 + 5]); o[3] = pk2(ys[q * 8 + 6], ys[q * 8 + 7]); *(u32x4*)(yo + q * 8) = o; } }
    LDS_WAIT();
  }
}
DI void phase_final(const Params& p, int bid, int nblk, int tid) {
  const int lane = tid & 63, wave = tid >> 6;
  const float* X1 = (const float*)(p.ws + OFF_X1); const float* MOD = (const float*)(p.ws + OFF_MOD); const bf16_t* Y = (const bf16_t*)(p.ws + OFF_Y);
  for (int t = bid * 8 + wave; t < T_; t += nblk * 8) {
    const int b = t >> 11;
    const float* gt = MOD + b * 16384 + 5 * 2048; const float* sho = MOD + b * 16384 + 12288; const float* sco = sho + 2048;
    f32x4 v[8]; float ss = 0.f;
#pragma unroll
    for (int j = 0; j < 8; ++j) { const int e = j * 256 + lane * 4; const f32x4 xv = *(const f32x4*)(X1 + (size_t)t * 2048 + e), g4 = *(const f32x4*)(gt + e); const u32x2 yb = *(const u32x2*)(Y + (size_t)t * 2048 + e); f32x4 yv; yv[0] = bflo(yb[0]); yv[1] = bfhi(yb[0]); yv[2] = bflo(yb[1]); yv[3] = bfhi(yb[1]);
      v[j] = xv + g4 * yv; ss += v[j][0] * v[j][0] + v[j][1] * v[j][1] + v[j][2] * v[j][2] + v[j][3] * v[j][3]; }
    ss = wave_sum(ss);
    const float rstd = 1.0f / sqrtf(ss * (1.f / 2048.f) + 1e-6f);
#pragma unroll
    for (int j = 0; j < 8; ++j) { const int e = j * 256 + lane * 4; const f32x4 gf = *(const f32x4*)(p.g_final + e), s4 = *(const f32x4*)(sco + e), h4 = *(const f32x4*)(sho + e);
      v[j] = v[j] * rstd * gf * (1.f + s4) + h4; }
#pragma unroll
    for (int j = 0; j < 8; ++j) *(f32x4*)(p.out + (size_t)t * 2048 + j * 256 + lane * 4) = v[j];
  }
}
#define XB_TMO      128
#define XB_XCNT(j)  (256  + 64 * (j))
#define XB_XSUB(j)  (1280 + 64 * (j))
#define XB_XGEN(j)  (2304 + 64 * (j))
#define XB_TOP      3328
#define XB_TOPGEN   3392
#define XB_SPIN_CAP (1u << 20)
#define XB_LAS __attribute__((address_space(3)))
DI unsigned xb_ld(unsigned* p)              { return __hip_atomic_load(p, __ATOMIC_RELAXED, __HIP_MEMORY_SCOPE_AGENT); }
DI unsigned xb_add(unsigned* p, unsigned v) { return __hip_atomic_fetch_add(p, v, __ATOMIC_RELAXED, __HIP_MEMORY_SCOPE_AGENT); }
DI unsigned xb_xcc_id() { return (unsigned)__builtin_amdgcn_s_getreg((3 << 11) | 20) & 0xFu; }
#define XB_SPIN(cond, bar) do { unsigned _sp = 0; while (cond) { __builtin_amdgcn_s_sleep(1); \
    if ((++_sp & 255u) == 0u) { if (xb_ld(&(bar)[XB_TMO])) break; if (_sp > XB_SPIN_CAP) { atomicAdd(&(bar)[XB_TMO], 1u); break; } } } } while (0)
struct XcdBarrier { unsigned* bar; unsigned x; volatile XB_LAS unsigned* st; };
DI XcdBarrier xcd_barrier_post(unsigned* bar, volatile XB_LAS unsigned* st) {
    XcdBarrier b; b.bar = bar; b.x = xb_xcc_id(); b.st = st;
    if (threadIdx.x == 0) st[2] = xb_add(&bar[XB_XCNT(b.x)], 1u);
    return b;
}
DI void xcd_barrier_complete(unsigned* bar, unsigned x, unsigned& nloc, unsigned& nx) {
    const unsigned G = gridDim.x * gridDim.y * gridDim.z;
    unsigned sum, cnt, mine, sp = 0u;
    for (;;) {
        sum = 0u; cnt = 0u; mine = 0u;
#pragma unroll
        for (unsigned j = 0; j < 16; ++j) { const unsigned c = xb_ld(&bar[XB_XCNT(j)]); sum += c; cnt += (c > 0u) ? 1u : 0u; mine = (j == x) ? c : mine; }
        if (sum == G) break;
        __builtin_amdgcn_s_sleep(1);
        if ((++sp & 255u) == 0u) { if (xb_ld(&bar[XB_TMO])) break; if (sp > XB_SPIN_CAP) { atomicAdd(&bar[XB_TMO], 1u); break; } }
    }
    nloc = mine > 0u ? mine : 1u; nx = cnt > 0u ? cnt : 1u;
}
DI void xcd_barrier(const XcdBarrier& b) {
    asm volatile("s_waitcnt vmcnt(0)" ::: "memory");
    __syncthreads();
    if (threadIdx.x == 0) {
        unsigned* bar = b.bar;
        __builtin_amdgcn_s_waitcnt(0);
        unsigned nloc = b.st[0], nx = b.st[1];
        if (nloc == 0u) { xcd_barrier_complete(bar, b.x, nloc, nx); b.st[0] = nloc; b.st[1] = nx; }
        const unsigned old = xb_add(&bar[XB_XSUB(b.x)], 1u);
        const unsigned gen = old / nloc;
        if (old + 1u == (gen + 1u) * nloc) {
            __builtin_amdgcn_fence(__ATOMIC_RELEASE, "agent");
            asm volatile("s_waitcnt vmcnt(0)" ::: "memory");
            const unsigned og = xb_add(&bar[XB_TOP], 1u);
            const unsigned tg = og / nx;
            if (og + 1u == (tg + 1u) * nx) xb_add(&bar[XB_TOPGEN], 1u);
            else XB_SPIN(xb_ld(&bar[XB_TOPGEN]) == tg, bar);
            __builtin_amdgcn_fence(__ATOMIC_ACQUIRE, "agent");
            xb_add(&bar[XB_XGEN(b.x)], 1u);
            asm volatile("s_waitcnt vmcnt(0)" ::: "memory");
        } else {
            XB_SPIN(xb_ld(&bar[XB_XGEN(b.x)]) == gen, bar);
            __builtin_amdgcn_fence(__ATOMIC_ACQUIRE, "agent");
            asm volatile("s_waitcnt vmcnt(0)" ::: "memory");
        }
    }
    __syncthreads();
}
#ifndef ONLY
#define ONLY -1
#endif
#define PH(k) ((ONLY < 0 || ONLY == (k)) && ph == (k))
__global__ void __launch_bounds__(512) mega(Params p, int ph_lo, int ph_hi) {
  extern __shared__ __attribute__((aligned(16))) unsigned char shm[];
  cg::grid_group grid = cg::this_grid();
  const int bid = blockIdx.x, nblk = gridDim.x, tid = threadIdx.x;
  volatile XB_LAS unsigned* xst = (volatile XB_LAS unsigned*)((PG8_LAS unsigned char*)shm + (LDS_BYTES - 16));
  if (tid < 4) xst[tid] = 0u;
  __syncthreads();
  const XcdBarrier xb = xcd_barrier_post((unsigned*)(p.ws + OFF_CTL), xst);
  if (ph_lo > 100) grid.sync();
#ifndef REPMASK
#define REPMASK 0
#endif
#define RUNPH(k, ...) if ((ONLY < 0 || ONLY == (k)) && ph_lo <= (k) && (k) <= ph_hi) { __VA_ARGS__ } if (((REPMASK >> (k)) & 1) && ph_lo <= (k) && (k) <= ph_hi) { __syncthreads(); __VA_ARGS__ } if (ph_lo <= (k) && (k) < ph_hi) xcd_barrier(xb);
  RUNPH(0, phase0(p, shm, bid, nblk, tid);)
  RUNPH(1, phase_norm<true>(p, p.x, p.g_mix, 0, 1, bid, nblk, tid, shm);)
  RUNPH(2, pg8::Gemm g{(const bf16_t*)(p.ws + OFF_HB), (const bf16_t*)(p.ws + OFF_WINT), 8192, 6144, 2048}; pg8::StaticOrder S; S.init(8192, 6144, nblk, bid);
      EpiProj E{(bf16_t*)(p.ws + OFF_PB)};
      pg8::gemm_phase<EpiProj, pg8::StaticOrder, false>((PG8_LAS unsigned char*)shm, g, S, E, nullptr);)
  RUNPH(3, phase_attn(p, shm, bid, nblk, tid); if ((REPMASK >> 13) & 1) { __syncthreads(); phase_attn(p, shm, bid, nblk, tid); } phase_mlA(p, shm, bid, nblk, tid); if ((REPMASK >> 14) & 1) { __syncthreads(); phase_mlA(p, shm, bid, nblk, tid); })
  RUNPH(4, phase_scan(p, bid, nblk, tid);)
  RUNPH(5, phase_mlC(p, shm, bid, nblk, tid);)
  RUNPH(6, pg8::Gemm g{(const bf16_t*)(p.ws + OFF_MIX), (const bf16_t*)(p.ws + OFF_WOUTT), 8192, 2048, 2048}; pg8::StaticOrder S; S.init(8192, 2048, nblk, bid);
      EpiRes E{(float*)(p.ws + OFF_X1), p.x, (const float*)(p.ws + OFF_MOD)};
      pg8::gemm_phase<EpiRes, pg8::StaticOrder, false>((PG8_LAS unsigned char*)shm, g, S, E, nullptr);)
  RUNPH(7, phase_norm<false>(p, (const float*)(p.ws + OFF_X1), p.g_ffn, 3, 4, bid, nblk, tid, shm);)
  if (nblk == 256) {
    RUNPH(8, pg8::Gemm g{(const bf16_t*)(p.ws + OFF_HB), (const bf16_t*)(p.ws + OFF_WPQT), 8192, 2048, 2048}; pg8::StaticOrder S; S.init(8192, 2048, nblk, bid);
        EpiTopk E{&p, bid, nblk};
        pg8::gemm_phase<EpiTopk, pg8::StaticOrder, false>((PG8_LAS unsigned char*)shm, g, S, E, nullptr);)
  } else {
    RUNPH(8, pg8::Gemm g{(const bf16_t*)(p.ws + OFF_HB), (const bf16_t*)(p.ws + OFF_WPQT), 8192, 2048, 2048}; pg8::StaticOrder S; S.init(8192, 2048, nblk, bid);
        EpiBf E{(bf16_t*)(p.ws + OFF_QP)};
        pg8::gemm_phase<EpiBf, pg8::StaticOrder, false>((PG8_LAS unsigned char*)shm, g, S, E, nullptr);)
    RUNPH(9, phase_topk(p, bid, nblk, tid);)
  }
  RUNPH(10, phase_gA(p, bid, nblk, tid);)
  RUNPH(11, phase_gB(p, shm, bid, nblk, tid);)
  RUNPH(12, phase_final(p, bid, nblk, tid);)

}
extern "C" void kernel_launch(void* const* d_in, const int* in_sizes, int n_in, void* d_out, int out_size, void* d_ws, size_t ws_size, hipStream_t stream) {
  (void)in_sizes; (void)n_in; (void)out_size;
  if (ws_size < WS_TOTAL) { fprintf(stderr, "kernel_launch: workspace too small (%zu < %zu)\n", ws_size, (size_t)WS_TOTAL); return; }
  Params p{};
  const float** f = (const float**)&p;
  for (int i = 0; i < 25; ++i) f[i] = (const float*)d_in[i];
  p.out = (float*)d_out; p.ws = (unsigned char*)d_ws;
  static bool attr_set = false;
  if (!attr_set) { if (hipFuncSetAttribute((const void*)mega, hipFuncAttributeMaxDynamicSharedMemorySize, LDS_BYTES) != hipSuccess) { fprintf(stderr, "kernel_launch: hipFuncSetAttribute failed\n"); return; } attr_set = true; }
  (void)hipMemsetAsync((unsigned char*)d_ws + OFF_CTL, 0, 16384, stream);
    int lo = 0, hi = 12;
  void* args[] = {&p, &lo, &hi};
  static int grid_blocks = 0;
  if (!grid_blocks) { int dev = 0, cus = 0, per_cu = 0; (void)hipGetDevice(&dev); (void)hipDeviceGetAttribute(&cus, hipDeviceAttributeMultiprocessorCount, dev);
    (void)hipOccupancyMaxActiveBlocksPerMultiprocessor(&per_cu, (const void*)mega, 512, LDS_BYTES);
    int g = cus * (per_cu > 0 ? per_cu : 1); if (g > 256) g = 256; g &= ~7; if (g < 8) g = 8; grid_blocks = g; }
  hipError_t e = hipLaunchCooperativeKernel((const void*)mega, dim3(grid_blocks), dim3(512), args, LDS_BYTES, stream);
  if (e != hipSuccess) fprintf(stderr, "cooperative launch failed: %s\n", hipGetErrorString(e));
}
```
